# Optimizing an MI355X kernel written in HIP

```python
import math
import jax, jax.numpy as jnp
from jax import lax
import numpy as np

D_MODEL = 1024
BATCH = 8
SEQ = 2048
DEPTH = 4
DEC_BATCH = 128
DEC_SEQ = 8
PAST_LEN = 16384
PAGE_SIZE = 128

SSD_HEAD_DIM = 64
SSD_HEADS = D_MODEL // SSD_HEAD_DIM
SSD_INNER = SSD_HEADS * SSD_HEAD_DIM
SSD_GROUPS = 2
SSD_STATE = 128
SSD_CONV = 4
SSD_CHUNK = 128
SSD_CONV_DIM = SSD_INNER + 2 * SSD_GROUPS * SSD_STATE
DT_MIN = 0.001
DT_MAX = 0.1
SGU_WIDTH = D_MODEL // 2
SGU_GROUPS = 4
SGU_CHUNK = 128
SGU_GW = SGU_WIDTH // SGU_GROUPS
POOL_WIDTH = D_MODEL // 2
POOL_WINDOWS = (2, 4, 8, 16)
POOL_GROUPS = len(POOL_WINDOWS)
POOL_GW = POOL_WIDTH // POOL_GROUPS
POOL_BUF = max(POOL_WINDOWS) - 1
D_FF = -(-8 * D_MODEL // (3 * 256)) * 256
PLE_DIM = 256
N_BRANCH = 3
EPS = 1e-6
O_Z = 0
O_XBC = O_Z + SSD_INNER
O_DT = O_XBC + SSD_CONV_DIM
O_UV = O_DT + SSD_HEADS
O_POOL = O_UV + 2 * SGU_WIDTH
O_GATE = O_POOL + POOL_WIDTH
IN_DIM = O_GATE + N_BRANCH * D_MODEL

kernel_name = 'hybrid_ssd_sgu_pool_step'


def rmsnorm(x, g):
    xf = x.astype(jnp.float32)
    y = xf * lax.rsqrt(jnp.mean(xf * xf, axis=-1, keepdims=True) + EPS)
    return (y * g.astype(jnp.float32)).astype(x.dtype)


def segsum(a):
    cs = jnp.cumsum(a, axis=-1)
    diff = cs[..., :, None] - cs[..., None, :]
    T = a.shape[-1]
    mask = jnp.tril(jnp.ones((T, T), dtype=bool))
    return jnp.where(mask, diff, -jnp.inf)


def ssd_scan(xdt, da, b, c, h0):
    n, L, H, P = xdt.shape
    G, N = b.shape[2], b.shape[3]
    R = H // G
    Q = min(SSD_CHUNK, L)
    Lp = -(-L // Q) * Q
    pad = Lp - L
    if pad:
        pw = ((0, 0), (0, pad), (0, 0), (0, 0))
        xdt = jnp.pad(xdt, pw)
        b = jnp.pad(b, pw)
        c = jnp.pad(c, pw)
        da = jnp.pad(da, ((0, 0), (0, pad), (0, 0)))
    nc = Lp // Q
    X = xdt.reshape(n, nc, Q, G, R, P)
    A = da.reshape(n, nc, Q, G, R).transpose(0, 3, 4, 1, 2)
    Bc = b.reshape(n, nc, Q, G, N)
    Cc = c.reshape(n, nc, Q, G, N)
    A_cs = jnp.cumsum(A, axis=-1)
    Lmat = jnp.exp(segsum(A))
    CB = jnp.einsum('bclgn,bcsgn->bgcls', Cc, Bc)
    y_diag = jnp.einsum('bgrcls,bcsgrp->bclgrp', CB[:, :, None] * Lmat, X)
    decay_states = jnp.exp(A_cs[..., -1:] - A_cs)
    states = jnp.einsum('bclgn,bgrcl,bclgrp->bcgrpn', Bc, decay_states, X)
    states = jnp.concatenate([h0.reshape(n, 1, G, R, P, N), states], axis=1)
    chunk_tot = jnp.pad(A_cs[..., -1], ((0, 0), (0, 0), (0, 0), (1, 0)))
    decay_chunk = jnp.exp(segsum(chunk_tot))
    new_states = jnp.einsum('bgrzc,bcgrpn->bzgrpn', decay_chunk, states)
    prev_states, final = new_states[:, :-1], new_states[:, -1]
    y_off = jnp.einsum('bclgn,bcgrpn,bgrcl->bclgrp', Cc, prev_states, jnp.exp(A_cs))
    y = (y_diag + y_off).reshape(n, Lp, H, P)[:, :L]
    return y, final.reshape(n, H, P, N)


def ssd_branch(z, xbc, dt_raw, conv_buf, h0, conv_w, conv_b, dt_bias, a_log, d_skip, norm_g):
    n, L, _ = xbc.shape
    dtype = xbc.dtype
    f32 = jnp.float32
    xp = jnp.concatenate([conv_buf.astype(dtype), xbc], axis=1)
    new_conv = xp[:, -(SSD_CONV - 1):]
    acc = xp[:, 0:L] * conv_w[0]
    for k in range(1, SSD_CONV):
        acc = acc + xp[:, k:k + L] * conv_w[k]
    xbc_c = jax.nn.silu((acc + conv_b).astype(f32))
    xs = xbc_c[..., :SSD_INNER].reshape(n, L, SSD_HEADS, SSD_HEAD_DIM)
    bs = xbc_c[..., SSD_INNER:SSD_INNER + SSD_GROUPS * SSD_STATE].reshape(n, L, SSD_GROUPS, SSD_STATE)
    cs = xbc_c[..., SSD_INNER + SSD_GROUPS * SSD_STATE:].reshape(n, L, SSD_GROUPS, SSD_STATE)
    dt = jax.nn.softplus(dt_raw.astype(f32) + dt_bias.astype(f32))
    a = -jnp.exp(a_log.astype(f32))
    y, h_last = ssd_scan(xs * dt[..., None], dt * a, bs, cs, h0.astype(f32))
    y = y + d_skip.astype(f32)[:, None] * xs
    y = y.reshape(n, L, SSD_INNER) * jax.nn.silu(z.astype(f32))
    yg = y.reshape(n, L, SSD_GROUPS, SSD_INNER // SSD_GROUPS)
    yg = yg * lax.rsqrt(jnp.mean(yg * yg, axis=-1, keepdims=True) + EPS)
    y = yg.reshape(n, L, SSD_INNER) * norm_g.astype(f32)
    return y.astype(dtype), new_conv, h_last.astype(h0.dtype)


def sgu_branch(uv, ln_g, ln_b, w_sp, b_sp):
    n, L, _ = uv.shape
    dtype = uv.dtype
    f32 = jnp.float32
    a = jax.nn.gelu(uv.astype(f32))
    u, v = a[..., :SGU_WIDTH], a[..., SGU_WIDTH:]
    mu = jnp.mean(v, axis=-1, keepdims=True)
    var = jnp.mean(jnp.square(v - mu), axis=-1, keepdims=True)
    vn = (v - mu) * lax.rsqrt(var + EPS) * ln_g.astype(f32) + ln_b.astype(f32)
    Lp = -(-L // SGU_CHUNK) * SGU_CHUNK
    vp = jnp.pad(vn, ((0, 0), (0, Lp - L), (0, 0)))
    vc = vp.reshape(n, Lp // SGU_CHUNK, SGU_CHUNK, SGU_GROUPS, SGU_GW)
    wm = w_sp.astype(f32) * jnp.tril(jnp.ones((SGU_CHUNK, SGU_CHUNK), f32))
    s = jnp.einsum('gts,bcsgd->bctgd', wm, vc) + b_sp.astype(f32).T[None, None, :, :, None]
    s = s.reshape(n, Lp, SGU_WIDTH)[:, :L]
    return (u * s).astype(dtype), vn.astype(dtype)


def pool_branch(xc, buf, start, pool_w, pool_scale):
    n, L, C = xc.shape
    f32 = jnp.float32
    xf = xc.astype(f32)
    xp = jnp.concatenate([buf.astype(f32), xf], axis=1)
    new_buf = xp[:, -POOL_BUF:].astype(xc.dtype)
    cs = jnp.concatenate([jnp.zeros((n, 1, C), f32), jnp.cumsum(xp, axis=1)], axis=1)
    pos = start + jnp.arange(L)
    means = []
    for g, w in enumerate(POOL_WINDOWS):
        sl = slice(g * POOL_GW, (g + 1) * POOL_GW)
        hi = cs[:, POOL_BUF + 1:POOL_BUF + 1 + L, sl]
        lo = cs[:, POOL_BUF + 1 - w:POOL_BUF + 1 - w + L, sl]
        cnt = jnp.minimum(pos + 1, w).astype(f32)
        means.append((hi - lo) / cnt[None, :, None])
    pooled = jnp.concatenate(means, axis=-1)
    d = (pooled - xf).reshape(n, L, POOL_GROUPS, POOL_GW)
    y = jnp.einsum('blgc,gcd->blgd', d, pool_w.astype(f32)).reshape(n, L, C) * pool_scale.astype(f32)
    return y.astype(xc.dtype), new_buf


def trunk(x, p, conv_state, ssm_state, pool_state, start, W):
    (norm_mix, w_in, conv_w, conv_b, dt_bias, a_log, d_skip, ssd_norm, sgu_ln_g, sgu_ln_b,
     w_spatial, b_spatial, pool_w, pool_scale, w_br_a, w_br_b, w_br_c, w_out, norm_ffn,
     w_gate_up, w_down, norm_ple, w_ple_gate, w_ple_up, final_norm) = W
    n, L, _ = x.shape
    v_from = ((start + L - 1) // SGU_CHUNK) * SGU_CHUNK - start
    convs, ssms, pools, vrows = [], [], [], []
    for i in range(DEPTH):
        h = rmsnorm(x, norm_mix[i])
        proj = h @ w_in[i]
        ya, c_new, s_new = ssd_branch(proj[..., O_Z:O_XBC], proj[..., O_XBC:O_DT], proj[..., O_DT:O_UV],
                                      conv_state[i], ssm_state[i], conv_w[i], conv_b[i], dt_bias[i],
                                      a_log[i], d_skip[i], ssd_norm[i])
        yb, v_new = sgu_branch(proj[..., O_UV:O_POOL], sgu_ln_g[i], sgu_ln_b[i], w_spatial[i], b_spatial[i])
        yc, p_new = pool_branch(proj[..., O_POOL:O_GATE], pool_state[i], start, pool_w[i], pool_scale[i])
        g = jax.nn.sigmoid(proj[..., O_GATE:].astype(jnp.float32)).astype(x.dtype)
        merged = (g[..., :D_MODEL] * (ya @ w_br_a[i])
                  + g[..., D_MODEL:2 * D_MODEL] * (yb @ w_br_b[i])
                  + g[..., 2 * D_MODEL:] * (yc @ w_br_c[i]))
        x = x + merged @ w_out[i]
        h = rmsnorm(x, norm_ffn[i])
        gu = h @ w_gate_up[i]
        x = x + (jax.nn.silu(gu[..., :D_FF]) * gu[..., D_FF:]) @ w_down[i]
        h = rmsnorm(x, norm_ple[i])
        x = x + (p[i] @ w_ple_up[i]) * jax.nn.sigmoid(h @ w_ple_gate[i])
        convs.append(c_new)
        ssms.append(s_new)
        pools.append(p_new)
        vrows.append(v_new[:, v_from:])
    y = rmsnorm(x, final_norm)
    return y, jnp.stack(convs), jnp.stack(ssms), jnp.stack(pools), jnp.stack(vrows)


def setup_inputs(seed: int = 0) -> dict:
    key = jax.random.key(seed)
    keys = list(jax.random.split(key, 32))
    f32 = jnp.float32

    def nrm(k, shape, scale):
        return jax.random.normal(k, shape, f32) * scale

    x_prompt = nrm(keys[0], (BATCH, SEQ, D_MODEL), 1.0)
    x_sample = nrm(keys[1], (DEC_BATCH, DEC_SEQ, D_MODEL), 1.0)
    state_conv = nrm(keys[2], (DEPTH, DEC_BATCH, SSD_CONV - 1, SSD_CONV_DIM), 1.0)
    state_ssm = nrm(keys[3], (DEPTH, DEC_BATCH, SSD_HEADS, SSD_HEAD_DIM, SSD_STATE), 0.3)
    state_pool = nrm(keys[4], (DEPTH, DEC_BATCH, POOL_BUF, POOL_WIDTH), 1.0)
    p_prompt = nrm(keys[5], (DEPTH, BATCH, SEQ, PLE_DIM), 1.0)
    p_sample = nrm(keys[6], (DEPTH, DEC_BATCH, DEC_SEQ, PLE_DIM), 1.0)
    norm_mix = 1.0 + nrm(keys[7], (DEPTH, D_MODEL), 0.02)
    w_in = nrm(keys[8], (DEPTH, D_MODEL, IN_DIM), D_MODEL ** -0.5)
    conv_w = nrm(keys[9], (DEPTH, SSD_CONV, SSD_CONV_DIM), SSD_CONV ** -0.5)
    conv_b = nrm(keys[10], (DEPTH, SSD_CONV_DIM), 0.02)
    dt0 = jnp.exp(jax.random.uniform(keys[11], (DEPTH, SSD_HEADS), f32, math.log(DT_MIN), math.log(DT_MAX)))
    dt_bias = dt0 + jnp.log(-jnp.expm1(-dt0))
    a_log = jnp.log(jax.random.uniform(keys[12], (DEPTH, SSD_HEADS), f32, 1.0, 16.0))
    d_skip = 1.0 + nrm(keys[13], (DEPTH, SSD_HEADS), 0.02)
    ssd_norm = 1.0 + nrm(keys[14], (DEPTH, SSD_INNER), 0.02)
    sgu_ln_g = 1.0 + nrm(keys[15], (DEPTH, SGU_WIDTH), 0.02)
    sgu_ln_b = nrm(keys[16], (DEPTH, SGU_WIDTH), 0.02)
    w_spatial = nrm(keys[17], (DEPTH, SGU_GROUPS, SGU_CHUNK, SGU_CHUNK), SGU_CHUNK ** -0.5)
    b_spatial = 1.0 + nrm(keys[18], (DEPTH, SGU_GROUPS, SGU_CHUNK), 0.02)
    pool_w = nrm(keys[19], (DEPTH, POOL_GROUPS, POOL_GW, POOL_GW), POOL_GW ** -0.5)
    pool_scale = 1.0 + nrm(keys[20], (DEPTH, POOL_WIDTH), 0.02)
    w_br_a = nrm(keys[21], (DEPTH, SSD_INNER, D_MODEL), SSD_INNER ** -0.5)
    w_br_b = nrm(keys[22], (DEPTH, SGU_WIDTH, D_MODEL), SGU_WIDTH ** -0.5)
    w_br_c = nrm(keys[23], (DEPTH, POOL_WIDTH, D_MODEL), POOL_WIDTH ** -0.5)
    w_out = nrm(keys[24], (DEPTH, D_MODEL, D_MODEL), D_MODEL ** -0.5)
    norm_ffn = 1.0 + nrm(keys[25], (DEPTH, D_MODEL), 0.02)
    w_gate_up = nrm(keys[26], (DEPTH, D_MODEL, 2 * D_FF), D_MODEL ** -0.5)
    w_down = nrm(keys[27], (DEPTH, D_FF, D_MODEL), D_FF ** -0.5)
    norm_ple = 1.0 + nrm(keys[28], (DEPTH, D_MODEL), 0.02)
    w_ple_gate = nrm(keys[29], (DEPTH, D_MODEL, D_MODEL), D_MODEL ** -0.5)
    w_ple_up = nrm(keys[30], (DEPTH, PLE_DIM, D_MODEL), PLE_DIM ** -0.5)
    final_norm = 1.0 + nrm(keys[31], (D_MODEL,), 0.02)
    return {'x_prompt': x_prompt, 'x_sample': x_sample, 'state_conv': state_conv, 'state_ssm': state_ssm,
            'state_pool': state_pool, 'p_prompt': p_prompt, 'p_sample': p_sample, 'norm_mix': norm_mix,
            'w_in': w_in, 'conv_w': conv_w, 'conv_b': conv_b, 'dt_bias': dt_bias, 'a_log': a_log,
            'd_skip': d_skip, 'ssd_norm': ssd_norm, 'sgu_ln_g': sgu_ln_g, 'sgu_ln_b': sgu_ln_b,
            'w_spatial': w_spatial, 'b_spatial': b_spatial, 'pool_w': pool_w, 'pool_scale': pool_scale,
            'w_br_a': w_br_a, 'w_br_b': w_br_b, 'w_br_c': w_br_c, 'w_out': w_out, 'norm_ffn': norm_ffn,
            'w_gate_up': w_gate_up, 'w_down': w_down, 'norm_ple': norm_ple, 'w_ple_gate': w_ple_gate,
            'w_ple_up': w_ple_up, 'final_norm': final_norm}


def reference(x_prompt, x_sample, state_conv, state_ssm, state_pool, p_prompt, p_sample, norm_mix, w_in,
              conv_w, conv_b, dt_bias, a_log, d_skip, ssd_norm, sgu_ln_g, sgu_ln_b, w_spatial, b_spatial,
              pool_w, pool_scale, w_br_a, w_br_b, w_br_c, w_out, norm_ffn, w_gate_up, w_down, norm_ple,
              w_ple_gate, w_ple_up, final_norm):
    W = (norm_mix, w_in, conv_w, conv_b, dt_bias, a_log, d_skip, ssd_norm, sgu_ln_g, sgu_ln_b,
         w_spatial, b_spatial, pool_w, pool_scale, w_br_a, w_br_b, w_br_c, w_out, norm_ffn,
         w_gate_up, w_down, norm_ple, w_ple_gate, w_ple_up, final_norm)
    dt = x_prompt.dtype
    zero_conv = jnp.zeros((DEPTH, BATCH, SSD_CONV - 1, SSD_CONV_DIM), dt)
    zero_ssm = jnp.zeros((DEPTH, BATCH, SSD_HEADS, SSD_HEAD_DIM, SSD_STATE), dt)
    zero_pool = jnp.zeros((DEPTH, BATCH, POOL_BUF, POOL_WIDTH), dt)
    y_prompt, conv_p, ssm_p, pool_p, v_p = trunk(x_prompt, p_prompt, zero_conv, zero_ssm, zero_pool, 0, W)
    y_sample, conv_s, ssm_s, pool_s, v_s = trunk(x_sample, p_sample, state_conv, state_ssm, state_pool,
                                                 PAST_LEN, W)
    return (y_prompt, y_sample, conv_p, ssm_p, pool_p, v_p, conv_s, ssm_s, pool_s, v_s)
```

```cpp
#include <hip/hip_runtime.h>
#include <hip/hip_cooperative_groups.h>
#include <cstdio>
namespace cg = cooperative_groups;

#define LAS __attribute__((address_space(3)))
typedef unsigned short bf16_t;
typedef unsigned char uchar;
typedef short bf16x8 __attribute__((ext_vector_type(8)));
typedef float f32x4 __attribute__((ext_vector_type(4)));
typedef unsigned u32x4 __attribute__((ext_vector_type(4)));
typedef unsigned u32x2 __attribute__((ext_vector_type(2)));

#ifndef MULTI_LAUNCH
#define MULTI_LAUNCH 0
#endif

constexpr int MT = 17408, MPR = 16384, DM = 1024, NPROJ = 7168, NIN = 7424, DFF = 2816;
constexpr float EPS = 1e-6f;
constexpr int NTHR = 512;
constexpr int LDS_BYTES = 141312;
constexpr int C_Z = 0, C_XBC = 1024, C_U = 2560, C_V = 3072, C_POOL = 3584, C_GA = 4096, C_GB = 5120, C_GC = 6144;
constexpr size_t al256(size_t x) { return (x + 255) & ~(size_t)255; }
constexpr size_t WS_WIN = 0;
constexpr size_t WS_WBR = WS_WIN + (size_t)4 * NIN * 1024 * 2;
constexpr size_t WS_WOUT = WS_WBR + (size_t)4 * 1024 * 2048 * 2;
constexpr size_t WS_WGU = WS_WOUT + (size_t)4 * 1024 * 1024 * 2;
constexpr size_t WS_WDN = WS_WGU + (size_t)4 * 5632 * 1024 * 2;
constexpr size_t WS_WPG = WS_WDN + (size_t)4 * 1024 * 2816 * 2;
constexpr size_t WS_WPU = WS_WPG + (size_t)4 * 1024 * 1024 * 2;
constexpr size_t WS_X = WS_WPU + (size_t)4 * 1024 * 256 * 2;
constexpr size_t WS_XN = WS_X + (size_t)MT * 1024 * 4;
constexpr size_t WS_RSS = WS_XN + (size_t)MT * 1024 * 2;
constexpr size_t WS_PROJ = al256(WS_RSS + (size_t)13 * MT * 16 * 4);
constexpr size_t WS_DT = WS_PROJ + (size_t)MT * NPROJ * 2;
constexpr size_t WS_Y = WS_DT + (size_t)MT * 16 * 4;
constexpr size_t WS_SSQ = WS_Y + (size_t)MT * 2048 * 2;
constexpr size_t WS_MRG = WS_SSQ + (size_t)MT * 16 * 4;
constexpr size_t WS_ACT = WS_MRG + (size_t)MT * 1024 * 2;
constexpr size_t WS_UP = WS_ACT + (size_t)MT * DFF * 2;
constexpr size_t WS_PBF = WS_UP + (size_t)4 * MT * 1024 * 2;
constexpr size_t WS_XN2 = WS_PBF + (size_t)4 * MT * 256 * 2;
constexpr size_t WS_END = WS_XN2 + (size_t)MT * 1024 * 2;
constexpr size_t O_Y = 0;
constexpr size_t O_CONVP = (size_t)MT * 1024;
constexpr size_t O_SSMP = O_CONVP + (size_t)4 * 8 * 3 * 1536;
constexpr size_t O_POOLP = O_SSMP + (size_t)4 * 8 * 16 * 64 * 128;
constexpr size_t O_VP = O_POOLP + (size_t)4 * 8 * 15 * 512;
constexpr size_t O_CONVS = O_VP + (size_t)4 * 8 * 128 * 512;
constexpr size_t O_SSMS = O_CONVS + (size_t)4 * 128 * 3 * 1536;
constexpr size_t O_POOLS = O_SSMS + (size_t)4 * 128 * 16 * 64 * 128;
constexpr size_t O_VS = O_POOLS + (size_t)4 * 128 * 15 * 512;
constexpr size_t O_END = O_VS + (size_t)4 * 128 * 8 * 512;

struct Params {
    const float* in[32];
    float* out;
    uchar* ws;
    int ph_lo, ph_hi;
};
enum { I_XP = 0, I_XS, I_SCONV, I_SSSM, I_SPOOL, I_PP, I_PS, I_NMIX, I_WIN, I_CONVW, I_CONVB, I_DTB, I_ALOG, I_DSKIP, I_SSDN, I_LNG, I_LNB, I_WSP, I_BSP,
       I_POOLW, I_POOLS, I_WBRA, I_WBRB, I_WBRC, I_WOUT, I_NFFN, I_WGU, I_WDN, I_NPLE, I_WPG, I_WPU, I_FN };


__device__ __forceinline__ int launder_s(int i) { asm volatile("" : "+s"(i)); return i; }
__device__ __forceinline__ int launder_v(int i) { asm volatile("" : "+v"(i)); return i; }
template <class T> __device__ __forceinline__ T* launder_p(T* p) { asm volatile("" : "+s"(p)); return p; }
__device__ __forceinline__ size_t launder_z() { size_t z = 0; asm volatile("" : "+s"(z)); return z; }
typedef const float __attribute__((address_space(1)))* gcf_t;
#define PIN(i) ((const float*)(gcf_t)(P.in[launder_s(i)]))
#define TIDX launder_v((int)threadIdx.x)
#define BIDX launder_s((int)blockIdx.x)
#define GDIM launder_s((int)gridDim.x)
__device__ __forceinline__ unsigned cvt_pk_bf16(float lo, float hi) { unsigned r; asm("v_cvt_pk_bf16_f32 %0, %1, %2" : "=v"(r) : "v"(lo), "v"(hi)); return r; }
__device__ __forceinline__ float bf_lo(unsigned w) { return __uint_as_float(w << 16); }
__device__ __forceinline__ float bf_hi(unsigned w) { return __uint_as_float(w & 0xffff0000u); }
__device__ __forceinline__ float bf1(bf16_t b) { return __uint_as_float(((unsigned)b) << 16); }
__device__ __forceinline__ float frcp(float x) { return __builtin_amdgcn_rcpf(x); }
__device__ __forceinline__ float sigmoidf_(float x) { return frcp(1.0f + __expf(-x)); }
__device__ __forceinline__ float siluf_(float x) { return x * sigmoidf_(x); }
__device__ __forceinline__ float gelu_tanh(float x) { const float u = 1.5957691216057308f * (x + 0.044715f * x * x * x); return x * sigmoidf_(u); }
__device__ __forceinline__ float softplusf_(float x) { return x > 20.f ? x : log1pf(__expf(x)); }
__device__ __forceinline__ float shx(float v, int m) { return __shfl_xor(v, m, 64); }

__device__ __forceinline__ float rownorm(const float* rssp, int row) {
    const f32x4 a = *(const f32x4*)(rssp + (size_t)row * 16), b = *(const f32x4*)(rssp + (size_t)row * 16 + 4), c = *(const f32x4*)(rssp + (size_t)row * 16 + 8), d = *(const f32x4*)(rssp + (size_t)row * 16 + 12);
    const float s = ((a[0] + a[1]) + (a[2] + a[3])) + ((b[0] + b[1]) + (b[2] + b[3])) + ((c[0] + c[1]) + (c[2] + c[3])) + ((d[0] + d[1]) + (d[2] + d[3]));
    return rsqrtf(s * (1.0f / 1024.0f) + EPS);
}
constexpr int BM = 256, BK = 64, HALF = 128, HTB = HALF * BK * 2, NXCD = 8, WGM = 8;
__device__ __forceinline__ int lds_byte(int r, int c) { const int st = (r >> 4) * 2 + (c >> 5), rr = r & 15, cc = c & 31, ob = rr * 64 + cc * 2; return st * 1024 + (ob ^ (((ob >> 9) & 1) << 5)); }
__device__ __forceinline__ void stage_rc(int b, int& R, int& C) { const int st = b / 1024, sb = b % 1024, swz = sb ^ (((sb >> 9) & 1) << 5); R = (st >> 1) * 16 + swz / 64; C = (st & 1) * 32 + (swz % 64) / 2; }

struct Unit { int pm, pn, seg, lay; };
enum { EPI_UP = 0, EPI_P1, EPI_P3, EPI_P4, EPI_P5, EPI_P6, EPI_P7 };

struct GPh {
    const bf16_t* A; const bf16_t* Bt; int lda, ldb, K, nM, nN, nseg, nlay; size_t a_lay, b_lay;
    int G, c;
    const float* rss; float* rss_next; const float* gnext; float* X; bf16_t* XN; bf16_t* O; float* DT; const bf16_t* PROJ; const float* SSQ; const bf16_t* UPB;
    __device__ __forceinline__ bool next(int i, Unit& u) const {
        const int tiles = nM * nN; const long L = (long)(i / nseg) * G + c; if (L >= (long)tiles * nlay) return false;
        u.seg = i % nseg; u.lay = (int)(L / tiles); int wgid = (int)(L % tiles);
        { const int q = tiles / NXCD, r = tiles % NXCD, xcd = wgid % NXCD, off = wgid / NXCD; wgid = (xcd < r ? xcd * (q + 1) : r * (q + 1) + (xcd - r) * q) + off; }
        const int nig = WGM * nN, gid = wgid / nig, fm = gid * WGM, gsz = (nM - fm) < WGM ? (nM - fm) : WGM;
        u.pm = fm + ((wgid % nig) % gsz); u.pn = (wgid % nig) / gsz; return true;
    }
    __device__ __forceinline__ const char* pa(const Unit& u) const { return (const char*)(A + u.lay * a_lay + (size_t)u.pm * BM * lda + (size_t)u.seg * K); }
    __device__ __forceinline__ const char* pb(const Unit& u) const { return (const char*)(Bt + u.lay * b_lay + (size_t)u.pn * BM * ldb + (size_t)u.seg * K); }
};

template <int EPI>
__device__ __forceinline__ void epilogue(const GPh& P, f32x4 (&acc)[2][2][4][2], const Unit& u, int, int, int, int) {
    const int tid_ = TIDX, wid_ = tid_ >> 6, wr = wid_ >> 2, wc = wid_ & 3, fr = tid_ & 15, fq = (tid_ >> 4) & 3;
    const int row0 = u.pm * BM + wr * 64 + fr, col0 = u.pn * BM + wc * 32 + 4 * fq;
    if constexpr (EPI == EPI_UP) {
        bf16_t* O = P.O + (size_t)u.lay * MT * 1024;
#pragma unroll
        for (int ai = 0; ai < 2; ++ai)
#pragma unroll
            for (int m = 0; m < 4; ++m) { const int row = row0 + ai * HALF + m * 16;
#pragma unroll
                for (int bj = 0; bj < 2; ++bj)
#pragma unroll
                    for (int n = 0; n < 2; ++n) { const int col = col0 + bj * HALF + n * 16; const f32x4 v = acc[ai][bj][m][n];
                        u32x2 o; o.x = cvt_pk_bf16(v[0], v[1]); o.y = cvt_pk_bf16(v[2], v[3]); *(u32x2*)(O + (size_t)row * 1024 + col) = o; } }
    } else if constexpr (EPI == EPI_P1) {
        const int pn = u.pn;
#pragma unroll
        for (int ai = 0; ai < 2; ++ai)
#pragma unroll
            for (int m = 0; m < 4; ++m) { const int row = row0 + ai * HALF + m * 16; const float r = rownorm(P.rss, row);
#pragma unroll
                for (int bj = 0; bj < 2; ++bj)
#pragma unroll
                    for (int n = 0; n < 2; ++n) { const int col = col0 + bj * HALF + n * 16; f32x4 v = acc[ai][bj][m][n] * r;
                        if (pn == 28) { if (col - NPROJ < 16) *(f32x4*)(P.DT + (size_t)row * 16 + (col - NPROJ)) = v; }
                        else {
                            if (pn >= 10 && pn < 14) { v[0] = gelu_tanh(v[0]); v[1] = gelu_tanh(v[1]); v[2] = gelu_tanh(v[2]); v[3] = gelu_tanh(v[3]); }
                            else if (pn >= 16) { v[0] = sigmoidf_(v[0]); v[1] = sigmoidf_(v[1]); v[2] = sigmoidf_(v[2]); v[3] = sigmoidf_(v[3]); }
                            u32x2 o; o.x = cvt_pk_bf16(v[0], v[1]); o.y = cvt_pk_bf16(v[2], v[3]); *(u32x2*)(P.O + (size_t)row * NPROJ + col) = o; } } }
    } else if constexpr (EPI == EPI_P3) {
        const int seg = u.seg;
#pragma unroll
        for (int ai = 0; ai < 2; ++ai)
#pragma unroll
            for (int m = 0; m < 4; ++m) { const int row = row0 + ai * HALF + m * 16;
                float rs0 = 1.f, rs1 = 1.f;
                if (seg < 2) { const f32x4 a0 = *(const f32x4*)(P.SSQ + (size_t)row * 16), a1 = *(const f32x4*)(P.SSQ + (size_t)row * 16 + 4), b0 = *(const f32x4*)(P.SSQ + (size_t)row * 16 + 8), b1 = *(const f32x4*)(P.SSQ + (size_t)row * 16 + 12);
                    rs0 = rsqrtf((a0[0] + a0[1] + a0[2] + a0[3] + a1[0] + a1[1] + a1[2] + a1[3]) * (1.0f / 512.0f) + EPS);
                    rs1 = rsqrtf((b0[0] + b0[1] + b0[2] + b0[3] + b1[0] + b1[1] + b1[2] + b1[3]) * (1.0f / 512.0f) + EPS); }
                const bf16_t* prow = P.PROJ + (size_t)row * NPROJ;
#pragma unroll
                for (int bj = 0; bj < 2; ++bj)
#pragma unroll
                    for (int n = 0; n < 2; ++n) { const int col = col0 + bj * HALF + n * 16; f32x4 v = acc[ai][bj][m][n];
                        if (seg == 0) { v = v * (rs0 * frcp(rs1)); acc[ai][bj][m][n] = v; }
                        else if (seg == 1) { const u32x2 ga = *(const u32x2*)(prow + C_GA + col), gb = *(const u32x2*)(prow + C_GB + col);
                            v[0] *= rs1 * bf_lo(ga.x) * frcp(bf_lo(gb.x)); v[1] *= rs1 * bf_hi(ga.x) * frcp(bf_hi(gb.x)); v[2] *= rs1 * bf_lo(ga.y) * frcp(bf_lo(gb.y)); v[3] *= rs1 * bf_hi(ga.y) * frcp(bf_hi(gb.y)); acc[ai][bj][m][n] = v; }
                        else if (seg == 2) { const u32x2 ga = *(const u32x2*)(prow + C_GB + col), gb = *(const u32x2*)(prow + C_GC + col);
                            v[0] *= bf_lo(ga.x) * frcp(bf_lo(gb.x)); v[1] *= bf_hi(ga.x) * frcp(bf_hi(gb.x)); v[2] *= bf_lo(ga.y) * frcp(bf_lo(gb.y)); v[3] *= bf_hi(ga.y) * frcp(bf_hi(gb.y)); acc[ai][bj][m][n] = v; }
                        else { const u32x2 gc = *(const u32x2*)(prow + C_GC + col);
                            u32x2 o; o.x = cvt_pk_bf16(v[0] * bf_lo(gc.x), v[1] * bf_hi(gc.x)); o.y = cvt_pk_bf16(v[2] * bf_lo(gc.y), v[3] * bf_hi(gc.y)); *(u32x2*)(P.O + (size_t)row * 1024 + col) = o; } } }
    } else if constexpr (EPI == EPI_P5) {
#pragma unroll
        for (int ai = 0; ai < 2; ++ai)
#pragma unroll
            for (int m = 0; m < 4; ++m) { const int row = row0 + ai * HALF + m * 16; const float r = rownorm(P.rss, row);
#pragma unroll
                for (int bj = 0; bj < 2; ++bj) { const f32x4 g = acc[ai][bj][m][0] * r, uu = acc[ai][bj][m][1] * r;
                    const int ocol = 16 * (8 * u.pn + 4 * bj + wc) + 4 * fq;
                    u32x2 o; o.x = cvt_pk_bf16(siluf_(g[0]) * uu[0], siluf_(g[1]) * uu[1]); o.y = cvt_pk_bf16(siluf_(g[2]) * uu[2], siluf_(g[3]) * uu[3]);
                    *(u32x2*)(P.O + (size_t)row * DFF + ocol) = o; } }
    } else {
#pragma unroll
        for (int ai = 0; ai < 2; ++ai)
#pragma unroll
            for (int m = 0; m < 4; ++m) { const int row = row0 + ai * HALF + m * 16; float ss = 0.f; float r7 = 0.f;
                if constexpr (EPI == EPI_P7) r7 = rownorm(P.rss, row);
#pragma unroll
                for (int bj = 0; bj < 2; ++bj)
#pragma unroll
                    for (int n = 0; n < 2; ++n) { const int col = col0 + bj * HALF + n * 16; f32x4 v = acc[ai][bj][m][n];
                        f32x4 xv = *(const f32x4*)(P.X + (size_t)row * 1024 + col);
                        if constexpr (EPI == EPI_P7) { const u32x2 up = *(const u32x2*)(P.UPB + (size_t)row * 1024 + col);
                            xv[0] += bf_lo(up.x) * sigmoidf_(v[0] * r7); xv[1] += bf_hi(up.x) * sigmoidf_(v[1] * r7); xv[2] += bf_lo(up.y) * sigmoidf_(v[2] * r7); xv[3] += bf_hi(up.y) * sigmoidf_(v[3] * r7); }
                        else xv += v;
                        *(f32x4*)(P.X + (size_t)row * 1024 + col) = xv;
                        ss += xv[0] * xv[0] + xv[1] * xv[1] + xv[2] * xv[2] + xv[3] * xv[3];
                        const f32x4 gn = *(const f32x4*)(P.gnext + col);
                        u32x2 o; o.x = cvt_pk_bf16(xv[0] * gn[0], xv[1] * gn[1]); o.y = cvt_pk_bf16(xv[2] * gn[2], xv[3] * gn[3]); *(u32x2*)(P.XN + (size_t)row * 1024 + col) = o; }
                ss += shx(ss, 16); ss += shx(ss, 32);
                if (fq == 0) P.rss_next[(size_t)row * 16 + u.pn * 4 + wc] = ss; }
    }
}

template <int EPI>
__device__ __forceinline__ void gemm_phase(LAS uchar* lds, const GPh& P) {
    const int tid = TIDX, wid = __builtin_amdgcn_readfirstlane(tid >> 6), lane = tid & 63, wr = wid >> 2, wc = wid & 3, fr = lane & 15, fq = lane >> 4;
    const int K = P.K, nt = K / BK;
    unsigned voffA[2], voffB[2];
#pragma unroll
    for (int i = 0; i < 2; ++i) { int R, C; stage_rc(tid * 16 + i * 8192, R, C); voffA[i] = (unsigned)(R * P.lda + C) * 2u; voffB[i] = (unsigned)(R * P.ldb + C) * 2u; }
    const size_t kstep = (size_t)(BK * 2);
    const size_t hstepA = (size_t)HALF * P.lda * 2, hstepB = (size_t)HALF * P.ldb * 2;
    const unsigned ldsw = (unsigned)wid * 1024u;
    const int aoff = lds_byte(wr * 64 + fr, fq * 8), boff = lds_byte(wc * 32 + fr, fq * 8);
#define PG8_SA(b, h) (((b) * 2 + (h)) * HTB)
#define PG8_SB(b, h) ((4 + (b) * 2 + (h)) * HTB)
#define PG8_STAGE(bufoff, gbase, voff) do { _Pragma("unroll") for (int _i = 0; _i < 2; ++_i) \
        __builtin_amdgcn_global_load_lds((const unsigned*)((const char*)(gbase) + (voff)[_i]), (LAS unsigned*)(lds + (bufoff) + ldsw + _i * 8192), 16, 0, 0); } while (0)
#define PG8_LDA(dst, b, h) do { _Pragma("unroll") for (int m = 0; m < 4; ++m) _Pragma("unroll") for (int k = 0; k < 2; ++k) dst[m][k] = *(const LAS bf16x8*)(lds + PG8_SA(b, h) + aoff + m * 2048 + k * 1024); } while (0)
#define PG8_LDB(dst, b, h) do { _Pragma("unroll") for (int n = 0; n < 2; ++n) _Pragma("unroll") for (int k = 0; k < 2; ++k) dst[n][k] = *(const LAS bf16x8*)(lds + PG8_SB(b, h) + boff + n * 2048 + k * 1024); } while (0)
#define PG8_MMA(ai, bj, At, Bt) do { __builtin_amdgcn_s_setprio(1); _Pragma("unroll") for (int m = 0; m < 4; ++m) _Pragma("unroll") for (int n = 0; n < 2; ++n) _Pragma("unroll") for (int k = 0; k < 2; ++k) \
        acc[ai][bj][m][n] = __builtin_amdgcn_mfma_f32_16x16x32_bf16(Bt[n][k], At[m][k], acc[ai][bj][m][n], 0, 0, 0); __builtin_amdgcn_s_setprio(0); } while (0)
#define PG8_WAIT_V(n) asm volatile("s_waitcnt vmcnt(" #n ")" ::: "memory")
#define PG8_WAIT_L(n) asm volatile("s_waitcnt lgkmcnt(" #n ")" ::: "memory")
#define PG8_BAR __builtin_amdgcn_s_barrier()
#define PG8_SCHED __builtin_amdgcn_sched_barrier(0)
    Unit cur, nxt; int ui = 0;
    if (!P.next(0, cur)) return;
    f32x4 acc[2][2][4][2];
#pragma unroll
    for (int a = 0; a < 2; ++a)
#pragma unroll
        for (int b = 0; b < 2; ++b)
#pragma unroll
            for (int m = 0; m < 4; ++m)
#pragma unroll
                for (int n = 0; n < 2; ++n) acc[a][b][m][n] = (f32x4){0.f, 0.f, 0.f, 0.f};
    bf16x8 At[4][2], B0[2][2], B1[2][2];
    const char* cA = P.pa(cur); const char* cB = P.pb(cur);
    PG8_STAGE(PG8_SB(0, 0), cB, voffB); PG8_STAGE(PG8_SA(0, 0), cA, voffA); PG8_STAGE(PG8_SB(0, 1), cB + hstepB, voffB); PG8_STAGE(PG8_SA(0, 1), cA + hstepA, voffA);
    if (wr == 1) PG8_BAR;
    PG8_WAIT_V(4); PG8_BAR;
    PG8_STAGE(PG8_SB(1, 0), cB + kstep, voffB); PG8_STAGE(PG8_SA(1, 0), cA + kstep, voffA); PG8_STAGE(PG8_SB(1, 1), cB + hstepB + kstep, voffB);
    PG8_WAIT_V(6); PG8_BAR;
    for (;;) {
        const bool has_next = P.next(ui + 1, nxt);
        const char* nA = has_next ? P.pa(nxt) : cA; const char* nB = has_next ? P.pb(nxt) : cB;
        for (int t = 0; t < nt; t += 2) {
            const bool last = (t == nt - 2);
            const char* a1 = cA + (size_t)(t + 1) * kstep;
            const char* a2 = last ? nA : cA + (size_t)(t + 2) * kstep; const char* b2 = last ? nB : cB + (size_t)(t + 2) * kstep;
            const char* a3 = a2 + kstep; const char* b3 = b2 + kstep;
            PG8_LDB(B0, 0, 0); PG8_SCHED; PG8_LDA(At, 0, 0); PG8_STAGE(PG8_SA(1, 1), a1 + hstepA, voffA);
            PG8_WAIT_L(8); PG8_BAR; PG8_WAIT_L(0); PG8_MMA(0, 0, At, B0); PG8_BAR; PG8_SCHED;
            PG8_LDB(B1, 0, 1); PG8_STAGE(PG8_SB(0, 0), b2, voffB);
            PG8_BAR; PG8_WAIT_L(0); PG8_MMA(0, 1, At, B1); PG8_BAR;
            PG8_LDA(At, 0, 1); PG8_STAGE(PG8_SA(0, 0), a2, voffA);
            PG8_BAR; PG8_WAIT_L(0); PG8_MMA(1, 0, At, B0); PG8_BAR; PG8_SCHED;
            PG8_STAGE(PG8_SB(0, 1), b2 + hstepB, voffB);
            PG8_WAIT_V(6); PG8_BAR; PG8_MMA(1, 1, At, B1); PG8_BAR;
            PG8_LDB(B0, 1, 0); PG8_SCHED; PG8_LDA(At, 1, 0); PG8_STAGE(PG8_SA(0, 1), a2 + hstepA, voffA);
            PG8_WAIT_L(8); PG8_BAR; PG8_WAIT_L(0); PG8_MMA(0, 0, At, B0); PG8_BAR; PG8_SCHED;
            PG8_LDB(B1, 1, 1); PG8_STAGE(PG8_SB(1, 0), b3, voffB);
            PG8_BAR; PG8_WAIT_L(0); PG8_MMA(0, 1, At, B1); PG8_BAR;
            PG8_LDA(At, 1, 1); PG8_STAGE(PG8_SA(1, 0), a3, voffA);
            PG8_BAR; PG8_WAIT_L(0); PG8_MMA(1, 0, At, B0); PG8_BAR; PG8_SCHED;
            PG8_STAGE(PG8_SB(1, 1), b3 + hstepB, voffB);
            PG8_WAIT_V(6); PG8_BAR; PG8_MMA(1, 1, At, B1); PG8_BAR;
        }
        epilogue<EPI>(P, acc, cur, wr, wc, fr, fq);
        if (!has_next) break;
        if (EPI != EPI_P3 || cur.seg == 3) {
#pragma unroll
            for (int a = 0; a < 2; ++a)
#pragma unroll
                for (int b = 0; b < 2; ++b)
#pragma unroll
                    for (int m = 0; m < 4; ++m)
#pragma unroll
                        for (int n = 0; n < 2; ++n) acc[a][b][m][n] = (f32x4){0.f, 0.f, 0.f, 0.f};
        }
        cur = nxt; cA = nA; cB = nB; ++ui;
    }
    PG8_WAIT_V(0);
    if (wr == 0) PG8_BAR;
    PG8_BAR;
#undef PG8_SA
#undef PG8_SB
#undef PG8_STAGE
#undef PG8_LDA
#undef PG8_LDB
#undef PG8_MMA
#undef PG8_WAIT_V
#undef PG8_WAIT_L
#undef PG8_BAR
#undef PG8_SCHED
}

template <int NT, int KS>
__device__ __forceinline__ void wmma(const LAS uchar* A, const LAS uchar* B, int pitch, f32x4 (&acc)[NT], int fr, int fq) {
#pragma unroll 1
    for (int ks = 0; ks < KS; ++ks) {
        const bf16x8 a = *(const LAS bf16x8*)(A + fr * pitch + (ks * 32 + fq * 8) * 2);
#pragma unroll
        for (int ni = 0; ni < NT; ++ni) {
            const bf16x8 b = *(const LAS bf16x8*)(B + (ni * 16 + fr) * pitch + (ks * 32 + fq * 8) * 2);
            acc[ni] = __builtin_amdgcn_mfma_f32_16x16x32_bf16(b, a, acc[ni], 0, 0, 0);
        }
    }
}
constexpr int PB = 272;

__device__ __forceinline__ int map_row(int n, int map) {
    if (map == 1) return n < 2560 ? n : (n < 2576 ? 7168 + (n - 2560) : n - 16);
    if (map == 2) { const int up = n >= DFF, nn = up ? n - DFF : n; return 32 * (nn >> 4) + 16 * up + (nn & 15); }
    return n;
}
__device__ __forceinline__ void tr_tile(LAS float* T, const float* src, int N, bf16_t* dst, int ldd, int dcol0, int k0, int n0, int map) {
    const int tid = TIDX;
    __syncthreads();
#pragma unroll
    for (int ps = 0; ps < 2; ++ps) { const int r = ps * 32 + (tid >> 4), c4 = (tid & 15) * 4; const int n = n0 + c4;
        f32x4 v = (f32x4){0.f, 0.f, 0.f, 0.f}; if (n < N) v = *(const f32x4*)(src + (size_t)(k0 + r) * N + n);
        T[r * 65 + c4 + 0] = v[0]; T[r * 65 + c4 + 1] = v[1]; T[r * 65 + c4 + 2] = v[2]; T[r * 65 + c4 + 3] = v[3]; }
    __syncthreads();
    { const int n = tid >> 3, k8 = (tid & 7) * 8;
        if (n0 + n < N) { u32x4 o; float f[8];
#pragma unroll
            for (int j = 0; j < 8; ++j) f[j] = T[(k8 + j) * 65 + n];
            o.x = cvt_pk_bf16(f[0], f[1]); o.y = cvt_pk_bf16(f[2], f[3]); o.z = cvt_pk_bf16(f[4], f[5]); o.w = cvt_pk_bf16(f[6], f[7]);
            *(u32x4*)(dst + (size_t)map_row(n0 + n, map) * ldd + dcol0 + k0 + k8) = o; } }
}

__device__ void phase_pre(LAS uchar* lds, const Params& P) {
    const int tid = TIDX, G = GDIM, bid = BIDX;
    uchar* ws = (P.ws + launder_z());
    LAS float* T = (LAS float*)lds;
    constexpr int T_IN = 16 * 113, T_BRA = 256, T_BRB = 128, T_OUT = 256, T_GU = 16 * 88, T_DN = 44 * 16, T_PG = 256, T_PU = 64;
    constexpr int T_L = T_IN + T_BRA + T_BRB + T_OUT + T_GU + T_DN + T_PG + T_PU;
    for (int job = bid; job < 4 * T_L; job += G) {
        const int l = job / T_L; int j = job % T_L;
        if (j < T_IN) { tr_tile(T, PIN(I_WIN) + (size_t)l * 1024 * 7184, 7184, (bf16_t*)(ws + WS_WIN) + (size_t)l * NIN * 1024, 1024, 0, (j / 113) * 64, (j % 113) * 64, 1); continue; } j -= T_IN;
        if (j < T_BRA) { tr_tile(T, PIN(I_WBRA) + (size_t)l * 1024 * 1024, 1024, (bf16_t*)(ws + WS_WBR) + (size_t)l * 1024 * 2048, 2048, 0, (j / 16) * 64, (j % 16) * 64, 0); continue; } j -= T_BRA;
        if (j < T_BRB) { tr_tile(T, PIN(I_WBRB) + (size_t)l * 512 * 1024, 1024, (bf16_t*)(ws + WS_WBR) + (size_t)l * 1024 * 2048, 2048, 1024, (j / 16) * 64, (j % 16) * 64, 0); continue; } j -= T_BRB;
        if (j < T_OUT) { tr_tile(T, PIN(I_WOUT) + (size_t)l * 1024 * 1024, 1024, (bf16_t*)(ws + WS_WOUT) + (size_t)l * 1024 * 1024, 1024, 0, (j / 16) * 64, (j % 16) * 64, 0); continue; } j -= T_OUT;
        if (j < T_GU) { tr_tile(T, PIN(I_WGU) + (size_t)l * 1024 * 5632, 5632, (bf16_t*)(ws + WS_WGU) + (size_t)l * 5632 * 1024, 1024, 0, (j / 88) * 64, (j % 88) * 64, 2); continue; } j -= T_GU;
        if (j < T_DN) { tr_tile(T, PIN(I_WDN) + (size_t)l * DFF * 1024, 1024, (bf16_t*)(ws + WS_WDN) + (size_t)l * 1024 * DFF, DFF, 0, (j / 16) * 64, (j % 16) * 64, 0); continue; } j -= T_DN;
        if (j < T_PG) { tr_tile(T, PIN(I_WPG) + (size_t)l * 1024 * 1024, 1024, (bf16_t*)(ws + WS_WPG) + (size_t)l * 1024 * 1024, 1024, 0, (j / 16) * 64, (j % 16) * 64, 0); continue; } j -= T_PG;
        tr_tile(T, PIN(I_WPU) + (size_t)l * 256 * 1024, 1024, (bf16_t*)(ws + WS_WPU) + (size_t)l * 1024 * 256, 256, 0, (j / 16) * 64, (j % 16) * 64, 0);
    }
    {
        LAS float* PW = (LAS float*)lds;
        LAS float* WC = (LAS float*)(lds + 128 * 129 * 4);
        for (int job = bid; job < 4 * 4 * 16; job += G) {
            const int l = job >> 6, g = (job >> 4) & 3, n0 = (job & 15) * 64;
            __syncthreads();
            for (int e = tid; e < 128 * 128; e += NTHR) { const int c = e >> 7, d = e & 127; PW[c * 129 + d] = PIN(I_POOLW)[((size_t)(l * 4 + g) * 128 + c) * 128 + d] * PIN(I_POOLS)[l * 512 + g * 128 + d]; }
            for (int e = tid; e < 128 * 64; e += NTHR) { const int d = e >> 6, n = e & 63; WC[d * 64 + n] = PIN(I_WBRC)[((size_t)l * 512 + g * 128 + d) * 1024 + n0 + n]; }
            __syncthreads();
            const int c = tid & 127, nq = (tid >> 7) * 16;
            float a[16];
#pragma unroll
            for (int i = 0; i < 16; ++i) a[i] = 0.f;
            for (int d = 0; d < 128; ++d) { const float pw = PW[c * 129 + d];
#pragma unroll
                for (int i = 0; i < 16; ++i) a[i] += pw * WC[d * 64 + nq + i]; }
            bf16_t* dst = (bf16_t*)(ws + WS_WBR) + (size_t)l * 1024 * 2048;
#pragma unroll
            for (int i = 0; i < 16; ++i) dst[(size_t)(n0 + nq + i) * 2048 + 1536 + g * 128 + c] = (bf16_t)(cvt_pk_bf16(a[i], 0.f) & 0xffffu);
        }
    }
    {
        const int lane = tid & 63, wv = tid >> 6;
        float* X = (float*)(ws + WS_X); bf16_t* XN = (bf16_t*)(ws + WS_XN); float* RSS = (float*)(ws + WS_RSS);
        const float* g0 = PIN(I_NMIX);
        for (int row = bid * 8 + wv; row < MT; row += G * 8) {
            const float* src = row < MPR ? PIN(I_XP) + (size_t)row * 1024 : PIN(I_XS) + (size_t)(row - MPR) * 1024;
            float ss = 0.f;
#pragma unroll
            for (int i = 0; i < 4; ++i) { const int col = i * 256 + lane * 4; const f32x4 v = *(const f32x4*)(src + col); const f32x4 gg = *(const f32x4*)(g0 + col);
                *(f32x4*)(X + (size_t)row * 1024 + col) = v; ss += v[0] * v[0] + v[1] * v[1] + v[2] * v[2] + v[3] * v[3];
                u32x2 o; o.x = cvt_pk_bf16(v[0] * gg[0], v[1] * gg[1]); o.y = cvt_pk_bf16(v[2] * gg[2], v[3] * gg[3]); *(u32x2*)(XN + (size_t)row * 1024 + col) = o; }
#pragma unroll
            for (int s = 1; s < 64; s <<= 1) ss += shx(ss, s);
            if (lane < 16) RSS[(size_t)row * 16 + lane] = lane == 0 ? ss : 0.f;
        }
    }
    {
        bf16_t* PBF = (bf16_t*)(ws + WS_PBF);
        const size_t n4 = (size_t)4 * MT * 256 / 4;
        for (size_t i = (size_t)bid * NTHR + tid; i < n4; i += (size_t)G * NTHR) {
            const size_t e = i * 4; const int l = (int)(e / ((size_t)MT * 256)); const size_t rem = e % ((size_t)MT * 256); const int row = (int)(rem >> 8), col = (int)(rem & 255);
            const float* src = row < MPR ? PIN(I_PP) + ((size_t)l * MPR + row) * 256 + col : PIN(I_PS) + ((size_t)l * 1024 + (row - MPR)) * 256 + col;
            const f32x4 v = *(const f32x4*)src; u32x2 o; o.x = cvt_pk_bf16(v[0], v[1]); o.y = cvt_pk_bf16(v[2], v[3]); *(u32x2*)(PBF + e) = o;
        }
    }
}

constexpr int L_CS = 0, L_BS = 34816, L_BDT = 69632, L_XT = 104448, L_SB = 121856, L_SC = 139264;
__device__ __forceinline__ int xbc_chan(int cc, int h, int g) { return cc < 64 ? h * 64 + cc : (cc < 192 ? 1024 + g * 128 + (cc - 64) : 1280 + g * 128 + (cc - 192)); }

__device__ void ssd_prompt(LAS uchar* lds, const Params& P, int l, int b, int h) {
    const int tid = TIDX, lane = tid & 63, w = tid >> 6, fr = lane & 15, fq = lane >> 4, g = h >> 3;
    const bf16_t* PROJ = (const bf16_t*)((P.ws + launder_z()) + WS_PROJ); const float* DT = (const float*)((P.ws + launder_z()) + WS_DT);
    bf16_t* Y = (bf16_t*)((P.ws + launder_z()) + WS_Y); float* SSQ = (float*)((P.ws + launder_z()) + WS_SSQ);
    LAS float* acs = (LAS float*)(lds + L_SC); LAS float* dtv = acs + 128; LAS float* eacs = acs + 256; LAS float* decdt = acs + 384;
    const float a_h = -__expf(PIN(I_ALOG)[l * 16 + h]), dtb = PIN(I_DTB)[l * 16 + h], Dh = PIN(I_DSKIP)[l * 16 + h];
    f32x4 S[4];
#pragma unroll
    for (int i = 0; i < 4; ++i) S[i] = (f32x4){0.f, 0.f, 0.f, 0.f};
    const int cg = tid % 40, rsg = tid / 40; const int ch = xbc_chan(cg * 8, h, g);
    for (int c = 0; c < 16; ++c) {
        const int grow0 = b * 2048 + c * 128;
        __syncthreads();
        if (w == 0) {
            const float r0 = DT[(size_t)(grow0 + 2 * lane) * 16 + h], r1 = DT[(size_t)(grow0 + 2 * lane + 1) * 16 + h];
            const float d0 = softplusf_(r0 + dtb), d1 = softplusf_(r1 + dtb); const float a0 = d0 * a_h, a1 = d1 * a_h;
            float inc = a0 + a1;
#pragma unroll
            for (int s = 1; s < 64; s <<= 1) { const float o = __shfl_up(inc, s, 64); if (lane >= s) inc += o; }
            const float tot = __shfl(inc, 63, 64); const float c1 = inc, c0 = inc - a1;
            acs[2 * lane] = c0; acs[2 * lane + 1] = c1; dtv[2 * lane] = d0; dtv[2 * lane + 1] = d1;
            eacs[2 * lane] = __expf(c0); eacs[2 * lane + 1] = __expf(c1); decdt[2 * lane] = __expf(tot - c0) * d0; decdt[2 * lane + 1] = __expf(tot - c1) * d1;
        }
        __syncthreads();
        if (tid < 320) {
    float cw[4][8], cbv[8];
#pragma unroll
        for (int k = 0; k < 4; ++k) { const f32x4 a = *(const f32x4*)(PIN(I_CONVW) + (size_t)(l * 4 + k) * 1536 + ch), cc = *(const f32x4*)(PIN(I_CONVW) + (size_t)(l * 4 + k) * 1536 + ch + 4);
            cw[k][0] = a[0]; cw[k][1] = a[1]; cw[k][2] = a[2]; cw[k][3] = a[3]; cw[k][4] = cc[0]; cw[k][5] = cc[1]; cw[k][6] = cc[2]; cw[k][7] = cc[3]; }
        const f32x4 a = *(const f32x4*)(PIN(I_CONVB) + (size_t)l * 1536 + ch), cc = *(const f32x4*)(PIN(I_CONVB) + (size_t)l * 1536 + ch + 4);
        cbv[0] = a[0]; cbv[1] = a[1]; cbv[2] = a[2]; cbv[3] = a[3]; cbv[4] = cc[0]; cbv[5] = cc[1]; cbv[6] = cc[2]; cbv[7] = cc[3];
            const int lr0 = rsg * 16;
            float hx[3][8];
#pragma unroll
            for (int k = 0; k < 3; ++k) { const int pos = c * 128 + lr0 - 3 + k;
                u32x4 v = (u32x4){0u, 0u, 0u, 0u}; if (pos >= 0) v = *(const u32x4*)(PROJ + (size_t)(b * 2048 + pos) * NPROJ + C_XBC + ch);
                hx[k][0] = bf_lo(v.x); hx[k][1] = bf_hi(v.x); hx[k][2] = bf_lo(v.y); hx[k][3] = bf_hi(v.y); hx[k][4] = bf_lo(v.z); hx[k][5] = bf_hi(v.z); hx[k][6] = bf_lo(v.w); hx[k][7] = bf_hi(v.w); }
#pragma unroll 1
            for (int t2 = 0; t2 < 8; ++t2) {
                const int lr = lr0 + 2 * t2;
                const u32x4 v0 = *(const u32x4*)(PROJ + (size_t)(grow0 + lr) * NPROJ + C_XBC + ch), v1 = *(const u32x4*)(PROJ + (size_t)(grow0 + lr + 1) * NPROJ + C_XBC + ch);
                float x0[8], x1[8], o0[8], o1[8];
                x0[0] = bf_lo(v0.x); x0[1] = bf_hi(v0.x); x0[2] = bf_lo(v0.y); x0[3] = bf_hi(v0.y); x0[4] = bf_lo(v0.z); x0[5] = bf_hi(v0.z); x0[6] = bf_lo(v0.w); x0[7] = bf_hi(v0.w);
                x1[0] = bf_lo(v1.x); x1[1] = bf_hi(v1.x); x1[2] = bf_lo(v1.y); x1[3] = bf_hi(v1.y); x1[4] = bf_lo(v1.z); x1[5] = bf_hi(v1.z); x1[6] = bf_lo(v1.w); x1[7] = bf_hi(v1.w);
#pragma unroll
                for (int j = 0; j < 8; ++j) {
                    o0[j] = siluf_(cbv[j] + cw[0][j] * hx[0][j] + cw[1][j] * hx[1][j] + cw[2][j] * hx[2][j] + cw[3][j] * x0[j]);
                    o1[j] = siluf_(cbv[j] + cw[0][j] * hx[1][j] + cw[1][j] * hx[2][j] + cw[2][j] * x0[j] + cw[3][j] * x1[j]);
                    hx[0][j] = hx[2][j]; hx[1][j] = x0[j]; hx[2][j] = x1[j]; }
                if (cg < 8) {
#pragma unroll
                    for (int j = 0; j < 8; ++j) *(LAS unsigned*)(lds + L_XT + (cg * 8 + j) * PB + lr * 2) = cvt_pk_bf16(o0[j], o1[j]);
                } else if (cg < 24) {
                    const int n0 = (cg - 8) * 8; const float s0 = decdt[lr], s1 = decdt[lr + 1];
                    u32x4 q; q.x = cvt_pk_bf16(o0[0], o0[1]); q.y = cvt_pk_bf16(o0[2], o0[3]); q.z = cvt_pk_bf16(o0[4], o0[5]); q.w = cvt_pk_bf16(o0[6], o0[7]); *(LAS u32x4*)(lds + L_BS + lr * PB + n0 * 2) = q;
                    q.x = cvt_pk_bf16(o1[0], o1[1]); q.y = cvt_pk_bf16(o1[2], o1[3]); q.z = cvt_pk_bf16(o1[4], o1[5]); q.w = cvt_pk_bf16(o1[6], o1[7]); *(LAS u32x4*)(lds + L_BS + (lr + 1) * PB + n0 * 2) = q;
#pragma unroll
                    for (int j = 0; j < 8; ++j) *(LAS unsigned*)(lds + L_BDT + (n0 + j) * PB + lr * 2) = cvt_pk_bf16(o0[j] * s0, o1[j] * s1);
                } else {
                    const int n0 = (cg - 24) * 8;
                    u32x4 q; q.x = cvt_pk_bf16(o0[0], o0[1]); q.y = cvt_pk_bf16(o0[2], o0[3]); q.z = cvt_pk_bf16(o0[4], o0[5]); q.w = cvt_pk_bf16(o0[6], o0[7]); *(LAS u32x4*)(lds + L_CS + lr * PB + n0 * 2) = q;
                    q.x = cvt_pk_bf16(o1[0], o1[1]); q.y = cvt_pk_bf16(o1[2], o1[3]); q.z = cvt_pk_bf16(o1[4], o1[5]); q.w = cvt_pk_bf16(o1[6], o1[7]); *(LAS u32x4*)(lds + L_CS + (lr + 1) * PB + n0 * 2) = q;
                }
            }
        }
        __syncthreads();
        {
            f32x4 cb[8];
#pragma unroll
            for (int i = 0; i < 8; ++i) cb[i] = (f32x4){0.f, 0.f, 0.f, 0.f};
            wmma<8, 4>(lds + L_CS + w * 16 * PB, lds + L_BS, PB, cb, fr, fq);
            __syncthreads();
            const int lrow = 16 * w + fr; const float al = acs[lrow];
#pragma unroll
            for (int ni = 0; ni < 8; ++ni) { const int s0 = ni * 16 + 4 * fq; float mv[4];
#pragma unroll
                for (int e = 0; e < 4; ++e) { const int s = s0 + e; const float dd = fminf(al - acs[s], 0.f); mv[e] = (s <= lrow) ? cb[ni][e] * __expf(dd) * dtv[s] : 0.f; }
                u32x2 o; o.x = cvt_pk_bf16(mv[0], mv[1]); o.y = cvt_pk_bf16(mv[2], mv[3]); *(LAS u32x2*)(lds + L_BS + lrow * PB + s0 * 2) = o; }
        }
        {
            f32x4 y[4];
#pragma unroll
            for (int i = 0; i < 4; ++i) y[i] = (f32x4){0.f, 0.f, 0.f, 0.f};
            const int lrow = 16 * w + fr;
            if (c > 0) { wmma<4, 4>(lds + L_CS + w * 16 * PB, lds + L_SB, PB, y, fr, fq); const float ea = eacs[lrow];
#pragma unroll
                for (int i = 0; i < 4; ++i) y[i] = y[i] * ea; }
            wmma<4, 4>(lds + L_BS + w * 16 * PB, lds + L_XT, PB, y, fr, fq);
            const int row = grow0 + lrow; float ssq = 0.f;
#pragma unroll
            for (int ni = 0; ni < 4; ++ni) { const int p0 = ni * 16 + 4 * fq;
                const u32x2 zz = *(const u32x2*)(PROJ + (size_t)row * NPROJ + C_Z + h * 64 + p0);
                const f32x4 ng = *(const f32x4*)(PIN(I_SSDN) + (size_t)l * 1024 + h * 64 + p0);
                float zf[4] = {bf_lo(zz.x), bf_hi(zz.x), bf_lo(zz.y), bf_hi(zz.y)}; float ov[4];
#pragma unroll
                for (int e = 0; e < 4; ++e) { const float xs = bf1(*(const LAS bf16_t*)(lds + L_XT + (p0 + e) * PB + lrow * 2)); const float v = (y[ni][e] + Dh * xs) * siluf_(zf[e]); ssq += v * v; ov[e] = v * ng[e]; }
                u32x2 o; o.x = cvt_pk_bf16(ov[0], ov[1]); o.y = cvt_pk_bf16(ov[2], ov[3]); *(u32x2*)(Y + (size_t)row * 2048 + h * 64 + p0) = o; }
            ssq += shx(ssq, 16); ssq += shx(ssq, 32);
            if (fq == 0) SSQ[(size_t)row * 16 + h] = ssq;
        }
        __syncthreads();
        {
            const float et = eacs[127];
#pragma unroll
            for (int i = 0; i < 4; ++i) S[i] = S[i] * et;
            wmma<4, 4>(lds + L_XT + (w >> 1) * 16 * PB, lds + L_BDT + (w & 1) * 64 * PB, PB, S, fr, fq);
            const int p = (w >> 1) * 16 + fr;
#pragma unroll
            for (int ni = 0; ni < 4; ++ni) { const int n0 = (w & 1) * 64 + ni * 16 + 4 * fq; u32x2 o; o.x = cvt_pk_bf16(S[ni][0], S[ni][1]); o.y = cvt_pk_bf16(S[ni][2], S[ni][3]); *(LAS u32x2*)(lds + L_SB + p * PB + n0 * 2) = o; }
        }
    }
    {
        float* dst = (P.out + launder_z()) + O_SSMP + ((size_t)((l * 8 + b) * 16 + h) * 64) * 128; const int p = (w >> 1) * 16 + fr;
#pragma unroll
        for (int ni = 0; ni < 4; ++ni) { const int n0 = (w & 1) * 64 + ni * 16 + 4 * fq; *(f32x4*)(dst + (size_t)p * 128 + n0) = S[ni]; }
    }
}

__device__ void ssd_sample(LAS uchar* lds, const Params& P, int l, int b, int hp) {
    const int tid = TIDX, half = tid >> 8, t8 = tid & 255, h = hp * 2 + half, g = h >> 3;
    const bf16_t* PROJ = (const bf16_t*)((P.ws + launder_z()) + WS_PROJ); const float* DT = (const float*)((P.ws + launder_z()) + WS_DT);
    bf16_t* Y = (bf16_t*)((P.ws + launder_z()) + WS_Y); float* SSQ = (float*)((P.ws + launder_z()) + WS_SSQ);
    LAS float* xs = (LAS float*)(lds + half * 16384); LAS float* Bv = xs + 512; LAS float* Cv = xs + 1536; LAS float* sdt = xs + 2560; LAS float* sdec = xs + 2568; LAS float* yv = xs + 2576;
    const int row0 = MPR + b * 8;
    __syncthreads();
    for (int cc = t8; cc < 320; cc += 256) {
        const int ch = xbc_chan(cc, h, g);
        float xv[11];
#pragma unroll
        for (int k = 0; k < 3; ++k) xv[k] = PIN(I_SCONV)[((size_t)(l * 128 + b) * 3 + k) * 1536 + ch];
#pragma unroll
        for (int t = 0; t < 8; ++t) xv[3 + t] = bf1(PROJ[(size_t)(row0 + t) * NPROJ + C_XBC + ch]);
        const float w0 = PIN(I_CONVW)[(size_t)(l * 4 + 0) * 1536 + ch], w1 = PIN(I_CONVW)[(size_t)(l * 4 + 1) * 1536 + ch], w2 = PIN(I_CONVW)[(size_t)(l * 4 + 2) * 1536 + ch], w3 = PIN(I_CONVW)[(size_t)(l * 4 + 3) * 1536 + ch];
        const float cb = PIN(I_CONVB)[(size_t)l * 1536 + ch];
#pragma unroll
        for (int t = 0; t < 8; ++t) { const float o = siluf_(cb + w0 * xv[t] + w1 * xv[t + 1] + w2 * xv[t + 2] + w3 * xv[t + 3]);
            if (cc < 64) xs[t * 64 + cc]= o; else if (cc < 192) Bv[t * 128 + cc - 64] = o; else Cv[t * 128 + cc - 192] = o; }
    }
    if (t8 < 8) { const float d = softplusf_(DT[(size_t)(row0 + t8) * 16 + h] + PIN(I_DTB)[l * 16 + h]); sdt[t8] = d; sdec[t8] = __expf(-d * __expf(PIN(I_ALOG)[l * 16 + h])); }
    __syncthreads();
    const int l16 = t8 & 15, pr = t8 >> 4;
    const float* hin = PIN(I_SSSM) + ((size_t)((l * 128 + b) * 16 + h) * 64) * 128;
    float* hout = (P.out + launder_z()) + O_SSMS + ((size_t)((l * 128 + b) * 16 + h) * 64) * 128;
    f32x4 hs[4][2];
#pragma unroll
    for (int pi = 0; pi < 4; ++pi)
#pragma unroll
        for (int it = 0; it < 2; ++it) hs[pi][it] = *(const f32x4*)(hin + (size_t)(pi * 16 + pr) * 128 + it * 64 + l16 * 4);
#pragma unroll 1
    for (int t = 0; t < 8; ++t) {
        const float dec = sdec[t], dtt = sdt[t];
        const f32x4 B0 = *(const LAS f32x4*)(Bv + t * 128 + l16 * 4), B1 = *(const LAS f32x4*)(Bv + t * 128 + 64 + l16 * 4);
        const f32x4 C0 = *(const LAS f32x4*)(Cv + t * 128 + l16 * 4), C1 = *(const LAS f32x4*)(Cv + t * 128 + 64 + l16 * 4);
#pragma unroll
        for (int pi = 0; pi < 4; ++pi) { const float xd = xs[t * 64 + pi * 16 + pr] * dtt;
            hs[pi][0] = hs[pi][0] * dec + B0 * xd; hs[pi][1] = hs[pi][1] * dec + B1 * xd;
            const f32x4 q = hs[pi][0] * C0 + hs[pi][1] * C1; float yp = q[0] + q[1] + q[2] + q[3];
            yp += shx(yp, 1); yp += shx(yp, 2); yp += shx(yp, 4); yp += shx(yp, 8);
            if (l16 == 0) yv[t * 64 + pi * 16 + pr] = yp; }
    }
#pragma unroll
    for (int pi = 0; pi < 4; ++pi)
#pragma unroll
        for (int it = 0; it < 2; ++it) *(f32x4*)(hout + (size_t)(pi * 16 + pr) * 128 + it * 64 + l16 * 4) = hs[pi][it];
    __syncthreads();
    {
        const int t = t8 >> 5, p0 = (t8 & 31) * 2, row = row0 + t; const float Dh = PIN(I_DSKIP)[l * 16 + h];
        const unsigned zz = *(const unsigned*)(PROJ + (size_t)row * NPROJ + C_Z + h * 64 + p0);
        const float v0 = (yv[t * 64 + p0] + Dh * xs[t * 64 + p0]) * siluf_(bf_lo(zz)), v1 = (yv[t * 64 + p0 + 1] + Dh * xs[t * 64 + p0 + 1]) * siluf_(bf_hi(zz));
        float ssq = v0 * v0 + v1 * v1;
        ssq += shx(ssq, 1); ssq += shx(ssq, 2); ssq += shx(ssq, 4); ssq += shx(ssq, 8); ssq += shx(ssq, 16);
        *(unsigned*)(Y + (size_t)row * 2048 + h * 64 + p0) = cvt_pk_bf16(v0 * PIN(I_SSDN)[(size_t)l * 1024 + h * 64 + p0], v1 * PIN(I_SSDN)[(size_t)l * 1024 + h * 64 + p0 + 1]);
        if ((t8 & 31) == 0) SSQ[(size_t)row * 16 + h] = ssq;
    }
}

__device__ void sgu_prompt(LAS uchar* lds, const Params& P, int l, int b, int c, int g) {
    const int tid = TIDX, lane = tid & 63, w = tid >> 6, fr = lane & 15, fq = lane >> 4;
    const bf16_t* PROJ = (const bf16_t*)((P.ws + launder_z()) + WS_PROJ); bf16_t* Y = (bf16_t*)((P.ws + launder_z()) + WS_Y);
    LAS float* smu = (LAS float*)(lds + 69632); LAS float* srs = smu + 128;
    const int grow0 = b * 2048 + c * 128;
    __syncthreads();
    {
        const int r = tid >> 2, q = tid & 3; const bf16_t* src = PROJ + (size_t)(grow0 + r) * NPROJ + C_V + q * 128;
        float s = 0.f, s2 = 0.f;
#pragma unroll
        for (int i = 0; i < 16; ++i) { const u32x4 v = *(const u32x4*)(src + i * 8);
            const float f[8] = {bf_lo(v.x), bf_hi(v.x), bf_lo(v.y), bf_hi(v.y), bf_lo(v.z), bf_hi(v.z), bf_lo(v.w), bf_hi(v.w)};
#pragma unroll
            for (int j = 0; j < 8; ++j) { s += f[j]; s2 += f[j] * f[j]; } }
        s += shx(s, 1); s += shx(s, 2); s2 += shx(s2, 1); s2 += shx(s2, 2);
        const float mu = s * (1.0f / 512.0f), var = fmaxf(s2 * (1.0f / 512.0f) - mu * mu, 0.f);
        if (q == 0) { smu[r] = mu; srs[r] = rsqrtf(var + EPS); }
        const float* wsrc = PIN(I_WSP) + ((size_t)(l * 4 + g) * 128 + r) * 128 + q * 32;
#pragma unroll
        for (int i = 0; i < 4; ++i) { const f32x4 a = *(const f32x4*)(wsrc + i * 8), bb = *(const f32x4*)(wsrc + i * 8 + 4); const int s0 = q * 32 + i * 8;
            u32x4 o; o.x = cvt_pk_bf16(s0 + 0 <= r ? a[0] : 0.f, s0 + 1 <= r ? a[1] : 0.f); o.y = cvt_pk_bf16(s0 + 2 <= r ? a[2] : 0.f, s0 + 3 <= r ? a[3] : 0.f);
            o.z = cvt_pk_bf16(s0 + 4 <= r ? bb[0] : 0.f, s0 + 5 <= r ? bb[1] : 0.f); o.w = cvt_pk_bf16(s0 + 6 <= r ? bb[2] : 0.f, s0 + 7 <= r ? bb[3] : 0.f);
            *(LAS u32x4*)(lds + r * PB + s0 * 2) = o; }
    }
    __syncthreads();
    {
        const int r = tid >> 2, q = tid & 3; const bf16_t* src = PROJ + (size_t)(grow0 + r) * NPROJ + C_V + g * 128 + q * 32;
        const float mu = smu[r], rs = srs[r];
        const float* lg = PIN(I_LNG) + (size_t)l * 512 + g * 128 + q * 32; const float* lb = PIN(I_LNB) + (size_t)l * 512 + g * 128 + q * 32;
        float* vout = (P.out + launder_z()) + O_VP + ((size_t)(l * 8 + b) * 128 + r) * 512 + g * 128 + q * 32;
#pragma unroll
        for (int i = 0; i < 4; ++i) { const u32x4 v = *(const u32x4*)(src + i * 8);
            const float f[8] = {bf_lo(v.x), bf_hi(v.x), bf_lo(v.y), bf_hi(v.y), bf_lo(v.z), bf_hi(v.z), bf_lo(v.w), bf_hi(v.w)}; float vn[8];
#pragma unroll
            for (int j = 0; j < 8; ++j) { vn[j] = (f[j] - mu) * rs * lg[i * 8 + j] + lb[i * 8 + j];
                *(LAS bf16_t*)(lds + 34816 + (q * 32 + i * 8 + j) * PB + r * 2) = (bf16_t)(cvt_pk_bf16(vn[j], 0.f) & 0xffffu); }
            if (c == 15) { *(f32x4*)(vout + i * 8) = (f32x4){vn[0], vn[1], vn[2], vn[3]}; *(f32x4*)(vout + i * 8 + 4) = (f32x4){vn[4], vn[5], vn[6], vn[7]}; } }
    }
    __syncthreads();
    {
        f32x4 acc[8];
#pragma unroll
        for (int i = 0; i < 8; ++i) acc[i] = (f32x4){0.f, 0.f, 0.f, 0.f};
        wmma<8, 4>(lds + w * 16 * PB, lds + 34816, PB, acc, fr, fq);
        const int t = 16 * w + fr, row = grow0 + t; const float bs = PIN(I_BSP)[(size_t)(l * 4 + g) * 128 + t];
#pragma unroll
        for (int ni = 0; ni < 8; ++ni) { const int d0 = ni * 16 + 4 * fq; const u32x2 uu = *(const u32x2*)(PROJ + (size_t)row * NPROJ + C_U + g * 128 + d0);
            u32x2 o; o.x = cvt_pk_bf16(bf_lo(uu.x) * (acc[ni][0] + bs), bf_hi(uu.x) * (acc[ni][1] + bs)); o.y = cvt_pk_bf16(bf_lo(uu.y) * (acc[ni][2] + bs), bf_hi(uu.y) * (acc[ni][3] + bs));
            *(u32x2*)(Y + (size_t)row * 2048 + 1024 + g * 128 + d0) = o; }
    }
}

__device__ void sgu_sample(LAS uchar* lds, const Params& P, int l, int b) {
    const int tid = TIDX, lane = tid & 63, w = tid >> 6, ch = tid, g = ch >> 7;
    const bf16_t* PROJ = (const bf16_t*)((P.ws + launder_z()) + WS_PROJ); bf16_t* Y = (bf16_t*)((P.ws + launder_z()) + WS_Y);
    LAS float* red = (LAS float*)lds;
    const int row0 = MPR + b * 8;
    float v[8], u[8];
#pragma unroll
    for (int s = 0; s < 8; ++s) { v[s] = bf1(PROJ[(size_t)(row0 + s) * NPROJ + C_V + ch]); u[s] = bf1(PROJ[(size_t)(row0 + s) * NPROJ + C_U + ch]); }
    __syncthreads();
#pragma unroll
    for (int s = 0; s < 8; ++s) { float a = v[s], a2 = v[s] * v[s];
#pragma unroll
        for (int m = 1; m < 64; m <<= 1) { a += shx(a, m); a2 += shx(a2, m); }
        if (lane == 0) { red[w * 16 + s] = a; red[w * 16 + 8 + s] = a2; } }
    __syncthreads();
    const float lg = PIN(I_LNG)[(size_t)l * 512 + ch], lb = PIN(I_LNB)[(size_t)l * 512 + ch];
    float vn[8];
#pragma unroll
    for (int s = 0; s < 8; ++s) { float a = 0.f, a2 = 0.f;
#pragma unroll
        for (int ww = 0; ww < 8; ++ww) { a += red[ww * 16 + s]; a2 += red[ww * 16 + 8 + s]; }
        const float mu = a * (1.0f / 512.0f), var = fmaxf(a2 * (1.0f / 512.0f) - mu * mu, 0.f);
        vn[s] = (v[s] - mu) * rsqrtf(var + EPS) * lg + lb;
        (P.out + launder_z())[O_VS + ((size_t)(l * 128 + b) * 8 + s) * 512 + ch] = vn[s]; }
    const float* W = PIN(I_WSP) + (size_t)(l * 4 + g) * 128 * 128; const float* bsp = PIN(I_BSP) + (size_t)(l * 4 + g) * 128;
#pragma unroll
    for (int t = 0; t < 8; ++t) { float o = bsp[t];
#pragma unroll
        for (int s = 0; s <= t; ++s) o += W[t * 128 + s] * vn[s];
        Y[(size_t)(row0 + t) * 2048 + 1024 + ch] = (bf16_t)(cvt_pk_bf16(u[t] * o, 0.f) & 0xffffu); }
}

__device__ void pool_prompt(const Params& P, int tile) {
    const int tid = TIDX, cgp = tid & 63, rsg = tid >> 6, ch0 = cgp * 8, wdw = 2 << (cgp >> 4);
    const bf16_t* PROJ = (const bf16_t*)((P.ws + launder_z()) + WS_PROJ); bf16_t* Y = (bf16_t*)((P.ws + launder_z()) + WS_Y);
    const int b = tile >> 4, pos0 = (tile & 15) * 128 + rsg * 16; const size_t rbase = (size_t)b * 2048;
    float S[8];
#pragma unroll
    for (int j = 0; j < 8; ++j) S[j] = 0.f;
    for (int k = 1; k < wdw; ++k) { const int pos = pos0 - k; if (pos >= 0) { const u32x4 v = *(const u32x4*)(PROJ + (rbase + pos) * NPROJ + C_POOL + ch0);
        S[0] += bf_lo(v.x); S[1] += bf_hi(v.x); S[2] += bf_lo(v.y); S[3] += bf_hi(v.y); S[4] += bf_lo(v.z); S[5] += bf_hi(v.z); S[6] += bf_lo(v.w); S[7] += bf_hi(v.w); } }
#pragma unroll 1
    for (int t = 0; t < 16; ++t) { const int pos = pos0 + t;
        const u32x4 v = *(const u32x4*)(PROJ + (rbase + pos) * NPROJ + C_POOL + ch0);
        const float x[8] = {bf_lo(v.x), bf_hi(v.x), bf_lo(v.y), bf_hi(v.y), bf_lo(v.z), bf_hi(v.z), bf_lo(v.w), bf_hi(v.w)};
        const float ic = 1.0f / (float)min(pos + 1, wdw); float d[8];
#pragma unroll
        for (int j = 0; j < 8; ++j) { S[j] += x[j]; d[j] = S[j] * ic - x[j]; }
        u32x4 o; o.x = cvt_pk_bf16(d[0], d[1]); o.y = cvt_pk_bf16(d[2], d[3]); o.z = cvt_pk_bf16(d[4], d[5]); o.w = cvt_pk_bf16(d[6], d[7]);
        *(u32x4*)(Y + (rbase + pos) * 2048 + 1536 + ch0) = o;
        const int po = pos - wdw + 1;
        if (po >= 0) { const u32x4 q = *(const u32x4*)(PROJ + (rbase + po) * NPROJ + C_POOL + ch0);
            S[0] -= bf_lo(q.x); S[1] -= bf_hi(q.x); S[2] -= bf_lo(q.y); S[3] -= bf_hi(q.y); S[4] -= bf_lo(q.z); S[5] -= bf_hi(q.z); S[6] -= bf_lo(q.w); S[7] -= bf_hi(q.w); } }
}
__device__ void pool_sample(const Params& P, int l, int si) {
    const int tid = TIDX, cgp = tid & 63, ch0 = cgp * 8, wdw = 2 << (cgp >> 4), b = si * 8 + (tid >> 6);
    const bf16_t* PROJ = (const bf16_t*)((P.ws + launder_z()) + WS_PROJ); bf16_t* Y = (bf16_t*)((P.ws + launder_z()) + WS_Y);
    const float* buf = PIN(I_SPOOL) + (size_t)(l * 128 + b) * 15 * 512 + ch0;
    const size_t rbase = (size_t)MPR + b * 8;
    float S[8];
#pragma unroll
    for (int j = 0; j < 8; ++j) S[j] = 0.f;
    for (int k = 1; k < wdw; ++k) { const f32x4 a = *(const f32x4*)(buf + (size_t)(15 - k) * 512), c = *(const f32x4*)(buf + (size_t)(15 - k) * 512 + 4);
        S[0] += a[0]; S[1] += a[1]; S[2] += a[2]; S[3] += a[3]; S[4] += c[0]; S[5] += c[1]; S[6] += c[2]; S[7] += c[3]; }
    const float ic = 1.0f / (float)wdw;
#pragma unroll 1
    for (int t = 0; t < 8; ++t) {
        const u32x4 v = *(const u32x4*)(PROJ + (rbase + t) * NPROJ + C_POOL + ch0);
        const float x[8] = {bf_lo(v.x), bf_hi(v.x), bf_lo(v.y), bf_hi(v.y), bf_lo(v.z), bf_hi(v.z), bf_lo(v.w), bf_hi(v.w)}; float d[8];
#pragma unroll
        for (int j = 0; j < 8; ++j) { S[j] += x[j]; d[j] = S[j] * ic - x[j]; }
        u32x4 o; o.x = cvt_pk_bf16(d[0], d[1]); o.y = cvt_pk_bf16(d[2], d[3]); o.z = cvt_pk_bf16(d[4], d[5]); o.w = cvt_pk_bf16(d[6], d[7]);
        *(u32x4*)(Y + (rbase + t) * 2048 + 1536 + ch0) = o;
        const int po = t - wdw + 1;
        if (po >= 0) { const u32x4 q = *(const u32x4*)(PROJ + (rbase + po) * NPROJ + C_POOL + ch0);
            S[0] -= bf_lo(q.x); S[1] -= bf_hi(q.x); S[2] -= bf_lo(q.y); S[3] -= bf_hi(q.y); S[4] -= bf_lo(q.z); S[5] -= bf_hi(q.z); S[6] -= bf_lo(q.w); S[7] -= bf_hi(q.w); }
        else { const f32x4 a = *(const f32x4*)(buf + (size_t)(15 + po) * 512), c = *(const f32x4*)(buf + (size_t)(15 + po) * 512 + 4);
            S[0] -= a[0]; S[1] -= a[1]; S[2] -= a[2]; S[3] -= a[3]; S[4] -= c[0]; S[5] -= c[1]; S[6] -= c[2]; S[7] -= c[3]; } }
}
constexpr int NC_CP = 8 * 3 * 1536, NC_CS = 128 * 3 * 1536, NC_PP = 8 * 15 * 512, NC_PS = 128 * 15 * 512, NC_ALL = NC_CP + NC_CS + NC_PP + NC_PS;
__device__ void state_copy(const Params& P, int l, int item) {
    const bf16_t* PROJ = (const bf16_t*)((P.ws + launder_z()) + WS_PROJ);
    for (int j = 0; j < 16; ++j) { int e = item * 8192 + j * NTHR + TIDX; if (e >= NC_ALL) return;
        if (e < NC_CP) { const int ch = e % 1536, k = (e / 1536) % 3, b = e / 4608; (P.out + launder_z())[O_CONVP + (size_t)l * NC_CP + e] = bf1(PROJ[(size_t)(b * 2048 + 2045 + k) * NPROJ + C_XBC + ch]); continue; } e -= NC_CP;
        if (e < NC_CS) { const int ch = e % 1536, k = (e / 1536) % 3, b = e / 4608; (P.out + launder_z())[O_CONVS + (size_t)l * NC_CS + e] = bf1(PROJ[(size_t)(MPR + b * 8 + 5 + k) * NPROJ + C_XBC + ch]); continue; } e -= NC_CS;
        if (e < NC_PP) { const int ch = e % 512, k = (e / 512) % 15, b = e / 7680; (P.out + launder_z())[O_POOLP + (size_t)l * NC_PP + e] = bf1(PROJ[(size_t)(b * 2048 + 2033 + k) * NPROJ + C_POOL + ch]); continue; } e -= NC_PP;
        { const int ch = e % 512, k = (e / 512) % 15, b = e / 7680;
          (P.out + launder_z())[O_POOLS + (size_t)l * NC_PS + e] = k < 7 ? PIN(I_SPOOL)[((size_t)(l * 128 + b) * 15 + 8 + k) * 512 + ch] : bf1(PROJ[(size_t)(MPR + b * 8 + (k - 7)) * NPROJ + C_POOL + ch]); }
    }
}

__device__ void phase_mixer(LAS uchar* lds, const Params& P, int l) {
    const int G = GDIM, bid = BIDX;
    constexpr int N_B = 1024, N_C = 512, N_D = 128, N_E = 128, N_E2 = 16, N_F = (NC_ALL + 8191) / 8192;
    constexpr int N_REST = N_B + N_C + N_D + N_E + N_E2 + N_F;
    int start, step;
    if (G > 128) { if (bid < 128) { ssd_prompt(lds, P, l, bid >> 4, bid & 15); start = -1; step = 1; } else { start = bid - 128; step = G - 128; } }
    else { for (int i = bid; i < 128; i += G) ssd_prompt(lds, P, l, i >> 4, i & 15); start = bid; step = G; }
    if (start < 0) return;
    for (int it = start; it < N_REST; it += step) {
        int j = it;
        if (j < N_C) { sgu_prompt(lds, P, l, j >> 6, (j >> 2) & 15, j & 3); continue; } j -= N_C;
        if (j < N_B) { ssd_sample(lds, P, l, j >> 3, j & 7); continue; } j -= N_B;
        if (j < N_D) { sgu_sample(lds, P, l, j); continue; } j -= N_D;
        if (j < N_E) { pool_prompt(P, j); continue; } j -= N_E;
        if (j < N_E2) { pool_sample(P, l, j); continue; } j -= N_E2;
        state_copy(P, l, j);
    }
}

__device__ __forceinline__ void run_phase(LAS uchar* lds, const Params& P, int ph) {
    uchar* ws = (P.ws + launder_z());
    float* RSS = (float*)(ws + WS_RSS);
    if (ph == 0) { phase_pre(lds, P); return; }
    if (ph == 30) {
        const int tid = TIDX, lane = tid & 63, wv = tid >> 6; const float* X = (const float*)(ws + WS_X); const float* fg = PIN(I_FN);
        for (int row = BIDX * 8 + wv; row < MT; row += GDIM * 8) { const float r = rownorm(RSS + (size_t)12 * MT * 16, row);
#pragma unroll
            for (int i = 0; i < 4; ++i) { const int col = i * 256 + lane * 4; const f32x4 v = *(const f32x4*)(X + (size_t)row * 1024 + col), gg = *(const f32x4*)(fg + col);
                *(f32x4*)((P.out + launder_z()) + O_Y + (size_t)row * 1024 + col) = (f32x4){v[0] * r * gg[0], v[1] * r * gg[1], v[2] * r * gg[2], v[3] * r * gg[3]}; } }
        return; }
    const int l = ph >= 2 ? (ph - 2) / 7 : 0, s = ph >= 2 ? (ph - 2) % 7 : -1;
    if (s == 1) { phase_mixer(lds, P, l); return; }
    bf16_t* xn_cur = (bf16_t*)(ws + ((l & 1) ? WS_XN2 : WS_XN)); bf16_t* xn_alt = (bf16_t*)(ws + ((l & 1) ? WS_XN : WS_XN2));
#define GINIT GPh g; g.G = GDIM; g.c = BIDX; g.nseg = 1; g.nlay = 1; g.a_lay = 0; g.b_lay = 0; g.nM = MT / 256; \
    g.rss = nullptr; g.rss_next = nullptr; g.gnext = nullptr; g.X = (float*)(ws + WS_X); g.XN = xn_alt; g.O = nullptr; g.DT = (float*)(ws + WS_DT); \
    g.PROJ = (const bf16_t*)(ws + WS_PROJ); g.SSQ = (const float*)(ws + WS_SSQ); g.UPB = nullptr; \
    g.A = xn_cur; g.lda = 1024; g.ldb = 1024; g.K = 1024; g.nN = 4;
    switch (s) {
    case -1: { GINIT g.A = (const bf16_t*)(ws + WS_PBF); g.Bt = (const bf16_t*)(ws + WS_WPU); g.lda = 256; g.ldb = 256; g.K = 256; g.nlay = 4; g.a_lay = (size_t)MT * 256; g.b_lay = (size_t)1024 * 256;
        g.O = (bf16_t*)(ws + WS_UP); gemm_phase<EPI_UP>(lds, g); } break;
    case 0: { GINIT g.Bt = (const bf16_t*)(ws + WS_WIN) + (size_t)l * NIN * 1024; g.nN = NIN / 256;
        g.rss = RSS + (size_t)(3 * l) * MT * 16; g.O = (bf16_t*)(ws + WS_PROJ); gemm_phase<EPI_P1>(lds, g); } break;
    case 2: { GINIT g.A = (const bf16_t*)(ws + WS_Y); g.Bt = (const bf16_t*)(ws + WS_WBR) + (size_t)l * 1024 * 2048; g.lda = 2048; g.ldb = 2048; g.K = 512; g.nseg = 4;
        g.O = (bf16_t*)(ws + WS_MRG); gemm_phase<EPI_P3>(lds, g); } break;
    case 3: { GINIT g.A = (const bf16_t*)(ws + WS_MRG); g.Bt = (const bf16_t*)(ws + WS_WOUT) + (size_t)l * 1024 * 1024;
        g.rss_next = RSS + (size_t)(3 * l + 1) * MT * 16; g.gnext = PIN(I_NFFN) + (size_t)l * 1024; gemm_phase<EPI_P4>(lds, g); } break;
    case 4: { GINIT g.A = xn_alt; g.Bt = (const bf16_t*)(ws + WS_WGU) + (size_t)l * 5632 * 1024; g.nN = 22;
        g.rss = RSS + (size_t)(3 * l + 1) * MT * 16; g.O = (bf16_t*)(ws + WS_ACT); gemm_phase<EPI_P5>(lds, g); } break;
    case 5: { GINIT g.A = (const bf16_t*)(ws + WS_ACT); g.Bt = (const bf16_t*)(ws + WS_WDN) + (size_t)l * 1024 * DFF; g.lda = DFF; g.ldb = DFF; g.K = DFF;
        g.XN = xn_cur; g.rss_next = RSS + (size_t)(3 * l + 2) * MT * 16; g.gnext = PIN(I_NPLE) + (size_t)l * 1024; gemm_phase<EPI_P6>(lds, g); } break;
    default: { GINIT g.Bt = (const bf16_t*)(ws + WS_WPG) + (size_t)l * 1024 * 1024;
        g.rss = RSS + (size_t)(3 * l + 2) * MT * 16; g.rss_next = RSS + (size_t)(3 * l + 3) * MT * 16; g.gnext = l < 3 ? PIN(I_NMIX) + (size_t)(l + 1) * 1024 : PIN(I_FN);
        g.UPB = (const bf16_t*)(ws + WS_UP) + (size_t)l * MT * 1024; gemm_phase<EPI_P7>(lds, g); } break;
    }
#undef GINIT
}

__global__ void __launch_bounds__(NTHR, 2) hybrid_fwd(Params P) {
    extern __shared__ __attribute__((aligned(16))) uchar smem[];
    LAS uchar* lds = (LAS uchar*)smem;
    cg::grid_group grid = cg::this_grid();
    for (int ph = P.ph_lo; ph < P.ph_hi; ++ph) {
        run_phase(lds, P, ph);
        if (ph + 1 < P.ph_hi) {
            asm volatile("s_waitcnt vmcnt(0)" ::: "memory");
            __syncthreads();
            if (threadIdx.x < 64) { __builtin_amdgcn_fence(__ATOMIC_RELEASE, "agent"); asm volatile("s_waitcnt vmcnt(0)" ::: "memory"); }
            __syncthreads();
            grid.sync();
            if (threadIdx.x < 64) { __builtin_amdgcn_fence(__ATOMIC_ACQUIRE, "agent"); asm volatile("s_waitcnt vmcnt(0)" ::: "memory"); }
            __syncthreads();
        }
    }
}

extern "C" void kernel_launch(void* const* d_in, const int* in_sizes, int n_in, void* d_out, int out_size, void* d_ws, size_t ws_size, hipStream_t stream) {
    static int grid = 0;
    if (grid == 0) {
        if (n_in != 32 || (size_t)out_size != O_END || ws_size < WS_END) { fprintf(stderr, "kernel_launch: shape mismatch n_in %d out %d (want %zu) ws %zu (want %zu)\n", n_in, out_size, (size_t)O_END, ws_size, (size_t)WS_END); grid = -1; return; }
        int dev = 0, cus = 0, per_cu = 0;
        hipGetDevice(&dev); hipDeviceGetAttribute(&cus, hipDeviceAttributeMultiprocessorCount, dev);
        if (hipFuncSetAttribute((const void*)hybrid_fwd, hipFuncAttributeMaxDynamicSharedMemorySize, LDS_BYTES) != hipSuccess) { fprintf(stderr, "kernel_launch: hipFuncSetAttribute failed\n"); grid = -1; return; }
        hipOccupancyMaxActiveBlocksPerMultiprocessor(&per_cu, (const void*)hybrid_fwd, NTHR, LDS_BYTES);
        if (per_cu < 1) { fprintf(stderr, "kernel_launch: occupancy query says %d blocks per CU\n", per_cu); per_cu = 1; }
        grid = cus * 1;
        fprintf(stderr, "kernel_launch: cus %d per_cu %d grid %d\n", cus, per_cu, grid);
    }
    if (grid < 0) return;
    Params p{};
    for (int i = 0; i < 32; ++i) p.in[i] = (const float*)d_in[i];
    p.out = (float*)d_out; p.ws = (uchar*)d_ws;
#if MULTI_LAUNCH
    for (int ph = 0; ph < 31; ++ph) { p.ph_lo = ph; p.ph_hi = ph + 1; hipLaunchKernelGGL(hybrid_fwd, dim3(grid), dim3(NTHR), LDS_BYTES, stream, p); }
#else
    p.ph_lo = 0; p.ph_hi = 31;
    void* args[] = {&p};
    hipError_t e = hipLaunchCooperativeKernel((const void*)hybrid_fwd, dim3(grid), dim3(NTHR), args, LDS_BYTES, stream);
    if (e != hipSuccess) fprintf(stderr, "cooperative launch failed: %s (grid %d)\n", hipGetErrorString(e), grid);
#endif
}
```

```cpp
#include <hip/hip_runtime.h>
#include <hip/hip_cooperative_groups.h>
#include <cstdio>
namespace cg = cooperative_groups;

#define LAS __attribute__((address_space(3)))
typedef unsigned short bf16_t;
typedef unsigned char uchar;
typedef short bf16x8 __attribute__((ext_vector_type(8)));
typedef float f32x4 __attribute__((ext_vector_type(4)));
typedef unsigned u32x4 __attribute__((ext_vector_type(4)));
typedef unsigned u32x2 __attribute__((ext_vector_type(2)));

#ifndef MULTI_LAUNCH
#define MULTI_LAUNCH 0
#endif

constexpr int MT = 17408, MPR = 16384, DM = 1024, NPROJ = 7168, NIN = 7424, DFF = 2816;
constexpr float EPS = 1e-6f;
constexpr int NTHR = 512;
constexpr int LDS_BYTES = 141312;
constexpr int C_Z = 0, C_XBC = 1024, C_U = 2560, C_V = 3072, C_POOL = 3584, C_GA = 4096, C_GB = 5120, C_GC = 6144;
constexpr size_t al256(size_t x) { return (x + 255) & ~(size_t)255; }
constexpr size_t WS_WIN = 0;
constexpr size_t WS_WBR = WS_WIN + (size_t)4 * NIN * 1024 * 2;
constexpr size_t WS_WOUT = WS_WBR + (size_t)4 * 1024 * 2048 * 2;
constexpr size_t WS_WGU = WS_WOUT + (size_t)4 * 1024 * 1024 * 2;
constexpr size_t WS_WDN = WS_WGU + (size_t)4 * 5632 * 1024 * 2;
constexpr size_t WS_WPG = WS_WDN + (size_t)4 * 1024 * 2816 * 2;
constexpr size_t WS_WPU = WS_WPG + (size_t)4 * 1024 * 1024 * 2;
constexpr size_t WS_X = WS_WPU + (size_t)4 * 1024 * 256 * 2;
constexpr size_t WS_XN = WS_X + (size_t)MT * 1024 * 4;
constexpr size_t WS_RSS = WS_XN + (size_t)MT * 1024 * 2;
constexpr size_t WS_PROJ = al256(WS_RSS + (size_t)13 * MT * 16 * 4);
constexpr size_t WS_DT = WS_PROJ + (size_t)MT * NPROJ * 2;
constexpr size_t WS_Y = WS_DT + (size_t)MT * 16 * 4;
constexpr size_t WS_SSQ = WS_Y + (size_t)MT * 2048 * 2;
constexpr size_t WS_MRG = WS_SSQ + (size_t)MT * 16 * 4;
constexpr size_t WS_ACT = WS_MRG + (size_t)MT * 1024 * 2;
constexpr size_t WS_UP = WS_ACT + (size_t)MT * DFF * 2;
constexpr size_t WS_PBF = WS_UP + (size_t)4 * MT * 1024 * 2;
constexpr size_t WS_XN2 = WS_PBF + (size_t)4 * MT * 256 * 2;
constexpr size_t WS_BAR = WS_XN2 + (size_t)MT * 1024 * 2;
constexpr size_t WS_END = WS_BAR + 16384;
constexpr size_t O_Y = 0;
constexpr size_t O_CONVP = (size_t)MT * 1024;
constexpr size_t O_SSMP = O_CONVP + (size_t)4 * 8 * 3 * 1536;
constexpr size_t O_POOLP = O_SSMP + (size_t)4 * 8 * 16 * 64 * 128;
constexpr size_t O_VP = O_POOLP + (size_t)4 * 8 * 15 * 512;
constexpr size_t O_CONVS = O_VP + (size_t)4 * 8 * 128 * 512;
constexpr size_t O_SSMS = O_CONVS + (size_t)4 * 128 * 3 * 1536;
constexpr size_t O_POOLS = O_SSMS + (size_t)4 * 128 * 16 * 64 * 128;
constexpr size_t O_VS = O_POOLS + (size_t)4 * 128 * 15 * 512;
constexpr size_t O_END = O_VS + (size_t)4 * 128 * 8 * 512;

struct Params {
    const float* in[32];
    float* out;
    uchar* ws;
    int ph_lo, ph_hi;
};
enum { I_XP = 0, I_XS, I_SCONV, I_SSSM, I_SPOOL, I_PP, I_PS, I_NMIX, I_WIN, I_CONVW, I_CONVB, I_DTB, I_ALOG, I_DSKIP, I_SSDN, I_LNG, I_LNB, I_WSP, I_BSP,
       I_POOLW, I_POOLS, I_WBRA, I_WBRB, I_WBRC, I_WOUT, I_NFFN, I_WGU, I_WDN, I_NPLE, I_WPG, I_WPU, I_FN };


__device__ __forceinline__ int launder_s(int i) { asm volatile("" : "+s"(i)); return i; }
__device__ __forceinline__ int launder_v(int i) { asm volatile("" : "+v"(i)); return i; }
template <class T> __device__ __forceinline__ T* launder_p(T* p) { asm volatile("" : "+s"(p)); return p; }
__device__ __forceinline__ size_t launder_z() { size_t z = 0; asm volatile("" : "+s"(z)); return z; }
typedef const float __attribute__((address_space(1)))* gcf_t;
#define PIN(i) ((const float*)(gcf_t)(P.in[launder_s(i)]))
#define TIDX launder_v((int)threadIdx.x)
#define BIDX launder_s((int)blockIdx.x)
#define GDIM launder_s((int)gridDim.x)
__device__ __forceinline__ unsigned cvt_pk_bf16(float lo, float hi) { unsigned r; asm("v_cvt_pk_bf16_f32 %0, %1, %2" : "=v"(r) : "v"(lo), "v"(hi)); return r; }
__device__ __forceinline__ float bf_lo(unsigned w) { return __uint_as_float(w << 16); }
__device__ __forceinline__ float bf_hi(unsigned w) { return __uint_as_float(w & 0xffff0000u); }
__device__ __forceinline__ float bf1(bf16_t b) { return __uint_as_float(((unsigned)b) << 16); }
__device__ __forceinline__ float frcp(float x) { return __builtin_amdgcn_rcpf(x); }
__device__ __forceinline__ float sigmoidf_(float x) { return frcp(1.0f + __expf(-x)); }
__device__ __forceinline__ float siluf_(float x) { return x * sigmoidf_(x); }
__device__ __forceinline__ float gelu_tanh(float x) { const float u = 1.5957691216057308f * (x + 0.044715f * x * x * x); return x * sigmoidf_(u); }
__device__ __forceinline__ float softplusf_(float x) { return x > 20.f ? x : log1pf(__expf(x)); }
__device__ __forceinline__ float shx(float v, int m) { return __shfl_xor(v, m, 64); }

__device__ __forceinline__ float rownorm(const float* rssp, int row) {
    const f32x4 a = *(const f32x4*)(rssp + (size_t)row * 16), b = *(const f32x4*)(rssp + (size_t)row * 16 + 4), c = *(const f32x4*)(rssp + (size_t)row * 16 + 8), d = *(const f32x4*)(rssp + (size_t)row * 16 + 12);
    const float s = ((a[0] + a[1]) + (a[2] + a[3])) + ((b[0] + b[1]) + (b[2] + b[3])) + ((c[0] + c[1]) + (c[2] + c[3])) + ((d[0] + d[1]) + (d[2] + d[3]));
    return rsqrtf(s * (1.0f / 1024.0f) + EPS);
}
constexpr int BM = 256, BK = 64, HALF = 128, HTB = HALF * BK * 2, NXCD = 8, WGM = 8;
__device__ __forceinline__ int lds_byte(int r, int c) { const int st = (r >> 4) * 2 + (c >> 5), rr = r & 15, cc = c & 31, ob = rr * 64 + cc * 2; return st * 1024 + (ob ^ (((ob >> 9) & 1) << 5)); }
__device__ __forceinline__ void stage_rc(int b, int& R, int& C) { const int st = b / 1024, sb = b % 1024, swz = sb ^ (((sb >> 9) & 1) << 5); R = (st >> 1) * 16 + swz / 64; C = (st & 1) * 32 + (swz % 64) / 2; }

struct Unit { int pm, pn, seg, lay; };
enum { EPI_UP = 0, EPI_P1, EPI_P3, EPI_P4, EPI_P5, EPI_P6, EPI_P7 };

struct GPh {
    const bf16_t* A; const bf16_t* Bt; int lda, ldb, K, nM, nN, nseg, nlay; size_t a_lay, b_lay;
    int G, c;
    const float* rss; float* rss_next; const float* gnext; float* X; bf16_t* XN; bf16_t* O; float* DT; const bf16_t* PROJ; const float* SSQ; const bf16_t* UPB;
    __device__ __forceinline__ bool next(int i, Unit& u) const {
        const int tiles = nM * nN; const long L = (long)(i / nseg) * G + c; if (L >= (long)tiles * nlay) return false;
        u.seg = i % nseg; u.lay = (int)(L / tiles); int wgid = (int)(L % tiles);
        { const int q = tiles / NXCD, r = tiles % NXCD, xcd = wgid % NXCD, off = wgid / NXCD; wgid = (xcd < r ? xcd * (q + 1) : r * (q + 1) + (xcd - r) * q) + off; }
        const int nig = WGM * nN, gid = wgid / nig, fm = gid * WGM, gsz = (nM - fm) < WGM ? (nM - fm) : WGM;
        u.pm = fm + ((wgid % nig) % gsz); u.pn = (wgid % nig) / gsz; return true;
    }
    __device__ __forceinline__ const char* pa(const Unit& u) const { return (const char*)(A + u.lay * a_lay + (size_t)u.pm * BM * lda + (size_t)u.seg * K); }
    __device__ __forceinline__ const char* pb(const Unit& u) const { return (const char*)(Bt + u.lay * b_lay + (size_t)u.pn * BM * ldb + (size_t)u.seg * K); }
};

template <int EPI>
__device__ __forceinline__ void epilogue(const GPh& P, f32x4 (&acc)[2][2][4][2], const Unit& u, int, int, int, int) {
    const int tid_ = TIDX, wid_ = tid_ >> 6, wr = wid_ >> 2, wc = wid_ & 3, fr = tid_ & 15, fq = (tid_ >> 4) & 3;
    const int row0 = u.pm * BM + wr * 64 + fr, col0 = u.pn * BM + wc * 32 + 4 * fq;
    if constexpr (EPI == EPI_UP) {
        bf16_t* O = P.O + (size_t)u.lay * MT * 1024;
#pragma unroll
        for (int ai = 0; ai < 2; ++ai)
#pragma unroll
            for (int m = 0; m < 4; ++m) { const int row = row0 + ai * HALF + m * 16;
#pragma unroll
                for (int bj = 0; bj < 2; ++bj)
#pragma unroll
                    for (int n = 0; n < 2; ++n) { const int col = col0 + bj * HALF + n * 16; const f32x4 v = acc[ai][bj][m][n];
                        u32x2 o; o.x = cvt_pk_bf16(v[0], v[1]); o.y = cvt_pk_bf16(v[2], v[3]); *(u32x2*)(O + (size_t)row * 1024 + col) = o; } }
    } else if constexpr (EPI == EPI_P1) {
        const int pn = u.pn;
#pragma unroll
        for (int ai = 0; ai < 2; ++ai)
#pragma unroll
            for (int m = 0; m < 4; ++m) { const int row = row0 + ai * HALF + m * 16; const float r = rownorm(P.rss, row);
#pragma unroll
                for (int bj = 0; bj < 2; ++bj)
#pragma unroll
                    for (int n = 0; n < 2; ++n) { const int col = col0 + bj * HALF + n * 16; f32x4 v = acc[ai][bj][m][n] * r;
                        if (pn == 28) { if (col - NPROJ < 16) *(f32x4*)(P.DT + (size_t)row * 16 + (col - NPROJ)) = v; }
                        else {
                            if (pn >= 10 && pn < 14) { v[0] = gelu_tanh(v[0]); v[1] = gelu_tanh(v[1]); v[2] = gelu_tanh(v[2]); v[3] = gelu_tanh(v[3]); }
                            else if (pn >= 16) { v[0] = sigmoidf_(v[0]); v[1] = sigmoidf_(v[1]); v[2] = sigmoidf_(v[2]); v[3] = sigmoidf_(v[3]); }
                            u32x2 o; o.x = cvt_pk_bf16(v[0], v[1]); o.y = cvt_pk_bf16(v[2], v[3]); *(u32x2*)(P.O + (size_t)row * NPROJ + col) = o; } } }
    } else if constexpr (EPI == EPI_P3) {
        const int seg = u.seg;
#pragma unroll
        for (int ai = 0; ai < 2; ++ai)
#pragma unroll
            for (int m = 0; m < 4; ++m) { const int row = row0 + ai * HALF + m * 16;
                float rs0 = 1.f, rs1 = 1.f;
                if (seg < 2) { const f32x4 a0 = *(const f32x4*)(P.SSQ + (size_t)row * 16), a1 = *(const f32x4*)(P.SSQ + (size_t)row * 16 + 4), b0 = *(const f32x4*)(P.SSQ + (size_t)row * 16 + 8), b1 = *(const f32x4*)(P.SSQ + (size_t)row * 16 + 12);
                    rs0 = rsqrtf((a0[0] + a0[1] + a0[2] + a0[3] + a1[0] + a1[1] + a1[2] + a1[3]) * (1.0f / 512.0f) + EPS);
                    rs1 = rsqrtf((b0[0] + b0[1] + b0[2] + b0[3] + b1[0] + b1[1] + b1[2] + b1[3]) * (1.0f / 512.0f) + EPS); }
                const bf16_t* prow = P.PROJ + (size_t)row * NPROJ;
#pragma unroll
                for (int bj = 0; bj < 2; ++bj)
#pragma unroll
                    for (int n = 0; n < 2; ++n) { const int col = col0 + bj * HALF + n * 16; f32x4 v = acc[ai][bj][m][n];
                        if (seg == 0) { v = v * (rs0 * frcp(rs1)); acc[ai][bj][m][n] = v; }
                        else if (seg == 1) { const u32x2 ga = *(const u32x2*)(prow + C_GA + col), gb = *(const u32x2*)(prow + C_GB + col);
                            v[0] *= rs1 * bf_lo(ga.x) * frcp(bf_lo(gb.x)); v[1] *= rs1 * bf_hi(ga.x) * frcp(bf_hi(gb.x)); v[2] *= rs1 * bf_lo(ga.y) * frcp(bf_lo(gb.y)); v[3] *= rs1 * bf_hi(ga.y) * frcp(bf_hi(gb.y)); acc[ai][bj][m][n] = v; }
                        else if (seg == 2) { const u32x2 ga = *(const u32x2*)(prow + C_GB + col), gb = *(const u32x2*)(prow + C_GC + col);
                            v[0] *= bf_lo(ga.x) * frcp(bf_lo(gb.x)); v[1] *= bf_hi(ga.x) * frcp(bf_hi(gb.x)); v[2] *= bf_lo(ga.y) * frcp(bf_lo(gb.y)); v[3] *= bf_hi(ga.y) * frcp(bf_hi(gb.y)); acc[ai][bj][m][n] = v; }
                        else { const u32x2 gc = *(const u32x2*)(prow + C_GC + col);
                            u32x2 o; o.x = cvt_pk_bf16(v[0] * bf_lo(gc.x), v[1] * bf_hi(gc.x)); o.y = cvt_pk_bf16(v[2] * bf_lo(gc.y), v[3] * bf_hi(gc.y)); *(u32x2*)(P.O + (size_t)row * 1024 + col) = o; } } }
    } else if constexpr (EPI == EPI_P5) {
#pragma unroll
        for (int ai = 0; ai < 2; ++ai)
#pragma unroll
            for (int m = 0; m < 4; ++m) { const int row = row0 + ai * HALF + m * 16; const float r = rownorm(P.rss, row);
#pragma unroll
                for (int bj = 0; bj < 2; ++bj) { const f32x4 g = acc[ai][bj][m][0] * r, uu = acc[ai][bj][m][1] * r;
                    const int ocol = 16 * (8 * u.pn + 4 * bj + wc) + 4 * fq;
                    u32x2 o; o.x = cvt_pk_bf16(siluf_(g[0]) * uu[0], siluf_(g[1]) * uu[1]); o.y = cvt_pk_bf16(siluf_(g[2]) * uu[2], siluf_(g[3]) * uu[3]);
                    *(u32x2*)(P.O + (size_t)row * DFF + ocol) = o; } }
    } else {
#pragma unroll
        for (int ai = 0; ai < 2; ++ai)
#pragma unroll
            for (int m = 0; m < 4; ++m) { const int row = row0 + ai * HALF + m * 16; float ss = 0.f; float r7 = 0.f;
                if constexpr (EPI == EPI_P7) r7 = rownorm(P.rss, row);
#pragma unroll
                for (int bj = 0; bj < 2; ++bj)
#pragma unroll
                    for (int n = 0; n < 2; ++n) { const int col = col0 + bj * HALF + n * 16; f32x4 v = acc[ai][bj][m][n];
                        f32x4 xv = *(const f32x4*)(P.X + (size_t)row * 1024 + col);
                        if constexpr (EPI == EPI_P7) { const u32x2 up = *(const u32x2*)(P.UPB + (size_t)row * 1024 + col);
                            xv[0] += bf_lo(up.x) * sigmoidf_(v[0] * r7); xv[1] += bf_hi(up.x) * sigmoidf_(v[1] * r7); xv[2] += bf_lo(up.y) * sigmoidf_(v[2] * r7); xv[3] += bf_hi(up.y) * sigmoidf_(v[3] * r7); }
                        else xv += v;
                        *(f32x4*)(P.X + (size_t)row * 1024 + col) = xv;
                        ss += xv[0] * xv[0] + xv[1] * xv[1] + xv[2] * xv[2] + xv[3] * xv[3];
                        const f32x4 gn = *(const f32x4*)(P.gnext + col);
                        u32x2 o; o.x = cvt_pk_bf16(xv[0] * gn[0], xv[1] * gn[1]); o.y = cvt_pk_bf16(xv[2] * gn[2], xv[3] * gn[3]); *(u32x2*)(P.XN + (size_t)row * 1024 + col) = o; }
                ss += shx(ss, 16); ss += shx(ss, 32);
                if (fq == 0) P.rss_next[(size_t)row * 16 + u.pn * 4 + wc] = ss; }
    }
}

template <int EPI>
__device__ __forceinline__ void gemm_phase(LAS uchar* lds, const GPh& P) {
    const int tid = TIDX, wid = __builtin_amdgcn_readfirstlane(tid >> 6), lane = tid & 63, wr = wid >> 2, wc = wid & 3, fr = lane & 15, fq = lane >> 4;
    const int K = P.K, nt = K / BK;
    unsigned voffA[2], voffB[2];
#pragma unroll
    for (int i = 0; i < 2; ++i) { int R, C; stage_rc(tid * 16 + i * 8192, R, C); voffA[i] = (unsigned)(R * P.lda + C) * 2u; voffB[i] = (unsigned)(R * P.ldb + C) * 2u; }
    const size_t kstep = (size_t)(BK * 2);
    const size_t hstepA = (size_t)HALF * P.lda * 2, hstepB = (size_t)HALF * P.ldb * 2;
    const unsigned ldsw = (unsigned)wid * 1024u;
    const int aoff = lds_byte(wr * 64 + fr, fq * 8), boff = lds_byte(wc * 32 + fr, fq * 8);
#define PG8_SA(b, h) (((b) * 2 + (h)) * HTB)
#define PG8_SB(b, h) ((4 + (b) * 2 + (h)) * HTB)
#define PG8_STAGE(bufoff, gbase, voff) do { _Pragma("unroll") for (int _i = 0; _i < 2; ++_i) \
        __builtin_amdgcn_global_load_lds((const unsigned*)((const char*)(gbase) + (voff)[_i]), (LAS unsigned*)(lds + (bufoff) + ldsw + _i * 8192), 16, 0, 0); } while (0)
#define PG8_LDA(dst, b, h) do { _Pragma("unroll") for (int m = 0; m < 4; ++m) _Pragma("unroll") for (int k = 0; k < 2; ++k) dst[m][k] = *(const LAS bf16x8*)(lds + PG8_SA(b, h) + aoff + m * 2048 + k * 1024); } while (0)
#define PG8_LDB(dst, b, h) do { _Pragma("unroll") for (int n = 0; n < 2; ++n) _Pragma("unroll") for (int k = 0; k < 2; ++k) dst[n][k] = *(const LAS bf16x8*)(lds + PG8_SB(b, h) + boff + n * 2048 + k * 1024); } while (0)
#define PG8_MMA(ai, bj, At, Bt) do { __builtin_amdgcn_s_setprio(1); _Pragma("unroll") for (int m = 0; m < 4; ++m) _Pragma("unroll") for (int n = 0; n < 2; ++n) _Pragma("unroll") for (int k = 0; k < 2; ++k) \
        acc[ai][bj][m][n] = __builtin_amdgcn_mfma_f32_16x16x32_bf16(Bt[n][k], At[m][k], acc[ai][bj][m][n], 0, 0, 0); __builtin_amdgcn_s_setprio(0); } while (0)
#define PG8_WAIT_V(n) asm volatile("s_waitcnt vmcnt(" #n ")" ::: "memory")
#define PG8_WAIT_L(n) asm volatile("s_waitcnt lgkmcnt(" #n ")" ::: "memory")
#define PG8_BAR __builtin_amdgcn_s_barrier()
#define PG8_SCHED __builtin_amdgcn_sched_barrier(0)
    Unit cur, nxt; int ui = 0;
    if (!P.next(0, cur)) return;
    f32x4 acc[2][2][4][2];
#pragma unroll
    for (int a = 0; a < 2; ++a)
#pragma unroll
        for (int b = 0; b < 2; ++b)
#pragma unroll
            for (int m = 0; m < 4; ++m)
#pragma unroll
                for (int n = 0; n < 2; ++n) acc[a][b][m][n] = (f32x4){0.f, 0.f, 0.f, 0.f};
    bf16x8 At[4][2], B0[2][2], B1[2][2];
    const char* cA = P.pa(cur); const char* cB = P.pb(cur);
    PG8_STAGE(PG8_SB(0, 0), cB, voffB); PG8_STAGE(PG8_SA(0, 0), cA, voffA); PG8_STAGE(PG8_SB(0, 1), cB + hstepB, voffB); PG8_STAGE(PG8_SA(0, 1), cA + hstepA, voffA);
    if (wr == 1) PG8_BAR;
    PG8_WAIT_V(4); PG8_BAR;
    PG8_STAGE(PG8_SB(1, 0), cB + kstep, voffB); PG8_STAGE(PG8_SA(1, 0), cA + kstep, voffA); PG8_STAGE(PG8_SB(1, 1), cB + hstepB + kstep, voffB);
    PG8_WAIT_V(6); PG8_BAR;
    for (;;) {
        const bool has_next = P.next(ui + 1, nxt);
        const char* nA = has_next ? P.pa(nxt) : cA; const char* nB = has_next ? P.pb(nxt) : cB;
        for (int t = 0; t < nt; t += 2) {
            const bool last = (t == nt - 2);
            const char* a1 = cA + (size_t)(t + 1) * kstep;
            const char* a2 = last ? nA : cA + (size_t)(t + 2) * kstep; const char* b2 = last ? nB : cB + (size_t)(t + 2) * kstep;
            const char* a3 = a2 + kstep; const char* b3 = b2 + kstep;
            PG8_LDB(B0, 0, 0); PG8_SCHED; PG8_LDA(At, 0, 0); PG8_STAGE(PG8_SA(1, 1), a1 + hstepA, voffA);
            PG8_WAIT_L(8); PG8_BAR; PG8_WAIT_L(0); PG8_MMA(0, 0, At, B0); PG8_BAR; PG8_SCHED;
            PG8_LDB(B1, 0, 1); PG8_STAGE(PG8_SB(0, 0), b2, voffB);
            PG8_BAR; PG8_WAIT_L(0); PG8_MMA(0, 1, At, B1); PG8_BAR;
            PG8_LDA(At, 0, 1); PG8_STAGE(PG8_SA(0, 0), a2, voffA);
            PG8_BAR; PG8_WAIT_L(0); PG8_MMA(1, 0, At, B0); PG8_BAR; PG8_SCHED;
            PG8_STAGE(PG8_SB(0, 1), b2 + hstepB, voffB);
            PG8_WAIT_V(6); PG8_BAR; PG8_MMA(1, 1, At, B1); PG8_BAR;
            PG8_LDB(B0, 1, 0); PG8_SCHED; PG8_LDA(At, 1, 0); PG8_STAGE(PG8_SA(0, 1), a2 + hstepA, voffA);
            PG8_WAIT_L(8); PG8_BAR; PG8_WAIT_L(0); PG8_MMA(0, 0, At, B0); PG8_BAR; PG8_SCHED;
            PG8_LDB(B1, 1, 1); PG8_STAGE(PG8_SB(1, 0), b3, voffB);
            PG8_BAR; PG8_WAIT_L(0); PG8_MMA(0, 1, At, B1); PG8_BAR;
            PG8_LDA(At, 1, 1); PG8_STAGE(PG8_SA(1, 0), a3, voffA);
            PG8_BAR; PG8_WAIT_L(0); PG8_MMA(1, 0, At, B0); PG8_BAR; PG8_SCHED;
            PG8_STAGE(PG8_SB(1, 1), b3 + hstepB, voffB);
            PG8_WAIT_V(6); PG8_BAR; PG8_MMA(1, 1, At, B1); PG8_BAR;
        }
        epilogue<EPI>(P, acc, cur, wr, wc, fr, fq);
        if (!has_next) break;
        if (EPI != EPI_P3 || cur.seg == 3) {
#pragma unroll
            for (int a = 0; a < 2; ++a)
#pragma unroll
                for (int b = 0; b < 2; ++b)
#pragma unroll
                    for (int m = 0; m < 4; ++m)
#pragma unroll
                        for (int n = 0; n < 2; ++n) acc[a][b][m][n] = (f32x4){0.f, 0.f, 0.f, 0.f};
        }
        cur = nxt; cA = nA; cB = nB; ++ui;
    }
    PG8_WAIT_V(0);
    if (wr == 0) PG8_BAR;
    PG8_BAR;
#undef PG8_SA
#undef PG8_SB
#undef PG8_STAGE
#undef PG8_LDA
#undef PG8_LDB
#undef PG8_MMA
#undef PG8_WAIT_V
#undef PG8_WAIT_L
#undef PG8_BAR
#undef PG8_SCHED
}

template <int NT, int KS>
__device__ __forceinline__ void wmma(const LAS uchar* A, const LAS uchar* B, int pitch, f32x4 (&acc)[NT], int fr, int fq) {
#pragma unroll 1
    for (int ks = 0; ks < KS; ++ks) {
        const bf16x8 a = *(const LAS bf16x8*)(A + fr * pitch + (ks * 32 + fq * 8) * 2);
#pragma unroll
        for (int ni = 0; ni < NT; ++ni) {
            const bf16x8 b = *(const LAS bf16x8*)(B + (ni * 16 + fr) * pitch + (ks * 32 + fq * 8) * 2);
            acc[ni] = __builtin_amdgcn_mfma_f32_16x16x32_bf16(b, a, acc[ni], 0, 0, 0);
        }
    }
}
constexpr int PB = 272;

__device__ __forceinline__ int map_row(int n, int map) {
    if (map == 1) return n < 2560 ? n : (n < 2576 ? 7168 + (n - 2560) : n - 16);
    if (map == 2) { const int up = n >= DFF, nn = up ? n - DFF : n; return 32 * (nn >> 4) + 16 * up + (nn & 15); }
    return n;
}
__device__ __forceinline__ void tr_tile(LAS float* T, const float* src, int N, bf16_t* dst, int ldd, int dcol0, int k0, int n0, int map) {
    const int tid = TIDX;
    __syncthreads();
#pragma unroll
    for (int ps = 0; ps < 2; ++ps) { const int r = ps * 32 + (tid >> 4), c4 = (tid & 15) * 4; const int n = n0 + c4;
        f32x4 v = (f32x4){0.f, 0.f, 0.f, 0.f}; if (n < N) v = *(const f32x4*)(src + (size_t)(k0 + r) * N + n);
        T[r * 65 + c4 + 0] = v[0]; T[r * 65 + c4 + 1] = v[1]; T[r * 65 + c4 + 2] = v[2]; T[r * 65 + c4 + 3] = v[3]; }
    __syncthreads();
    { const int n = tid >> 3, k8 = (tid & 7) * 8;
        if (n0 + n < N) { u32x4 o; float f[8];
#pragma unroll
            for (int j = 0; j < 8; ++j) f[j] = T[(k8 + j) * 65 + n];
            o.x = cvt_pk_bf16(f[0], f[1]); o.y = cvt_pk_bf16(f[2], f[3]); o.z = cvt_pk_bf16(f[4], f[5]); o.w = cvt_pk_bf16(f[6], f[7]);
            *(u32x4*)(dst + (size_t)map_row(n0 + n, map) * ldd + dcol0 + k0 + k8) = o; } }
}

__device__ void phase_pre(LAS uchar* lds, const Params& P) {
    const int tid = TIDX, G = GDIM, bid = BIDX;
    uchar* ws = (P.ws + launder_z());
    LAS float* T = (LAS float*)lds;
    constexpr int T_IN = 16 * 113, T_BRA = 256, T_BRB = 128, T_OUT = 256, T_GU = 16 * 88, T_DN = 44 * 16, T_PG = 256, T_PU = 64;
    constexpr int T_L = T_IN + T_BRA + T_BRB + T_OUT + T_GU + T_DN + T_PG + T_PU;
    for (int job = bid; job < 4 * T_L; job += G) {
        const int l = job / T_L; int j = job % T_L;
        if (j < T_IN) { tr_tile(T, PIN(I_WIN) + (size_t)l * 1024 * 7184, 7184, (bf16_t*)(ws + WS_WIN) + (size_t)l * NIN * 1024, 1024, 0, (j / 113) * 64, (j % 113) * 64, 1); continue; } j -= T_IN;
        if (j < T_BRA) { tr_tile(T, PIN(I_WBRA) + (size_t)l * 1024 * 1024, 1024, (bf16_t*)(ws + WS_WBR) + (size_t)l * 1024 * 2048, 2048, 0, (j / 16) * 64, (j % 16) * 64, 0); continue; } j -= T_BRA;
        if (j < T_BRB) { tr_tile(T, PIN(I_WBRB) + (size_t)l * 512 * 1024, 1024, (bf16_t*)(ws + WS_WBR) + (size_t)l * 1024 * 2048, 2048, 1024, (j / 16) * 64, (j % 16) * 64, 0); continue; } j -= T_BRB;
        if (j < T_OUT) { tr_tile(T, PIN(I_WOUT) + (size_t)l * 1024 * 1024, 1024, (bf16_t*)(ws + WS_WOUT) + (size_t)l * 1024 * 1024, 1024, 0, (j / 16) * 64, (j % 16) * 64, 0); continue; } j -= T_OUT;
        if (j < T_GU) { tr_tile(T, PIN(I_WGU) + (size_t)l * 1024 * 5632, 5632, (bf16_t*)(ws + WS_WGU) + (size_t)l * 5632 * 1024, 1024, 0, (j / 88) * 64, (j % 88) * 64, 2); continue; } j -= T_GU;
        if (j < T_DN) { tr_tile(T, PIN(I_WDN) + (size_t)l * DFF * 1024, 1024, (bf16_t*)(ws + WS_WDN) + (size_t)l * 1024 * DFF, DFF, 0, (j / 16) * 64, (j % 16) * 64, 0); continue; } j -= T_DN;
        if (j < T_PG) { tr_tile(T, PIN(I_WPG) + (size_t)l * 1024 * 1024, 1024, (bf16_t*)(ws + WS_WPG) + (size_t)l * 1024 * 1024, 1024, 0, (j / 16) * 64, (j % 16) * 64, 0); continue; } j -= T_PG;
        tr_tile(T, PIN(I_WPU) + (size_t)l * 256 * 1024, 1024, (bf16_t*)(ws + WS_WPU) + (size_t)l * 1024 * 256, 256, 0, (j / 16) * 64, (j % 16) * 64, 0);
    }
    {
        LAS float* PW = (LAS float*)lds;
        LAS float* WC = (LAS float*)(lds + 128 * 129 * 4);
        for (int job = bid; job < 4 * 4 * 16; job += G) {
            const int l = job >> 6, g = (job >> 4) & 3, n0 = (job & 15) * 64;
            __syncthreads();
            for (int e = tid; e < 128 * 128; e += NTHR) { const int c = e >> 7, d = e & 127; PW[c * 129 + d] = PIN(I_POOLW)[((size_t)(l * 4 + g) * 128 + c) * 128 + d] * PIN(I_POOLS)[l * 512 + g * 128 + d]; }
            for (int e = tid; e < 128 * 64; e += NTHR) { const int d = e >> 6, n = e & 63; WC[d * 64 + n] = PIN(I_WBRC)[((size_t)l * 512 + g * 128 + d) * 1024 + n0 + n]; }
            __syncthreads();
            const int c = tid & 127, nq = (tid >> 7) * 16;
            float a[16];
#pragma unroll
            for (int i = 0; i < 16; ++i) a[i] = 0.f;
            for (int d = 0; d < 128; ++d) { const float pw = PW[c * 129 + d];
#pragma unroll
                for (int i = 0; i < 16; ++i) a[i] += pw * WC[d * 64 + nq + i]; }
            bf16_t* dst = (bf16_t*)(ws + WS_WBR) + (size_t)l * 1024 * 2048;
#pragma unroll
            for (int i = 0; i < 16; ++i) dst[(size_t)(n0 + nq + i) * 2048 + 1536 + g * 128 + c] = (bf16_t)(cvt_pk_bf16(a[i], 0.f) & 0xffffu);
        }
    }
    {
        const int lane = tid & 63, wv = tid >> 6;
        float* X = (float*)(ws + WS_X); bf16_t* XN = (bf16_t*)(ws + WS_XN); float* RSS = (float*)(ws + WS_RSS);
        const float* g0 = PIN(I_NMIX);
        for (int row = bid * 8 + wv; row < MT; row += G * 8) {
            const float* src = row < MPR ? PIN(I_XP) + (size_t)row * 1024 : PIN(I_XS) + (size_t)(row - MPR) * 1024;
            float ss = 0.f;
#pragma unroll
            for (int i = 0; i < 4; ++i) { const int col = i * 256 + lane * 4; const f32x4 v = *(const f32x4*)(src + col); const f32x4 gg = *(const f32x4*)(g0 + col);
                *(f32x4*)(X + (size_t)row * 1024 + col) = v; ss += v[0] * v[0] + v[1] * v[1] + v[2] * v[2] + v[3] * v[3];
                u32x2 o; o.x = cvt_pk_bf16(v[0] * gg[0], v[1] * gg[1]); o.y = cvt_pk_bf16(v[2] * gg[2], v[3] * gg[3]); *(u32x2*)(XN + (size_t)row * 1024 + col) = o; }
#pragma unroll
            for (int s = 1; s < 64; s <<= 1) ss += shx(ss, s);
            if (lane < 16) RSS[(size_t)row * 16 + lane] = lane == 0 ? ss : 0.f;
        }
    }
    {
        bf16_t* PBF = (bf16_t*)(ws + WS_PBF);
        const size_t n4 = (size_t)4 * MT * 256 / 4;
        for (size_t i = (size_t)bid * NTHR + tid; i < n4; i += (size_t)G * NTHR) {
            const size_t e = i * 4; const int l = (int)(e / ((size_t)MT * 256)); const size_t rem = e % ((size_t)MT * 256); const int row = (int)(rem >> 8), col = (int)(rem & 255);
            const float* src = row < MPR ? PIN(I_PP) + ((size_t)l * MPR + row) * 256 + col : PIN(I_PS) + ((size_t)l * 1024 + (row - MPR)) * 256 + col;
            const f32x4 v = *(const f32x4*)src; u32x2 o; o.x = cvt_pk_bf16(v[0], v[1]); o.y = cvt_pk_bf16(v[2], v[3]); *(u32x2*)(PBF + e) = o;
        }
    }
}

constexpr int L_CS = 0, L_BS = 34816, L_BDT = 69632, L_XT = 104448, L_SB = 121856, L_SC = 139264;
__device__ __forceinline__ int xbc_chan(int cc, int h, int g) { return cc < 64 ? h * 64 + cc : (cc < 192 ? 1024 + g * 128 + (cc - 64) : 1280 + g * 128 + (cc - 192)); }

__device__ void ssd_prompt(LAS uchar* lds, const Params& P, int l, int b, int h) {
    const int tid = TIDX, lane = tid & 63, w = tid >> 6, fr = lane & 15, fq = lane >> 4, g = h >> 3;
    const bf16_t* PROJ = (const bf16_t*)((P.ws + launder_z()) + WS_PROJ); const float* DT = (const float*)((P.ws + launder_z()) + WS_DT);
    bf16_t* Y = (bf16_t*)((P.ws + launder_z()) + WS_Y); float* SSQ = (float*)((P.ws + launder_z()) + WS_SSQ);
    LAS float* acs = (LAS float*)(lds + L_SC); LAS float* dtv = acs + 128; LAS float* eacs = acs + 256; LAS float* decdt = acs + 384;
    const float a_h = -__expf(PIN(I_ALOG)[l * 16 + h]), dtb = PIN(I_DTB)[l * 16 + h], Dh = PIN(I_DSKIP)[l * 16 + h];
    f32x4 S[4];
#pragma unroll
    for (int i = 0; i < 4; ++i) S[i] = (f32x4){0.f, 0.f, 0.f, 0.f};
    const int cg = tid % 40, rsg = tid / 40; const int ch = xbc_chan(cg * 8, h, g);
    for (int c = 0; c < 16; ++c) {
        const int grow0 = b * 2048 + c * 128;
        __syncthreads();
        if (w == 0) {
            const float r0 = DT[(size_t)(grow0 + 2 * lane) * 16 + h], r1 = DT[(size_t)(grow0 + 2 * lane + 1) * 16 + h];
            const float d0 = softplusf_(r0 + dtb), d1 = softplusf_(r1 + dtb); const float a0 = d0 * a_h, a1 = d1 * a_h;
            float inc = a0 + a1;
#pragma unroll
            for (int s = 1; s < 64; s <<= 1) { const float o = __shfl_up(inc, s, 64); if (lane >= s) inc += o; }
            const float tot = __shfl(inc, 63, 64); const float c1 = inc, c0 = inc - a1;
            acs[2 * lane] = c0; acs[2 * lane + 1] = c1; dtv[2 * lane] = d0; dtv[2 * lane + 1] = d1;
            eacs[2 * lane] = __expf(c0); eacs[2 * lane + 1] = __expf(c1); decdt[2 * lane] = __expf(tot - c0) * d0; decdt[2 * lane + 1] = __expf(tot - c1) * d1;
        }
        __syncthreads();
        if (tid < 320) {
    float cw[4][8], cbv[8];
#pragma unroll
        for (int k = 0; k < 4; ++k) { const f32x4 a = *(const f32x4*)(PIN(I_CONVW) + (size_t)(l * 4 + k) * 1536 + ch), cc = *(const f32x4*)(PIN(I_CONVW) + (size_t)(l * 4 + k) * 1536 + ch + 4);
            cw[k][0] = a[0]; cw[k][1] = a[1]; cw[k][2] = a[2]; cw[k][3] = a[3]; cw[k][4] = cc[0]; cw[k][5] = cc[1]; cw[k][6] = cc[2]; cw[k][7] = cc[3]; }
        const f32x4 a = *(const f32x4*)(PIN(I_CONVB) + (size_t)l * 1536 + ch), cc = *(const f32x4*)(PIN(I_CONVB) + (size_t)l * 1536 + ch + 4);
        cbv[0] = a[0]; cbv[1] = a[1]; cbv[2] = a[2]; cbv[3] = a[3]; cbv[4] = cc[0]; cbv[5] = cc[1]; cbv[6] = cc[2]; cbv[7] = cc[3];
            const int lr0 = rsg * 16;
            float hx[3][8];
#pragma unroll
            for (int k = 0; k < 3; ++k) { const int pos = c * 128 + lr0 - 3 + k;
                u32x4 v = (u32x4){0u, 0u, 0u, 0u}; if (pos >= 0) v = *(const u32x4*)(PROJ + (size_t)(b * 2048 + pos) * NPROJ + C_XBC + ch);
                hx[k][0] = bf_lo(v.x); hx[k][1] = bf_hi(v.x); hx[k][2] = bf_lo(v.y); hx[k][3] = bf_hi(v.y); hx[k][4] = bf_lo(v.z); hx[k][5] = bf_hi(v.z); hx[k][6] = bf_lo(v.w); hx[k][7] = bf_hi(v.w); }
#pragma unroll 1
            for (int t2 = 0; t2 < 8; ++t2) {
                const int lr = lr0 + 2 * t2;
                const u32x4 v0 = *(const u32x4*)(PROJ + (size_t)(grow0 + lr) * NPROJ + C_XBC + ch), v1 = *(const u32x4*)(PROJ + (size_t)(grow0 + lr + 1) * NPROJ + C_XBC + ch);
                float x0[8], x1[8], o0[8], o1[8];
                x0[0] = bf_lo(v0.x); x0[1] = bf_hi(v0.x); x0[2] = bf_lo(v0.y); x0[3] = bf_hi(v0.y); x0[4] = bf_lo(v0.z); x0[5] = bf_hi(v0.z); x0[6] = bf_lo(v0.w); x0[7] = bf_hi(v0.w);
                x1[0] = bf_lo(v1.x); x1[1] = bf_hi(v1.x); x1[2] = bf_lo(v1.y); x1[3] = bf_hi(v1.y); x1[4] = bf_lo(v1.z); x1[5] = bf_hi(v1.z); x1[6] = bf_lo(v1.w); x1[7] = bf_hi(v1.w);
#pragma unroll
                for (int j = 0; j < 8; ++j) {
                    o0[j] = siluf_(cbv[j] + cw[0][j] * hx[0][j] + cw[1][j] * hx[1][j] + cw[2][j] * hx[2][j] + cw[3][j] * x0[j]);
                    o1[j] = siluf_(cbv[j] + cw[0][j] * hx[1][j] + cw[1][j] * hx[2][j] + cw[2][j] * x0[j] + cw[3][j] * x1[j]);
                    hx[0][j] = hx[2][j]; hx[1][j] = x0[j]; hx[2][j] = x1[j]; }
                if (cg < 8) {
#pragma unroll
                    for (int j = 0; j < 8; ++j) *(LAS unsigned*)(lds + L_XT + (cg * 8 + j) * PB + lr * 2) = cvt_pk_bf16(o0[j], o1[j]);
                } else if (cg < 24) {
                    const int n0 = (cg - 8) * 8; const float s0 = decdt[lr], s1 = decdt[lr + 1];
                    u32x4 q; q.x = cvt_pk_bf16(o0[0], o0[1]); q.y = cvt_pk_bf16(o0[2], o0[3]); q.z = cvt_pk_bf16(o0[4], o0[5]); q.w = cvt_pk_bf16(o0[6], o0[7]); *(LAS u32x4*)(lds + L_BS + lr * PB + n0 * 2) = q;
                    q.x = cvt_pk_bf16(o1[0], o1[1]); q.y = cvt_pk_bf16(o1[2], o1[3]); q.z = cvt_pk_bf16(o1[4], o1[5]); q.w = cvt_pk_bf16(o1[6], o1[7]); *(LAS u32x4*)(lds + L_BS + (lr + 1) * PB + n0 * 2) = q;
#pragma unroll
                    for (int j = 0; j < 8; ++j) *(LAS unsigned*)(lds + L_BDT + (n0 + j) * PB + lr * 2) = cvt_pk_bf16(o0[j] * s0, o1[j] * s1);
                } else {
                    const int n0 = (cg - 24) * 8;
                    u32x4 q; q.x = cvt_pk_bf16(o0[0], o0[1]); q.y = cvt_pk_bf16(o0[2], o0[3]); q.z = cvt_pk_bf16(o0[4], o0[5]); q.w = cvt_pk_bf16(o0[6], o0[7]); *(LAS u32x4*)(lds + L_CS + lr * PB + n0 * 2) = q;
                    q.x = cvt_pk_bf16(o1[0], o1[1]); q.y = cvt_pk_bf16(o1[2], o1[3]); q.z = cvt_pk_bf16(o1[4], o1[5]); q.w = cvt_pk_bf16(o1[6], o1[7]); *(LAS u32x4*)(lds + L_CS + (lr + 1) * PB + n0 * 2) = q;
                }
            }
        }
        __syncthreads();
        {
            f32x4 cb[8];
#pragma unroll
            for (int i = 0; i < 8; ++i) cb[i] = (f32x4){0.f, 0.f, 0.f, 0.f};
            wmma<8, 4>(lds + L_CS + w * 16 * PB, lds + L_BS, PB, cb, fr, fq);
            __syncthreads();
            const int lrow = 16 * w + fr; const float al = acs[lrow];
#pragma unroll
            for (int ni = 0; ni < 8; ++ni) { const int s0 = ni * 16 + 4 * fq; float mv[4];
#pragma unroll
                for (int e = 0; e < 4; ++e) { const int s = s0 + e; const float dd = fminf(al - acs[s], 0.f); mv[e] = (s <= lrow) ? cb[ni][e] * __expf(dd) * dtv[s] : 0.f; }
                u32x2 o; o.x = cvt_pk_bf16(mv[0], mv[1]); o.y = cvt_pk_bf16(mv[2], mv[3]); *(LAS u32x2*)(lds + L_BS + lrow * PB + s0 * 2) = o; }
        }
        {
            f32x4 y[4];
#pragma unroll
            for (int i = 0; i < 4; ++i) y[i] = (f32x4){0.f, 0.f, 0.f, 0.f};
            const int lrow = 16 * w + fr;
            if (c > 0) { wmma<4, 4>(lds + L_CS + w * 16 * PB, lds + L_SB, PB, y, fr, fq); const float ea = eacs[lrow];
#pragma unroll
                for (int i = 0; i < 4; ++i) y[i] = y[i] * ea; }
            wmma<4, 4>(lds + L_BS + w * 16 * PB, lds + L_XT, PB, y, fr, fq);
            const int row = grow0 + lrow; float ssq = 0.f;
#pragma unroll
            for (int ni = 0; ni < 4; ++ni) { const int p0 = ni * 16 + 4 * fq;
                const u32x2 zz = *(const u32x2*)(PROJ + (size_t)row * NPROJ + C_Z + h * 64 + p0);
                const f32x4 ng = *(const f32x4*)(PIN(I_SSDN) + (size_t)l * 1024 + h * 64 + p0);
                float zf[4] = {bf_lo(zz.x), bf_hi(zz.x), bf_lo(zz.y), bf_hi(zz.y)}; float ov[4];
#pragma unroll
                for (int e = 0; e < 4; ++e) { const float xs = bf1(*(const LAS bf16_t*)(lds + L_XT + (p0 + e) * PB + lrow * 2)); const float v = (y[ni][e] + Dh * xs) * siluf_(zf[e]); ssq += v * v; ov[e] = v * ng[e]; }
                u32x2 o; o.x = cvt_pk_bf16(ov[0], ov[1]); o.y = cvt_pk_bf16(ov[2], ov[3]); *(u32x2*)(Y + (size_t)row * 2048 + h * 64 + p0) = o; }
            ssq += shx(ssq, 16); ssq += shx(ssq, 32);
            if (fq == 0) SSQ[(size_t)row * 16 + h] = ssq;
        }
        __syncthreads();
        {
            const float et = eacs[127];
#pragma unroll
            for (int i = 0; i < 4; ++i) S[i] = S[i] * et;
            wmma<4, 4>(lds + L_XT + (w >> 1) * 16 * PB, lds + L_BDT + (w & 1) * 64 * PB, PB, S, fr, fq);
            const int p = (w >> 1) * 16 + fr;
#pragma unroll
            for (int ni = 0; ni < 4; ++ni) { const int n0 = (w & 1) * 64 + ni * 16 + 4 * fq; u32x2 o; o.x = cvt_pk_bf16(S[ni][0], S[ni][1]); o.y = cvt_pk_bf16(S[ni][2], S[ni][3]); *(LAS u32x2*)(lds + L_SB + p * PB + n0 * 2) = o; }
        }
    }
    {
        float* dst = (P.out + launder_z()) + O_SSMP + ((size_t)((l * 8 + b) * 16 + h) * 64) * 128; const int p = (w >> 1) * 16 + fr;
#pragma unroll
        for (int ni = 0; ni < 4; ++ni) { const int n0 = (w & 1) * 64 + ni * 16 + 4 * fq; *(f32x4*)(dst + (size_t)p * 128 + n0) = S[ni]; }
    }
}

__device__ void ssd_sample(LAS uchar* lds, const Params& P, int l, int b, int hp) {
    const int tid = TIDX, half = tid >> 8, t8 = tid & 255, h = hp * 2 + half, g = h >> 3;
    const bf16_t* PROJ = (const bf16_t*)((P.ws + launder_z()) + WS_PROJ); const float* DT = (const float*)((P.ws + launder_z()) + WS_DT);
    bf16_t* Y = (bf16_t*)((P.ws + launder_z()) + WS_Y); float* SSQ = (float*)((P.ws + launder_z()) + WS_SSQ);
    LAS float* xs = (LAS float*)(lds + half * 16384); LAS float* Bv = xs + 512; LAS float* Cv = xs + 1536; LAS float* sdt = xs + 2560; LAS float* sdec = xs + 2568; LAS float* yv = xs + 2576;
    const int row0 = MPR + b * 8;
    __syncthreads();
    for (int cc = t8; cc < 320; cc += 256) {
        const int ch = xbc_chan(cc, h, g);
        float xv[11];
#pragma unroll
        for (int k = 0; k < 3; ++k) xv[k] = PIN(I_SCONV)[((size_t)(l * 128 + b) * 3 + k) * 1536 + ch];
#pragma unroll
        for (int t = 0; t < 8; ++t) xv[3 + t] = bf1(PROJ[(size_t)(row0 + t) * NPROJ + C_XBC + ch]);
        const float w0 = PIN(I_CONVW)[(size_t)(l * 4 + 0) * 1536 + ch], w1 = PIN(I_CONVW)[(size_t)(l * 4 + 1) * 1536 + ch], w2 = PIN(I_CONVW)[(size_t)(l * 4 + 2) * 1536 + ch], w3 = PIN(I_CONVW)[(size_t)(l * 4 + 3) * 1536 + ch];
        const float cb = PIN(I_CONVB)[(size_t)l * 1536 + ch];
#pragma unroll
        for (int t = 0; t < 8; ++t) { const float o = siluf_(cb + w0 * xv[t] + w1 * xv[t + 1] + w2 * xv[t + 2] + w3 * xv[t + 3]);
            if (cc < 64) xs[t * 64 + cc]= o; else if (cc < 192) Bv[t * 128 + cc - 64] = o; else Cv[t * 128 + cc - 192] = o; }
    }
    if (t8 < 8) { const float d = softplusf_(DT[(size_t)(row0 + t8) * 16 + h] + PIN(I_DTB)[l * 16 + h]); sdt[t8] = d; sdec[t8] = __expf(-d * __expf(PIN(I_ALOG)[l * 16 + h])); }
    __syncthreads();
    const int l16 = t8 & 15, pr = t8 >> 4;
    const float* hin = PIN(I_SSSM) + ((size_t)((l * 128 + b) * 16 + h) * 64) * 128;
    float* hout = (P.out + launder_z()) + O_SSMS + ((size_t)((l * 128 + b) * 16 + h) * 64) * 128;
    f32x4 hs[4][2];
#pragma unroll
    for (int pi = 0; pi < 4; ++pi)
#pragma unroll
        for (int it = 0; it < 2; ++it) hs[pi][it] = *(const f32x4*)(hin + (size_t)(pi * 16 + pr) * 128 + it * 64 + l16 * 4);
#pragma unroll 1
    for (int t = 0; t < 8; ++t) {
        const float dec = sdec[t], dtt = sdt[t];
        const f32x4 B0 = *(const LAS f32x4*)(Bv + t * 128 + l16 * 4), B1 = *(const LAS f32x4*)(Bv + t * 128 + 64 + l16 * 4);
        const f32x4 C0 = *(const LAS f32x4*)(Cv + t * 128 + l16 * 4), C1 = *(const LAS f32x4*)(Cv + t * 128 + 64 + l16 * 4);
#pragma unroll
        for (int pi = 0; pi < 4; ++pi) { const float xd = xs[t * 64 + pi * 16 + pr] * dtt;
            hs[pi][0] = hs[pi][0] * dec + B0 * xd; hs[pi][1] = hs[pi][1] * dec + B1 * xd;
            const f32x4 q = hs[pi][0] * C0 + hs[pi][1] * C1; float yp = q[0] + q[1] + q[2] + q[3];
            yp += shx(yp, 1); yp += shx(yp, 2); yp += shx(yp, 4); yp += shx(yp, 8);
            if (l16 == 0) yv[t * 64 + pi * 16 + pr] = yp; }
    }
#pragma unroll
    for (int pi = 0; pi < 4; ++pi)
#pragma unroll
        for (int it = 0; it < 2; ++it) *(f32x4*)(hout + (size_t)(pi * 16 + pr) * 128 + it * 64 + l16 * 4) = hs[pi][it];
    __syncthreads();
    {
        const int t = t8 >> 5, p0 = (t8 & 31) * 2, row = row0 + t; const float Dh = PIN(I_DSKIP)[l * 16 + h];
        const unsigned zz = *(const unsigned*)(PROJ + (size_t)row * NPROJ + C_Z + h * 64 + p0);
        const float v0 = (yv[t * 64 + p0] + Dh * xs[t * 64 + p0]) * siluf_(bf_lo(zz)), v1 = (yv[t * 64 + p0 + 1] + Dh * xs[t * 64 + p0 + 1]) * siluf_(bf_hi(zz));
        float ssq = v0 * v0 + v1 * v1;
        ssq += shx(ssq, 1); ssq += shx(ssq, 2); ssq += shx(ssq, 4); ssq += shx(ssq, 8); ssq += shx(ssq, 16);
        *(unsigned*)(Y + (size_t)row * 2048 + h * 64 + p0) = cvt_pk_bf16(v0 * PIN(I_SSDN)[(size_t)l * 1024 + h * 64 + p0], v1 * PIN(I_SSDN)[(size_t)l * 1024 + h * 64 + p0 + 1]);
        if ((t8 & 31) == 0) SSQ[(size_t)row * 16 + h] = ssq;
    }
}

__device__ void sgu_prompt(LAS uchar* lds, const Params& P, int l, int b, int c, int g) {
    const int tid = TIDX, lane = tid & 63, w = tid >> 6, fr = lane & 15, fq = lane >> 4;
    const bf16_t* PROJ = (const bf16_t*)((P.ws + launder_z()) + WS_PROJ); bf16_t* Y = (bf16_t*)((P.ws + launder_z()) + WS_Y);
    LAS float* smu = (LAS float*)(lds + 69632); LAS float* srs = smu + 128;
    const int grow0 = b * 2048 + c * 128;
    __syncthreads();
    {
        const int r = tid >> 2, q = tid & 3; const bf16_t* src = PROJ + (size_t)(grow0 + r) * NPROJ + C_V + q * 128;
        float s = 0.f, s2 = 0.f;
#pragma unroll
        for (int i = 0; i < 16; ++i) { const u32x4 v = *(const u32x4*)(src + i * 8);
            const float f[8] = {bf_lo(v.x), bf_hi(v.x), bf_lo(v.y), bf_hi(v.y), bf_lo(v.z), bf_hi(v.z), bf_lo(v.w), bf_hi(v.w)};
#pragma unroll
            for (int j = 0; j < 8; ++j) { s += f[j]; s2 += f[j] * f[j]; } }
        s += shx(s, 1); s += shx(s, 2); s2 += shx(s2, 1); s2 += shx(s2, 2);
        const float mu = s * (1.0f / 512.0f), var = fmaxf(s2 * (1.0f / 512.0f) - mu * mu, 0.f);
        if (q == 0) { smu[r] = mu; srs[r] = rsqrtf(var + EPS); }
        const float* wsrc = PIN(I_WSP) + ((size_t)(l * 4 + g) * 128 + r) * 128 + q * 32;
#pragma unroll
        for (int i = 0; i < 4; ++i) { const f32x4 a = *(const f32x4*)(wsrc + i * 8), bb = *(const f32x4*)(wsrc + i * 8 + 4); const int s0 = q * 32 + i * 8;
            u32x4 o; o.x = cvt_pk_bf16(s0 + 0 <= r ? a[0] : 0.f, s0 + 1 <= r ? a[1] : 0.f); o.y = cvt_pk_bf16(s0 + 2 <= r ? a[2] : 0.f, s0 + 3 <= r ? a[3] : 0.f);
            o.z = cvt_pk_bf16(s0 + 4 <= r ? bb[0] : 0.f, s0 + 5 <= r ? bb[1] : 0.f); o.w = cvt_pk_bf16(s0 + 6 <= r ? bb[2] : 0.f, s0 + 7 <= r ? bb[3] : 0.f);
            *(LAS u32x4*)(lds + r * PB + s0 * 2) = o; }
    }
    __syncthreads();
    {
        const int r = tid >> 2, q = tid & 3; const bf16_t* src = PROJ + (size_t)(grow0 + r) * NPROJ + C_V + g * 128 + q * 32;
        const float mu = smu[r], rs = srs[r];
        const float* lg = PIN(I_LNG) + (size_t)l * 512 + g * 128 + q * 32; const float* lb = PIN(I_LNB) + (size_t)l * 512 + g * 128 + q * 32;
        float* vout = (P.out + launder_z()) + O_VP + ((size_t)(l * 8 + b) * 128 + r) * 512 + g * 128 + q * 32;
#pragma unroll
        for (int i = 0; i < 4; ++i) { const u32x4 v = *(const u32x4*)(src + i * 8);
            const float f[8] = {bf_lo(v.x), bf_hi(v.x), bf_lo(v.y), bf_hi(v.y), bf_lo(v.z), bf_hi(v.z), bf_lo(v.w), bf_hi(v.w)}; float vn[8];
#pragma unroll
            for (int j = 0; j < 8; ++j) { vn[j] = (f[j] - mu) * rs * lg[i * 8 + j] + lb[i * 8 + j];
                *(LAS bf16_t*)(lds + 34816 + (q * 32 + i * 8 + j) * PB + r * 2) = (bf16_t)(cvt_pk_bf16(vn[j], 0.f) & 0xffffu); }
            if (c == 15) { *(f32x4*)(vout + i * 8) = (f32x4){vn[0], vn[1], vn[2], vn[3]}; *(f32x4*)(vout + i * 8 + 4) = (f32x4){vn[4], vn[5], vn[6], vn[7]}; } }
    }
    __syncthreads();
    {
        f32x4 acc[8];
#pragma unroll
        for (int i = 0; i < 8; ++i) acc[i] = (f32x4){0.f, 0.f, 0.f, 0.f};
        wmma<8, 4>(lds + w * 16 * PB, lds + 34816, PB, acc, fr, fq);
        const int t = 16 * w + fr, row = grow0 + t; const float bs = PIN(I_BSP)[(size_t)(l * 4 + g) * 128 + t];
#pragma unroll
        for (int ni = 0; ni < 8; ++ni) { const int d0 = ni * 16 + 4 * fq; const u32x2 uu = *(const u32x2*)(PROJ + (size_t)row * NPROJ + C_U + g * 128 + d0);
            u32x2 o; o.x = cvt_pk_bf16(bf_lo(uu.x) * (acc[ni][0] + bs), bf_hi(uu.x) * (acc[ni][1] + bs)); o.y = cvt_pk_bf16(bf_lo(uu.y) * (acc[ni][2] + bs), bf_hi(uu.y) * (acc[ni][3] + bs));
            *(u32x2*)(Y + (size_t)row * 2048 + 1024 + g * 128 + d0) = o; }
    }
}

__device__ void sgu_sample(LAS uchar* lds, const Params& P, int l, int b) {
    const int tid = TIDX, lane = tid & 63, w = tid >> 6, ch = tid, g = ch >> 7;
    const bf16_t* PROJ = (const bf16_t*)((P.ws + launder_z()) + WS_PROJ); bf16_t* Y = (bf16_t*)((P.ws + launder_z()) + WS_Y);
    LAS float* red = (LAS float*)lds;
    const int row0 = MPR + b * 8;
    float v[8], u[8];
#pragma unroll
    for (int s = 0; s < 8; ++s) { v[s] = bf1(PROJ[(size_t)(row0 + s) * NPROJ + C_V + ch]); u[s] = bf1(PROJ[(size_t)(row0 + s) * NPROJ + C_U + ch]); }
    __syncthreads();
#pragma unroll
    for (int s = 0; s < 8; ++s) { float a = v[s], a2 = v[s] * v[s];
#pragma unroll
        for (int m = 1; m < 64; m <<= 1) { a += shx(a, m); a2 += shx(a2, m); }
        if (lane == 0) { red[w * 16 + s] = a; red[w * 16 + 8 + s] = a2; } }
    __syncthreads();
    const float lg = PIN(I_LNG)[(size_t)l * 512 + ch], lb = PIN(I_LNB)[(size_t)l * 512 + ch];
    float vn[8];
#pragma unroll
    for (int s = 0; s < 8; ++s) { float a = 0.f, a2 = 0.f;
#pragma unroll
        for (int ww = 0; ww < 8; ++ww) { a += red[ww * 16 + s]; a2 += red[ww * 16 + 8 + s]; }
        const float mu = a * (1.0f / 512.0f), var = fmaxf(a2 * (1.0f / 512.0f) - mu * mu, 0.f);
        vn[s] = (v[s] - mu) * rsqrtf(var + EPS) * lg + lb;
        (P.out + launder_z())[O_VS + ((size_t)(l * 128 + b) * 8 + s) * 512 + ch] = vn[s]; }
    const float* W = PIN(I_WSP) + (size_t)(l * 4 + g) * 128 * 128; const float* bsp = PIN(I_BSP) + (size_t)(l * 4 + g) * 128;
#pragma unroll
    for (int t = 0; t < 8; ++t) { float o = bsp[t];
#pragma unroll
        for (int s = 0; s <= t; ++s) o += W[t * 128 + s] * vn[s];
        Y[(size_t)(row0 + t) * 2048 + 1024 + ch] = (bf16_t)(cvt_pk_bf16(u[t] * o, 0.f) & 0xffffu); }
}

__device__ void pool_prompt(const Params& P, int tile) {
    const int tid = TIDX, cgp = tid & 63, rsg = tid >> 6, ch0 = cgp * 8, wdw = 2 << (cgp >> 4);
    const bf16_t* PROJ = (const bf16_t*)((P.ws + launder_z()) + WS_PROJ); bf16_t* Y = (bf16_t*)((P.ws + launder_z()) + WS_Y);
    const int b = tile >> 4, pos0 = (tile & 15) * 128 + rsg * 16; const size_t rbase = (size_t)b * 2048;
    float S[8];
#pragma unroll
    for (int j = 0; j < 8; ++j) S[j] = 0.f;
    for (int k = 1; k < wdw; ++k) { const int pos = pos0 - k; if (pos >= 0) { const u32x4 v = *(const u32x4*)(PROJ + (rbase + pos) * NPROJ + C_POOL + ch0);
        S[0] += bf_lo(v.x); S[1] += bf_hi(v.x); S[2] += bf_lo(v.y); S[3] += bf_hi(v.y); S[4] += bf_lo(v.z); S[5] += bf_hi(v.z); S[6] += bf_lo(v.w); S[7] += bf_hi(v.w); } }
#pragma unroll 1
    for (int t = 0; t < 16; ++t) { const int pos = pos0 + t;
        const u32x4 v = *(const u32x4*)(PROJ + (rbase + pos) * NPROJ + C_POOL + ch0);
        const float x[8] = {bf_lo(v.x), bf_hi(v.x), bf_lo(v.y), bf_hi(v.y), bf_lo(v.z), bf_hi(v.z), bf_lo(v.w), bf_hi(v.w)};
        const float ic = 1.0f / (float)min(pos + 1, wdw); float d[8];
#pragma unroll
        for (int j = 0; j < 8; ++j) { S[j] += x[j]; d[j] = S[j] * ic - x[j]; }
        u32x4 o; o.x = cvt_pk_bf16(d[0], d[1]); o.y = cvt_pk_bf16(d[2], d[3]); o.z = cvt_pk_bf16(d[4], d[5]); o.w = cvt_pk_bf16(d[6], d[7]);
        *(u32x4*)(Y + (rbase + pos) * 2048 + 1536 + ch0) = o;
        const int po = pos - wdw + 1;
        if (po >= 0) { const u32x4 q = *(const u32x4*)(PROJ + (rbase + po) * NPROJ + C_POOL + ch0);
            S[0] -= bf_lo(q.x); S[1] -= bf_hi(q.x); S[2] -= bf_lo(q.y); S[3] -= bf_hi(q.y); S[4] -= bf_lo(q.z); S[5] -= bf_hi(q.z); S[6] -= bf_lo(q.w); S[7] -= bf_hi(q.w); } }
}
__device__ void pool_sample(const Params& P, int l, int si) {
    const int tid = TIDX, cgp = tid & 63, ch0 = cgp * 8, wdw = 2 << (cgp >> 4), b = si * 8 + (tid >> 6);
    const bf16_t* PROJ = (const bf16_t*)((P.ws + launder_z()) + WS_PROJ); bf16_t* Y = (bf16_t*)((P.ws + launder_z()) + WS_Y);
    const float* buf = PIN(I_SPOOL) + (size_t)(l * 128 + b) * 15 * 512 + ch0;
    const size_t rbase = (size_t)MPR + b * 8;
    float S[8];
#pragma unroll
    for (int j = 0; j < 8; ++j) S[j] = 0.f;
    for (int k = 1; k < wdw; ++k) { const f32x4 a = *(const f32x4*)(buf + (size_t)(15 - k) * 512), c = *(const f32x4*)(buf + (size_t)(15 - k) * 512 + 4);
        S[0] += a[0]; S[1] += a[1]; S[2] += a[2]; S[3] += a[3]; S[4] += c[0]; S[5] += c[1]; S[6] += c[2]; S[7] += c[3]; }
    const float ic = 1.0f / (float)wdw;
#pragma unroll 1
    for (int t = 0; t < 8; ++t) {
        const u32x4 v = *(const u32x4*)(PROJ + (rbase + t) * NPROJ + C_POOL + ch0);
        const float x[8] = {bf_lo(v.x), bf_hi(v.x), bf_lo(v.y), bf_hi(v.y), bf_lo(v.z), bf_hi(v.z), bf_lo(v.w), bf_hi(v.w)}; float d[8];
#pragma unroll
        for (int j = 0; j < 8; ++j) { S[j] += x[j]; d[j] = S[j] * ic - x[j]; }
        u32x4 o; o.x = cvt_pk_bf16(d[0], d[1]); o.y = cvt_pk_bf16(d[2], d[3]); o.z = cvt_pk_bf16(d[4], d[5]); o.w = cvt_pk_bf16(d[6], d[7]);
        *(u32x4*)(Y + (rbase + t) * 2048 + 1536 + ch0) = o;
        const int po = t - wdw + 1;
        if (po >= 0) { const u32x4 q = *(const u32x4*)(PROJ + (rbase + po) * NPROJ + C_POOL + ch0);
            S[0] -= bf_lo(q.x); S[1] -= bf_hi(q.x); S[2] -= bf_lo(q.y); S[3] -= bf_hi(q.y); S[4] -= bf_lo(q.z); S[5] -= bf_hi(q.z); S[6] -= bf_lo(q.w); S[7] -= bf_hi(q.w); }
        else { const f32x4 a = *(const f32x4*)(buf + (size_t)(15 + po) * 512), c = *(const f32x4*)(buf + (size_t)(15 + po) * 512 + 4);
            S[0] -= a[0]; S[1] -= a[1]; S[2] -= a[2]; S[3] -= a[3]; S[4] -= c[0]; S[5] -= c[1]; S[6] -= c[2]; S[7] -= c[3]; } }
}
constexpr int NC_CP = 8 * 3 * 1536, NC_CS = 128 * 3 * 1536, NC_PP = 8 * 15 * 512, NC_PS = 128 * 15 * 512, NC_ALL = NC_CP + NC_CS + NC_PP + NC_PS;
__device__ void state_copy(const Params& P, int l, int item) {
    const bf16_t* PROJ = (const bf16_t*)((P.ws + launder_z()) + WS_PROJ);
    for (int j = 0; j < 16; ++j) { int e = item * 8192 + j * NTHR + TIDX; if (e >= NC_ALL) return;
        if (e < NC_CP) { const int ch = e % 1536, k = (e / 1536) % 3, b = e / 4608; (P.out + launder_z())[O_CONVP + (size_t)l * NC_CP + e] = bf1(PROJ[(size_t)(b * 2048 + 2045 + k) * NPROJ + C_XBC + ch]); continue; } e -= NC_CP;
        if (e < NC_CS) { const int ch = e % 1536, k = (e / 1536) % 3, b = e / 4608; (P.out + launder_z())[O_CONVS + (size_t)l * NC_CS + e] = bf1(PROJ[(size_t)(MPR + b * 8 + 5 + k) * NPROJ + C_XBC + ch]); continue; } e -= NC_CS;
        if (e < NC_PP) { const int ch = e % 512, k = (e / 512) % 15, b = e / 7680; (P.out + launder_z())[O_POOLP + (size_t)l * NC_PP + e] = bf1(PROJ[(size_t)(b * 2048 + 2033 + k) * NPROJ + C_POOL + ch]); continue; } e -= NC_PP;
        { const int ch = e % 512, k = (e / 512) % 15, b = e / 7680;
          (P.out + launder_z())[O_POOLS + (size_t)l * NC_PS + e] = k < 7 ? PIN(I_SPOOL)[((size_t)(l * 128 + b) * 15 + 8 + k) * 512 + ch] : bf1(PROJ[(size_t)(MPR + b * 8 + (k - 7)) * NPROJ + C_POOL + ch]); }
    }
}

__device__ void phase_mixer(LAS uchar* lds, const Params& P, int l) {
    const int G = GDIM, bid = BIDX;
    constexpr int N_B = 1024, N_C = 512, N_D = 128, N_E = 128, N_E2 = 16, N_F = (NC_ALL + 8191) / 8192;
    constexpr int N_REST = N_B + N_C + N_D + N_E + N_E2 + N_F;
    int start, step;
    if (G > 128) { if (bid < 128) { ssd_prompt(lds, P, l, bid >> 4, bid & 15); start = -1; step = 1; } else { start = bid - 128; step = G - 128; } }
    else { for (int i = bid; i < 128; i += G) ssd_prompt(lds, P, l, i >> 4, i & 15); start = bid; step = G; }
    if (start < 0) return;
    for (int it = start; it < N_REST; it += step) {
        int j = it;
        if (j < N_C) { sgu_prompt(lds, P, l, j >> 6, (j >> 2) & 15, j & 3); continue; } j -= N_C;
        if (j < N_B) { ssd_sample(lds, P, l, j >> 3, j & 7); continue; } j -= N_B;
        if (j < N_D) { sgu_sample(lds, P, l, j); continue; } j -= N_D;
        if (j < N_E) { pool_prompt(P, j); continue; } j -= N_E;
        if (j < N_E2) { pool_sample(P, l, j); continue; } j -= N_E2;
        state_copy(P, l, j);
    }
}


#define XB_TMO      128
#define XB_XCNT(j)  (256  + 64 * (j))
#define XB_XSUB(j)  (1280 + 64 * (j))
#define XB_XGEN(j)  (2304 + 64 * (j))
#define XB_TOP      3328
#define XB_TOPGEN   3392
#define XCD_BAR_WORDS 3456
#define XB_SPIN_CAP (1u << 20)
__device__ __forceinline__ unsigned xb_ld(unsigned* p)              { return __hip_atomic_load(p, __ATOMIC_RELAXED, __HIP_MEMORY_SCOPE_AGENT); }
__device__ __forceinline__ unsigned xb_add(unsigned* p, unsigned v) { return __hip_atomic_fetch_add(p, v, __ATOMIC_RELAXED, __HIP_MEMORY_SCOPE_AGENT); }
__device__ __forceinline__ unsigned xb_xcc_id() { return (unsigned)__builtin_amdgcn_s_getreg((3 << 11) | 20) & 0xFu; }
#define XB_SPIN(cond, bar) do { unsigned _sp = 0; while (cond) { __builtin_amdgcn_s_sleep(1); \
    if ((++_sp & 255u) == 0u) { if (xb_ld(&(bar)[XB_TMO])) break; if (_sp > XB_SPIN_CAP) { atomicAdd(&(bar)[XB_TMO], 1u); break; } } } } while (0)
struct XcdBarrier { unsigned* bar; unsigned x; volatile LAS unsigned* st; };
__device__ __forceinline__ XcdBarrier xcd_barrier_post(unsigned* bar, volatile LAS unsigned* st) {
    XcdBarrier b; b.bar = bar; b.x = xb_xcc_id(); b.st = st;
    if (threadIdx.x == 0) (void)xb_add(&bar[XB_XCNT(b.x)], 1u);
    return b;
}
__device__ __forceinline__ void xcd_barrier_complete(unsigned* bar, unsigned x, unsigned& nloc, unsigned& nx) {
    const unsigned G = gridDim.x * gridDim.y * gridDim.z;
    unsigned sum, cnt, mine, sp = 0u;
    for (;;) {
        sum = 0u; cnt = 0u; mine = 0u;
#pragma unroll
        for (unsigned j = 0; j < 16; ++j) { const unsigned c = xb_ld(&bar[XB_XCNT(j)]); sum += c; cnt += (c > 0u) ? 1u : 0u; mine = (j == x) ? c : mine; }
        if (sum == G) break;
        __builtin_amdgcn_s_sleep(1);
        if ((++sp & 255u) == 0u) { if (xb_ld(&bar[XB_TMO])) break; if (sp > XB_SPIN_CAP) { atomicAdd(&bar[XB_TMO], 1u); break; } }
    }
    nloc = mine > 0u ? mine : 1u; nx = cnt > 0u ? cnt : 1u;
}
__device__ __forceinline__ void xcd_barrier(const XcdBarrier& b) {
    asm volatile("s_waitcnt vmcnt(0)" ::: "memory");
    __syncthreads();
    if (threadIdx.x == 0) {
        unsigned* bar = b.bar;
        __builtin_amdgcn_s_waitcnt(0);
        unsigned nloc = b.st[0], nx = b.st[1];
        if (nloc == 0u) { xcd_barrier_complete(bar, b.x, nloc, nx); b.st[0] = nloc; b.st[1] = nx; }
        const unsigned old = xb_add(&bar[XB_XSUB(b.x)], 1u);
        const unsigned gen = old / nloc;
        if (old + 1u == (gen + 1u) * nloc) {
            __builtin_amdgcn_fence(__ATOMIC_RELEASE, "agent");
            asm volatile("s_waitcnt vmcnt(0)" ::: "memory");
            const unsigned og = xb_add(&bar[XB_TOP], 1u);
            const unsigned tg = og / nx;
            if (og + 1u == (tg + 1u) * nx) xb_add(&bar[XB_TOPGEN], 1u);
            else XB_SPIN(xb_ld(&bar[XB_TOPGEN]) == tg, bar);
            __builtin_amdgcn_fence(__ATOMIC_ACQUIRE, "agent");
            xb_add(&bar[XB_XGEN(b.x)], 1u);
            asm volatile("s_waitcnt vmcnt(0)" ::: "memory");
        } else {
            XB_SPIN(xb_ld(&bar[XB_XGEN(b.x)]) == gen, bar);
            __builtin_amdgcn_fence(__ATOMIC_ACQUIRE, "agent");
            asm volatile("s_waitcnt vmcnt(0)" ::: "memory");
        }
    }
    __syncthreads();
}

__device__ __forceinline__ void run_phase(LAS uchar* lds, const Params& P, int ph) {
    uchar* ws = (P.ws + launder_z());
    float* RSS = (float*)(ws + WS_RSS);
    if (ph == 0) { phase_pre(lds, P); return; }
    if (ph == 30) {
        const int tid = TIDX, lane = tid & 63, wv = tid >> 6; const float* X = (const float*)(ws + WS_X); const float* fg = PIN(I_FN);
        for (int row = BIDX * 8 + wv; row < MT; row += GDIM * 8) { const float r = rownorm(RSS + (size_t)12 * MT * 16, row);
#pragma unroll
            for (int i = 0; i < 4; ++i) { const int col = i * 256 + lane * 4; const f32x4 v = *(const f32x4*)(X + (size_t)row * 1024 + col), gg = *(const f32x4*)(fg + col);
                *(f32x4*)((P.out + launder_z()) + O_Y + (size_t)row * 1024 + col) = (f32x4){v[0] * r * gg[0], v[1] * r * gg[1], v[2] * r * gg[2], v[3] * r * gg[3]}; } }
        return; }
    const int l = ph >= 2 ? (ph - 2) / 7 : 0, s = ph >= 2 ? (ph - 2) % 7 : -1;
    if (s == 1) { phase_mixer(lds, P, l); return; }
    bf16_t* xn_cur = (bf16_t*)(ws + ((l & 1) ? WS_XN2 : WS_XN)); bf16_t* xn_alt = (bf16_t*)(ws + ((l & 1) ? WS_XN : WS_XN2));
#define GINIT GPh g; g.G = GDIM; g.c = BIDX; g.nseg = 1; g.nlay = 1; g.a_lay = 0; g.b_lay = 0; g.nM = MT / 256; \
    g.rss = nullptr; g.rss_next = nullptr; g.gnext = nullptr; g.X = (float*)(ws + WS_X); g.XN = xn_alt; g.O = nullptr; g.DT = (float*)(ws + WS_DT); \
    g.PROJ = (const bf16_t*)(ws + WS_PROJ); g.SSQ = (const float*)(ws + WS_SSQ); g.UPB = nullptr; \
    g.A = xn_cur; g.lda = 1024; g.ldb = 1024; g.K = 1024; g.nN = 4;
    switch (s) {
    case -1: { GINIT g.A = (const bf16_t*)(ws + WS_PBF); g.Bt = (const bf16_t*)(ws + WS_WPU); g.lda = 256; g.ldb = 256; g.K = 256; g.nlay = 4; g.a_lay = (size_t)MT * 256; g.b_lay = (size_t)1024 * 256;
        g.O = (bf16_t*)(ws + WS_UP); gemm_phase<EPI_UP>(lds, g); } break;
    case 0: { GINIT g.Bt = (const bf16_t*)(ws + WS_WIN) + (size_t)l * NIN * 1024; g.nN = NIN / 256;
        g.rss = RSS + (size_t)(3 * l) * MT * 16; g.O = (bf16_t*)(ws + WS_PROJ); gemm_phase<EPI_P1>(lds, g); } break;
    case 2: { GINIT g.A = (const bf16_t*)(ws + WS_Y); g.Bt = (const bf16_t*)(ws + WS_WBR) + (size_t)l * 1024 * 2048; g.lda = 2048; g.ldb = 2048; g.K = 512; g.nseg = 4;
        g.O = (bf16_t*)(ws + WS_MRG); gemm_phase<EPI_P3>(lds, g); } break;
    case 3: { GINIT g.A = (const bf16_t*)(ws + WS_MRG); g.Bt = (const bf16_t*)(ws + WS_WOUT) + (size_t)l * 1024 * 1024;
        g.rss_next = RSS + (size_t)(3 * l + 1) * MT * 16; g.gnext = PIN(I_NFFN) + (size_t)l * 1024; gemm_phase<EPI_P4>(lds, g); } break;
    case 4: { GINIT g.A = xn_alt; g.Bt = (const bf16_t*)(ws + WS_WGU) + (size_t)l * 5632 * 1024; g.nN = 22;
        g.rss = RSS + (size_t)(3 * l + 1) * MT * 16; g.O = (bf16_t*)(ws + WS_ACT); gemm_phase<EPI_P5>(lds, g); } break;
    case 5: { GINIT g.A = (const bf16_t*)(ws + WS_ACT); g.Bt = (const bf16_t*)(ws + WS_WDN) + (size_t)l * 1024 * DFF; g.lda = DFF; g.ldb = DFF; g.K = DFF;
        g.XN = xn_cur; g.rss_next = RSS + (size_t)(3 * l + 2) * MT * 16; g.gnext = PIN(I_NPLE) + (size_t)l * 1024; gemm_phase<EPI_P6>(lds, g); } break;
    default: { GINIT g.Bt = (const bf16_t*)(ws + WS_WPG) + (size_t)l * 1024 * 1024;
        g.rss = RSS + (size_t)(3 * l + 2) * MT * 16; g.rss_next = RSS + (size_t)(3 * l + 3) * MT * 16; g.gnext = l < 3 ? PIN(I_NMIX) + (size_t)(l + 1) * 1024 : PIN(I_FN);
        g.UPB = (const bf16_t*)(ws + WS_UP) + (size_t)l * MT * 1024; gemm_phase<EPI_P7>(lds, g); } break;
    }
#undef GINIT
}

__global__ void __launch_bounds__(NTHR, 2) hybrid_fwd(Params P) {
    extern __shared__ __attribute__((aligned(16))) uchar smem[];
    LAS uchar* lds = (LAS uchar*)smem;
    cg::grid_group grid = cg::this_grid();
    volatile LAS unsigned* st = (volatile LAS unsigned*)(lds + LDS_BYTES);
    if (threadIdx.x < 4) st[threadIdx.x] = 0u;
    __syncthreads();
    const XcdBarrier xbar = xcd_barrier_post((unsigned*)(P.ws + WS_BAR), st);
    for (int ph = P.ph_lo; ph < P.ph_hi; ++ph) {
        int nrep_ = 1;
#ifdef PROBE_REP
        { const int s_ = ph >= 2 && ph < 30 ? (ph - 2) % 7 : (ph == 0 ? 7 : (ph == 1 ? 8 : 9)); if ((PROBE_REP >> s_) & 1) nrep_ = 2; }
#endif
#pragma unroll 1
        for (int r_ = 0; r_ < nrep_; ++r_) { run_phase(lds, P, ph); __syncthreads(); }
        if (ph + 1 < P.ph_hi) {
            if (ph == P.ph_lo) {
                asm volatile("s_waitcnt vmcnt(0)" ::: "memory");
                __syncthreads();
                if (threadIdx.x < 64) { __builtin_amdgcn_fence(__ATOMIC_RELEASE, "agent"); asm volatile("s_waitcnt vmcnt(0)" ::: "memory"); }
                __syncthreads();
                grid.sync();
                if (threadIdx.x < 64) { __builtin_amdgcn_fence(__ATOMIC_ACQUIRE, "agent"); asm volatile("s_waitcnt vmcnt(0)" ::: "memory"); }
                __syncthreads();
            } else xcd_barrier(xbar);
        }
    }
}

extern "C" void kernel_launch(void* const* d_in, const int* in_sizes, int n_in, void* d_out, int out_size, void* d_ws, size_t ws_size, hipStream_t stream) {
    static int grid = 0;
    if (grid == 0) {
        if (n_in != 32 || (size_t)out_size != O_END || ws_size < WS_END) { fprintf(stderr, "kernel_launch: shape mismatch n_in %d out %d (want %zu) ws %zu (want %zu)\n", n_in, out_size, (size_t)O_END, ws_size, (size_t)WS_END); grid = -1; return; }
        int dev = 0, cus = 0, per_cu = 0;
        hipGetDevice(&dev); hipDeviceGetAttribute(&cus, hipDeviceAttributeMultiprocessorCount, dev);
        if (hipFuncSetAttribute((const void*)hybrid_fwd, hipFuncAttributeMaxDynamicSharedMemorySize, LDS_BYTES + 16) != hipSuccess) { fprintf(stderr, "kernel_launch: hipFuncSetAttribute failed\n"); grid = -1; return; }
        hipOccupancyMaxActiveBlocksPerMultiprocessor(&per_cu, (const void*)hybrid_fwd, NTHR, LDS_BYTES + 16);
        if (per_cu < 1) { fprintf(stderr, "kernel_launch: occupancy query says %d blocks per CU\n", per_cu); per_cu = 1; }
        grid = cus * 1;
        fprintf(stderr, "kernel_launch: cus %d per_cu %d grid %d\n", cus, per_cu, grid);
    }
    if (grid < 0) return;
    hipMemsetAsync((char*)d_ws + WS_BAR, 0, 16384, stream);
    Params p{};
    for (int i = 0; i < 32; ++i) p.in[i] = (const float*)d_in[i];
    p.out = (float*)d_out; p.ws = (uchar*)d_ws;
#if MULTI_LAUNCH
    for (int ph = 0; ph < 31; ++ph) { p.ph_lo = ph; p.ph_hi = ph + 1; hipLaunchKernelGGL(hybrid_fwd, dim3(grid), dim3(NTHR), LDS_BYTES + 16, stream, p); }
#else
    p.ph_lo = 0; p.ph_hi = 31;
    void* args[] = {&p};
    hipError_t e = hipLaunchCooperativeKernel((const void*)hybrid_fwd, dim3(grid), dim3(NTHR), args, LDS_BYTES + 16, stream);
    if (e != hipSuccess) fprintf(stderr, "cooperative launch failed: %s (grid %d)\n", hipGetErrorString(e), grid);
#endif
}
```

```cpp
#include <hip/hip_runtime.h>
#include <hip/hip_cooperative_groups.h>
#include <cstdio>
namespace cg = cooperative_groups;

#define LAS __attribute__((address_space(3)))
typedef unsigned short bf16_t;
typedef unsigned char uchar;
typedef short bf16x8 __attribute__((ext_vector_type(8)));
typedef float f32x4 __attribute__((ext_vector_type(4)));
typedef unsigned u32x4 __attribute__((ext_vector_type(4)));
typedef unsigned u32x2 __attribute__((ext_vector_type(2)));

#ifndef MULTI_LAUNCH
#define MULTI_LAUNCH 0
#endif

constexpr int MT = 17408, MPR = 16384, DM = 1024, NPROJ = 7168, NIN = 7424, DFF = 2816;
constexpr float EPS = 1e-6f;
constexpr int NTHR = 512;
constexpr int LDS_BYTES = 141312;
constexpr int C_Z = 0, C_XBC = 1024, C_U = 2560, C_V = 3072, C_POOL = 3584, C_GA = 4096, C_GB = 5120, C_GC = 6144;
constexpr size_t al256(size_t x) { return (x + 255) & ~(size_t)255; }
constexpr size_t WS_WIN = 0;
constexpr size_t WS_WBR = WS_WIN + (size_t)4 * NIN * 1024 * 2;
constexpr size_t WS_WOUT = WS_WBR + (size_t)4 * 1024 * 2048 * 2;
constexpr size_t WS_WGU = WS_WOUT + (size_t)4 * 1024 * 1024 * 2;
constexpr size_t WS_WDN = WS_WGU + (size_t)4 * 5632 * 1024 * 2;
constexpr size_t WS_WPG = WS_WDN + (size_t)4 * 1024 * 2816 * 2;
constexpr size_t WS_WPU = WS_WPG + (size_t)4 * 1024 * 1024 * 2;
constexpr size_t WS_X = WS_WPU + (size_t)4 * 1024 * 256 * 2;
constexpr size_t WS_XN = WS_X + (size_t)MT * 1024 * 4;
constexpr size_t WS_RSS = WS_XN + (size_t)MT * 1024 * 2;
constexpr size_t WS_PROJ = al256(WS_RSS + (size_t)13 * MT * 16 * 4);
constexpr size_t WS_DT = WS_PROJ + (size_t)MT * NPROJ * 2;
constexpr size_t WS_Y = WS_DT + (size_t)MT * 16 * 4;
constexpr size_t WS_SSQ = WS_Y + (size_t)MT * 2048 * 2;
constexpr size_t WS_MRG = WS_SSQ + (size_t)MT * 16 * 4;
constexpr size_t WS_ACT = WS_MRG + (size_t)MT * 1024 * 2;
constexpr size_t WS_UP = WS_ACT + (size_t)MT * DFF * 2;
constexpr size_t WS_PBF = WS_UP + (size_t)4 * MT * 1024 * 2;
constexpr size_t WS_XN2 = WS_PBF + (size_t)4 * MT * 256 * 2;
constexpr size_t WS_BAR = WS_XN2 + (size_t)MT * 1024 * 2;
constexpr size_t WS_END = WS_BAR + 16384;
constexpr size_t O_Y = 0;
constexpr size_t O_CONVP = (size_t)MT * 1024;
constexpr size_t O_SSMP = O_CONVP + (size_t)4 * 8 * 3 * 1536;
constexpr size_t O_POOLP = O_SSMP + (size_t)4 * 8 * 16 * 64 * 128;
constexpr size_t O_VP = O_POOLP + (size_t)4 * 8 * 15 * 512;
constexpr size_t O_CONVS = O_VP + (size_t)4 * 8 * 128 * 512;
constexpr size_t O_SSMS = O_CONVS + (size_t)4 * 128 * 3 * 1536;
constexpr size_t O_POOLS = O_SSMS + (size_t)4 * 128 * 16 * 64 * 128;
constexpr size_t O_VS = O_POOLS + (size_t)4 * 128 * 15 * 512;
constexpr size_t O_END = O_VS + (size_t)4 * 128 * 8 * 512;

struct Params {
    const float* in[32];
    float* out;
    uchar* ws;
    int ph_lo, ph_hi;
};
enum { I_XP = 0, I_XS, I_SCONV, I_SSSM, I_SPOOL, I_PP, I_PS, I_NMIX, I_WIN, I_CONVW, I_CONVB, I_DTB, I_ALOG, I_DSKIP, I_SSDN, I_LNG, I_LNB, I_WSP, I_BSP,
       I_POOLW, I_POOLS, I_WBRA, I_WBRB, I_WBRC, I_WOUT, I_NFFN, I_WGU, I_WDN, I_NPLE, I_WPG, I_WPU, I_FN };


__device__ __forceinline__ int launder_s(int i) { asm volatile("" : "+s"(i)); return i; }
__device__ __forceinline__ int launder_v(int i) { asm volatile("" : "+v"(i)); return i; }
template <class T> __device__ __forceinline__ T* launder_p(T* p) { asm volatile("" : "+s"(p)); return p; }
__device__ __forceinline__ size_t launder_z() { size_t z = 0; asm volatile("" : "+s"(z)); return z; }
typedef const float __attribute__((address_space(1)))* gcf_t;
#define PIN(i) ((const float*)(gcf_t)(P.in[launder_s(i)]))
#define TIDX launder_v((int)threadIdx.x)
#define BIDX launder_s((int)blockIdx.x)
#define GDIM launder_s((int)gridDim.x)
__device__ __forceinline__ unsigned cvt_pk_bf16(float lo, float hi) { unsigned r; asm("v_cvt_pk_bf16_f32 %0, %1, %2" : "=v"(r) : "v"(lo), "v"(hi)); return r; }
__device__ __forceinline__ float bf_lo(unsigned w) { return __uint_as_float(w << 16); }
__device__ __forceinline__ float bf_hi(unsigned w) { return __uint_as_float(w & 0xffff0000u); }
__device__ __forceinline__ float bf1(bf16_t b) { return __uint_as_float(((unsigned)b) << 16); }
__device__ __forceinline__ float frcp(float x) { return __builtin_amdgcn_rcpf(x); }
__device__ __forceinline__ float sigmoidf_(float x) { return frcp(1.0f + __expf(-x)); }
__device__ __forceinline__ float siluf_(float x) { return x * sigmoidf_(x); }
__device__ __forceinline__ float gelu_tanh(float x) { const float u = 1.5957691216057308f * (x + 0.044715f * x * x * x); return x * sigmoidf_(u); }
__device__ __forceinline__ float softplusf_(float x) { return x > 20.f ? x : log1pf(__expf(x)); }
__device__ __forceinline__ float shx(float v, int m) { return __shfl_xor(v, m, 64); }

__device__ __forceinline__ float rownorm(const float* rssp, int row) {
    const f32x4 a = *(const f32x4*)(rssp + (size_t)row * 16), b = *(const f32x4*)(rssp + (size_t)row * 16 + 4), c = *(const f32x4*)(rssp + (size_t)row * 16 + 8), d = *(const f32x4*)(rssp + (size_t)row * 16 + 12);
    const float s = ((a[0] + a[1]) + (a[2] + a[3])) + ((b[0] + b[1]) + (b[2] + b[3])) + ((c[0] + c[1]) + (c[2] + c[3])) + ((d[0] + d[1]) + (d[2] + d[3]));
    return rsqrtf(s * (1.0f / 1024.0f) + EPS);
}
constexpr int BM = 256, BK = 64, HALF = 128, HTB = HALF * BK * 2, NXCD = 8, WGM = 8;
__device__ __forceinline__ int lds_byte(int r, int c) { const int st = (r >> 4) * 2 + (c >> 5), rr = r & 15, cc = c & 31, ob = rr * 64 + cc * 2; return st * 1024 + (ob ^ (((ob >> 9) & 1) << 5)); }
__device__ __forceinline__ void stage_rc(int b, int& R, int& C) { const int st = b / 1024, sb = b % 1024, swz = sb ^ (((sb >> 9) & 1) << 5); R = (st >> 1) * 16 + swz / 64; C = (st & 1) * 32 + (swz % 64) / 2; }

struct Unit { int pm, pn, seg, lay; };
enum { EPI_UP = 0, EPI_P1, EPI_P3, EPI_P4, EPI_P5, EPI_P6, EPI_P7 };

struct GPh {
    const bf16_t* A; const bf16_t* Bt; int lda, ldb, K, nM, nN, nseg, nlay; size_t a_lay, b_lay;
    int G, c;
    const float* rss; float* rss_next; const float* gnext; float* X; bf16_t* XN; bf16_t* O; float* DT; const bf16_t* PROJ; const float* SSQ; const bf16_t* UPB;
    __device__ __forceinline__ bool next(int i, Unit& u) const {
        const int tiles = nM * nN; const long L = (long)(i / nseg) * G + c; if (L >= (long)tiles * nlay) return false;
        u.seg = i % nseg; u.lay = (int)(L / tiles); int wgid = (int)(L % tiles);
        { const int q = tiles / NXCD, r = tiles % NXCD, xcd = wgid % NXCD, off = wgid / NXCD; wgid = (xcd < r ? xcd * (q + 1) : r * (q + 1) + (xcd - r) * q) + off; }
        const int nig = WGM * nN, gid = wgid / nig, fm = gid * WGM, gsz = (nM - fm) < WGM ? (nM - fm) : WGM;
        u.pm = fm + ((wgid % nig) % gsz); u.pn = (wgid % nig) / gsz; return true;
    }
    __device__ __forceinline__ const char* pa(const Unit& u) const { return (const char*)(A + u.lay * a_lay + (size_t)u.pm * BM * lda + (size_t)u.seg * K); }
    __device__ __forceinline__ const char* pb(const Unit& u) const { return (const char*)(Bt + u.lay * b_lay + (size_t)u.pn * BM * ldb + (size_t)u.seg * K); }
};

__device__ __forceinline__ void p3_rowscale(const GPh& P, const int row, const int seg, float& rs0, float& rs1) {
    rs0 = 1.f; rs1 = 1.f;
    if (seg < 2) { const f32x4 a0 = *(const f32x4*)(P.SSQ + (size_t)row * 16), a1 = *(const f32x4*)(P.SSQ + (size_t)row * 16 + 4), b0 = *(const f32x4*)(P.SSQ + (size_t)row * 16 + 8), b1 = *(const f32x4*)(P.SSQ + (size_t)row * 16 + 12);
        rs0 = rsqrtf((a0[0] + a0[1] + a0[2] + a0[3] + a1[0] + a1[1] + a1[2] + a1[3]) * (1.0f / 512.0f) + EPS);
        rs1 = rsqrtf((b0[0] + b0[1] + b0[2] + b0[3] + b1[0] + b1[1] + b1[2] + b1[3]) * (1.0f / 512.0f) + EPS); }
}
__device__ __forceinline__ void p3_elem(const GPh& P, f32x4& v, const int row, const int col, const int seg, const float rs0, const float rs1) {
    const bf16_t* prow = P.PROJ + (size_t)row * NPROJ;
    if (seg == 0) { v = v * (rs0 * frcp(rs1)); }
    else if (seg == 1) { const u32x2 ga = *(const u32x2*)(prow + C_GA + col), gb = *(const u32x2*)(prow + C_GB + col);
        v[0] *= rs1 * bf_lo(ga.x) * frcp(bf_lo(gb.x)); v[1] *= rs1 * bf_hi(ga.x) * frcp(bf_hi(gb.x)); v[2] *= rs1 * bf_lo(ga.y) * frcp(bf_lo(gb.y)); v[3] *= rs1 * bf_hi(ga.y) * frcp(bf_hi(gb.y)); }
    else if (seg == 2) { const u32x2 ga = *(const u32x2*)(prow + C_GB + col), gb = *(const u32x2*)(prow + C_GC + col);
        v[0] *= bf_lo(ga.x) * frcp(bf_lo(gb.x)); v[1] *= bf_hi(ga.x) * frcp(bf_hi(gb.x)); v[2] *= bf_lo(ga.y) * frcp(bf_lo(gb.y)); v[3] *= bf_hi(ga.y) * frcp(bf_hi(gb.y)); }
    else { const u32x2 gc = *(const u32x2*)(prow + C_GC + col);
        u32x2 o; o.x = cvt_pk_bf16(v[0] * bf_lo(gc.x), v[1] * bf_hi(gc.x)); o.y = cvt_pk_bf16(v[2] * bf_lo(gc.y), v[3] * bf_hi(gc.y)); *(u32x2*)(P.O + (size_t)row * 1024 + col) = o; }
}
template <int EPI>
__device__ __forceinline__ void epi_row(const GPh& P, f32x4 (&a)[2][2], const int row, const int col0, const int pn, const int wc, const int fq, const int seg, const int lay) {
    if constexpr (EPI == EPI_UP) {
        bf16_t* O = P.O + (size_t)lay * MT * 1024;
#pragma unroll
        for (int bj = 0; bj < 2; ++bj)
#pragma unroll
            for (int n = 0; n < 2; ++n) { const int col = col0 + bj * HALF + n * 16; const f32x4 v = a[bj][n];
                u32x2 o; o.x = cvt_pk_bf16(v[0], v[1]); o.y = cvt_pk_bf16(v[2], v[3]); *(u32x2*)(O + (size_t)row * 1024 + col) = o; }
    } else if constexpr (EPI == EPI_P1) {
        const float r = rownorm(P.rss, row);
#pragma unroll
        for (int bj = 0; bj < 2; ++bj)
#pragma unroll
            for (int n = 0; n < 2; ++n) { const int col = col0 + bj * HALF + n * 16; f32x4 v = a[bj][n] * r;
                if (pn == 28) { if (col - NPROJ < 16) *(f32x4*)(P.DT + (size_t)row * 16 + (col - NPROJ)) = v; }
                else {
                    if (pn >= 10 && pn < 14) { v[0] = gelu_tanh(v[0]); v[1] = gelu_tanh(v[1]); v[2] = gelu_tanh(v[2]); v[3] = gelu_tanh(v[3]); }
                    else if (pn >= 16) { v[0] = sigmoidf_(v[0]); v[1] = sigmoidf_(v[1]); v[2] = sigmoidf_(v[2]); v[3] = sigmoidf_(v[3]); }
                    u32x2 o; o.x = cvt_pk_bf16(v[0], v[1]); o.y = cvt_pk_bf16(v[2], v[3]); *(u32x2*)(P.O + (size_t)row * NPROJ + col) = o; } }
    } else if constexpr (EPI == EPI_P3) {
        float rs0, rs1; p3_rowscale(P, row, seg, rs0, rs1);
#pragma unroll
        for (int bj = 0; bj < 2; ++bj)
#pragma unroll
            for (int n = 0; n < 2; ++n) p3_elem(P, a[bj][n], row, col0 + bj * HALF + n * 16, seg, rs0, rs1);
    } else if constexpr (EPI == EPI_P5) {
        const float r = rownorm(P.rss, row);
#pragma unroll
        for (int bj = 0; bj < 2; ++bj) { const f32x4 g = a[bj][0] * r, uu = a[bj][1] * r;
            const int ocol = 16 * (8 * pn + 4 * bj + wc) + 4 * fq;
            u32x2 o; o.x = cvt_pk_bf16(siluf_(g[0]) * uu[0], siluf_(g[1]) * uu[1]); o.y = cvt_pk_bf16(siluf_(g[2]) * uu[2], siluf_(g[3]) * uu[3]);
            *(u32x2*)(P.O + (size_t)row * DFF + ocol) = o; }
    } else {
        float ss = 0.f; float r7 = 0.f;
        if constexpr (EPI == EPI_P7) r7 = rownorm(P.rss, row);
#pragma unroll
        for (int bj = 0; bj < 2; ++bj)
#pragma unroll
            for (int n = 0; n < 2; ++n) { const int col = col0 + bj * HALF + n * 16; const f32x4 v = a[bj][n];
                f32x4 xv = *(const f32x4*)(P.X + (size_t)row * 1024 + col);
                if constexpr (EPI == EPI_P7) { const u32x2 up = *(const u32x2*)(P.UPB + (size_t)row * 1024 + col);
                    xv[0] += bf_lo(up.x) * sigmoidf_(v[0] * r7); xv[1] += bf_hi(up.x) * sigmoidf_(v[1] * r7); xv[2] += bf_lo(up.y) * sigmoidf_(v[2] * r7); xv[3] += bf_hi(up.y) * sigmoidf_(v[3] * r7); }
                else xv += v;
                *(f32x4*)(P.X + (size_t)row * 1024 + col) = xv;
                ss += xv[0] * xv[0] + xv[1] * xv[1] + xv[2] * xv[2] + xv[3] * xv[3];
                const f32x4 gn = *(const f32x4*)(P.gnext + col);
                u32x2 o; o.x = cvt_pk_bf16(xv[0] * gn[0], xv[1] * gn[1]); o.y = cvt_pk_bf16(xv[2] * gn[2], xv[3] * gn[3]); *(u32x2*)(P.XN + (size_t)row * 1024 + col) = o; }
        ss += shx(ss, 16); ss += shx(ss, 32);
        if (fq == 0) P.rss_next[(size_t)row * 16 + pn * 4 + wc] = ss;
    }
}
template <int EPI>
__device__ __forceinline__ void epilogue(const GPh& P, f32x4 (&acc)[2][2][4][2], const Unit& u, int, int, int, int) {
    const int tid_ = TIDX, wid_ = tid_ >> 6, wr = wid_ >> 2, wc = wid_ & 3, fr = tid_ & 15, fq = (tid_ >> 4) & 3;
    const int row0 = u.pm * BM + wr * 64 + fr, col0 = u.pn * BM + wc * 32 + 4 * fq;
#pragma unroll
    for (int ai = 0; ai < 2; ++ai)
#pragma unroll
        for (int m = 0; m < 4; ++m) {
            const int row = row0 + ai * HALF + m * 16;
            if constexpr (EPI == EPI_P3) {
                float rs0, rs1; p3_rowscale(P, row, u.seg, rs0, rs1);
#pragma unroll
                for (int bj = 0; bj < 2; ++bj)
#pragma unroll
                    for (int n = 0; n < 2; ++n) p3_elem(P, acc[ai][bj][m][n], row, col0 + bj * HALF + n * 16, u.seg, rs0, rs1);
            } else {
                f32x4 a[2][2] = {{acc[ai][0][m][0], acc[ai][0][m][1]}, {acc[ai][1][m][0], acc[ai][1][m][1]}};
                epi_row<EPI>(P, a, row, col0, u.pn, wc, fq, u.seg, u.lay);
            }
        }
}

template <int EPI>
__device__ __forceinline__ void mini_gemm(LAS uchar* lds, const GPh& P) {
    const int tid = TIDX, wid = tid >> 6, lane = tid & 63, kh = wid >> 2, wc = wid & 3, fr = lane & 15, fq = lane >> 4;
    const int nseg = P.nseg, K = P.K, Kh = K >> 1;
    for (int su = P.c; su < 256; su += P.G) {
        const int strip = su >> 2, pn = su & 3; const int row = MPR + strip * 16 + fr;
        const bf16_t* Ap = P.A + (size_t)row * P.lda + fq * 8;
        const bf16_t* Bp = P.Bt + (size_t)(pn * 256 + wc * 32 + fr) * P.ldb + fq * 8;
        f32x4 a[2][2];
#pragma unroll
        for (int bj = 0; bj < 2; ++bj)
#pragma unroll
            for (int n = 0; n < 2; ++n) a[bj][n] = (f32x4){0.f, 0.f, 0.f, 0.f};
        __syncthreads();
        for (int seg = 0; seg < nseg; ++seg) {
            const int kbeg = seg * K + kh * Kh;
#pragma unroll 1
            for (int k0 = kbeg; k0 < kbeg + Kh; k0 += 128) {
                bf16x8 af[4], bfr[4][2][2];
#pragma unroll
                for (int s = 0; s < 4; ++s) { af[s] = *(const bf16x8*)(Ap + k0 + s * 32);
#pragma unroll
                    for (int bj = 0; bj < 2; ++bj)
#pragma unroll
                        for (int n = 0; n < 2; ++n) bfr[s][bj][n] = *(const bf16x8*)(Bp + (size_t)(bj * HALF + n * 16) * P.ldb + k0 + s * 32); }
#pragma unroll
                for (int s = 0; s < 4; ++s)
#pragma unroll
                    for (int bj = 0; bj < 2; ++bj)
#pragma unroll
                        for (int n = 0; n < 2; ++n) a[bj][n] = __builtin_amdgcn_mfma_f32_16x16x32_bf16(bfr[s][bj][n], af[s], a[bj][n], 0, 0, 0);
            }
            if (EPI == EPI_P3 && seg < 3) epi_row<EPI>(P, a, row, pn * 256 + wc * 32 + 4 * fq, pn, wc, fq, seg, 0);
        }
        LAS f32x4* xch = (LAS f32x4*)lds;
        if (kh == 1) {
#pragma unroll
            for (int bj = 0; bj < 2; ++bj)
#pragma unroll
                for (int n = 0; n < 2; ++n) xch[((wc * 4 + bj * 2 + n) * 64) + lane] = a[bj][n];
        }
        __syncthreads();
        if (kh == 0) {
#pragma unroll
            for (int bj = 0; bj < 2; ++bj)
#pragma unroll
                for (int n = 0; n < 2; ++n) a[bj][n] += xch[((wc * 4 + bj * 2 + n) * 64) + lane];
            epi_row<EPI>(P, a, row, pn * 256 + wc * 32 + 4 * fq, pn, wc, fq, nseg - 1, 0);
        }
    }
}

template <int EPI>
__device__ __forceinline__ void gemm_phase(LAS uchar* lds, const GPh& P) {
    const int tid = TIDX, wid = __builtin_amdgcn_readfirstlane(tid >> 6), lane = tid & 63, wr = wid >> 2, wc = wid & 3, fr = lane & 15, fq = lane >> 4;
    const int K = P.K, nt = K / BK;
    unsigned voffA[2], voffB[2];
#pragma unroll
    for (int i = 0; i < 2; ++i) { int R, C; stage_rc(tid * 16 + i * 8192, R, C); voffA[i] = (unsigned)(R * P.lda + C) * 2u; voffB[i] = (unsigned)(R * P.ldb + C) * 2u; }
    const size_t kstep = (size_t)(BK * 2);
    const size_t hstepA = (size_t)HALF * P.lda * 2, hstepB = (size_t)HALF * P.ldb * 2;
    const unsigned ldsw = (unsigned)wid * 1024u;
    const int aoff = lds_byte(wr * 64 + fr, fq * 8), boff = lds_byte(wc * 32 + fr, fq * 8);
#define PG8_SA(b, h) (((b) * 2 + (h)) * HTB)
#define PG8_SB(b, h) ((4 + (b) * 2 + (h)) * HTB)
#define PG8_STAGE(bufoff, gbase, voff) do { _Pragma("unroll") for (int _i = 0; _i < 2; ++_i) \
        __builtin_amdgcn_global_load_lds((const unsigned*)((const char*)(gbase) + (voff)[_i]), (LAS unsigned*)(lds + (bufoff) + ldsw + _i * 8192), 16, 0, 0); } while (0)
#define PG8_LDA(dst, b, h) do { _Pragma("unroll") for (int m = 0; m < 4; ++m) _Pragma("unroll") for (int k = 0; k < 2; ++k) dst[m][k] = *(const LAS bf16x8*)(lds + PG8_SA(b, h) + aoff + m * 2048 + k * 1024); } while (0)
#define PG8_LDB(dst, b, h) do { _Pragma("unroll") for (int n = 0; n < 2; ++n) _Pragma("unroll") for (int k = 0; k < 2; ++k) dst[n][k] = *(const LAS bf16x8*)(lds + PG8_SB(b, h) + boff + n * 2048 + k * 1024); } while (0)
#define PG8_MMA(ai, bj, At, Bt) do { __builtin_amdgcn_s_setprio(1); _Pragma("unroll") for (int m = 0; m < 4; ++m) _Pragma("unroll") for (int n = 0; n < 2; ++n) _Pragma("unroll") for (int k = 0; k < 2; ++k) \
        acc[ai][bj][m][n] = __builtin_amdgcn_mfma_f32_16x16x32_bf16(Bt[n][k], At[m][k], acc[ai][bj][m][n], 0, 0, 0); __builtin_amdgcn_s_setprio(0); } while (0)
#define PG8_WAIT_V(n) asm volatile("s_waitcnt vmcnt(" #n ")" ::: "memory")
#define PG8_WAIT_L(n) asm volatile("s_waitcnt lgkmcnt(" #n ")" ::: "memory")
#define PG8_BAR __builtin_amdgcn_s_barrier()
#define PG8_SCHED __builtin_amdgcn_sched_barrier(0)
    Unit cur, nxt; int ui = 0;
    if (!P.next(0, cur)) return;
    f32x4 acc[2][2][4][2];
#pragma unroll
    for (int a = 0; a < 2; ++a)
#pragma unroll
        for (int b = 0; b < 2; ++b)
#pragma unroll
            for (int m = 0; m < 4; ++m)
#pragma unroll
                for (int n = 0; n < 2; ++n) acc[a][b][m][n] = (f32x4){0.f, 0.f, 0.f, 0.f};
    bf16x8 At[4][2], B0[2][2], B1[2][2];
    const char* cA = P.pa(cur); const char* cB = P.pb(cur);
    PG8_STAGE(PG8_SB(0, 0), cB, voffB); PG8_STAGE(PG8_SA(0, 0), cA, voffA); PG8_STAGE(PG8_SB(0, 1), cB + hstepB, voffB); PG8_STAGE(PG8_SA(0, 1), cA + hstepA, voffA);
    if (wr == 1) PG8_BAR;
    PG8_WAIT_V(4); PG8_BAR;
    PG8_STAGE(PG8_SB(1, 0), cB + kstep, voffB); PG8_STAGE(PG8_SA(1, 0), cA + kstep, voffA); PG8_STAGE(PG8_SB(1, 1), cB + hstepB + kstep, voffB);
    PG8_WAIT_V(6); PG8_BAR;
    for (;;) {
        const bool has_next = P.next(ui + 1, nxt);
        const char* nA = has_next ? P.pa(nxt) : cA; const char* nB = has_next ? P.pb(nxt) : cB;
        for (int t = 0; t < nt; t += 2) {
            const bool last = (t == nt - 2);
            const char* a1 = cA + (size_t)(t + 1) * kstep;
            const char* a2 = last ? nA : cA + (size_t)(t + 2) * kstep; const char* b2 = last ? nB : cB + (size_t)(t + 2) * kstep;
            const char* a3 = a2 + kstep; const char* b3 = b2 + kstep;
            PG8_LDB(B0, 0, 0); PG8_SCHED; PG8_LDA(At, 0, 0); PG8_STAGE(PG8_SA(1, 1), a1 + hstepA, voffA);
            PG8_WAIT_L(8); PG8_BAR; PG8_WAIT_L(0); PG8_MMA(0, 0, At, B0); PG8_BAR; PG8_SCHED;
            PG8_LDB(B1, 0, 1); PG8_STAGE(PG8_SB(0, 0), b2, voffB);
            PG8_BAR; PG8_WAIT_L(0); PG8_MMA(0, 1, At, B1); PG8_BAR;
            PG8_LDA(At, 0, 1); PG8_STAGE(PG8_SA(0, 0), a2, voffA);
            PG8_BAR; PG8_WAIT_L(0); PG8_MMA(1, 0, At, B0); PG8_BAR; PG8_SCHED;
            PG8_STAGE(PG8_SB(0, 1), b2 + hstepB, voffB);
            PG8_WAIT_V(6); PG8_BAR; PG8_MMA(1, 1, At, B1); PG8_BAR;
            PG8_LDB(B0, 1, 0); PG8_SCHED; PG8_LDA(At, 1, 0); PG8_STAGE(PG8_SA(0, 1), a2 + hstepA, voffA);
            PG8_WAIT_L(8); PG8_BAR; PG8_WAIT_L(0); PG8_MMA(0, 0, At, B0); PG8_BAR; PG8_SCHED;
            PG8_LDB(B1, 1, 1); PG8_STAGE(PG8_SB(1, 0), b3, voffB);
            PG8_BAR; PG8_WAIT_L(0); PG8_MMA(0, 1, At, B1); PG8_BAR;
            PG8_LDA(At, 1, 1); PG8_STAGE(PG8_SA(1, 0), a3, voffA);
            PG8_BAR; PG8_WAIT_L(0); PG8_MMA(1, 0, At, B0); PG8_BAR; PG8_SCHED;
            PG8_STAGE(PG8_SB(1, 1), b3 + hstepB, voffB);
            PG8_WAIT_V(6); PG8_BAR; PG8_MMA(1, 1, At, B1); PG8_BAR;
        }
        epilogue<EPI>(P, acc, cur, wr, wc, fr, fq);
        if (!has_next) break;
        if (EPI != EPI_P3 || cur.seg == 3) {
#pragma unroll
            for (int a = 0; a < 2; ++a)
#pragma unroll
                for (int b = 0; b < 2; ++b)
#pragma unroll
                    for (int m = 0; m < 4; ++m)
#pragma unroll
                        for (int n = 0; n < 2; ++n) acc[a][b][m][n] = (f32x4){0.f, 0.f, 0.f, 0.f};
        }
        cur = nxt; cA = nA; cB = nB; ++ui;
    }
    PG8_WAIT_V(0);
    if (wr == 0) PG8_BAR;
    PG8_BAR;
#undef PG8_SA
#undef PG8_SB
#undef PG8_STAGE
#undef PG8_LDA
#undef PG8_LDB
#undef PG8_MMA
#undef PG8_WAIT_V
#undef PG8_WAIT_L
#undef PG8_BAR
#undef PG8_SCHED
}

template <int NT, int KS>
__device__ __forceinline__ void wmma(const LAS uchar* A, const LAS uchar* B, int pitch, f32x4 (&acc)[NT], int fr, int fq) {
#pragma unroll 1
    for (int ks = 0; ks < KS; ++ks) {
        const bf16x8 a = *(const LAS bf16x8*)(A + fr * pitch + (ks * 32 + fq * 8) * 2);
#pragma unroll
        for (int ni = 0; ni < NT; ++ni) {
            const bf16x8 b = *(const LAS bf16x8*)(B + (ni * 16 + fr) * pitch + (ks * 32 + fq * 8) * 2);
            acc[ni] = __builtin_amdgcn_mfma_f32_16x16x32_bf16(b, a, acc[ni], 0, 0, 0);
        }
    }
}
constexpr int PB = 272;

__device__ __forceinline__ int map_row(int n, int map) {
    if (map == 1) return n < 2560 ? n : (n < 2576 ? 7168 + (n - 2560) : n - 16);
    if (map == 2) { const int up = n >= DFF, nn = up ? n - DFF : n; return 32 * (nn >> 4) + 16 * up + (nn & 15); }
    return n;
}
__device__ __forceinline__ void tr_tile(LAS float* T, const float* src, int N, bf16_t* dst, int ldd, int dcol0, int k0, int n0, int map) {
    const int tid = TIDX;
    __syncthreads();
#pragma unroll
    for (int ps = 0; ps < 2; ++ps) { const int r = ps * 32 + (tid >> 4), c4 = (tid & 15) * 4; const int n = n0 + c4;
        f32x4 v = (f32x4){0.f, 0.f, 0.f, 0.f}; if (n < N) v = *(const f32x4*)(src + (size_t)(k0 + r) * N + n);
        T[r * 65 + c4 + 0] = v[0]; T[r * 65 + c4 + 1] = v[1]; T[r * 65 + c4 + 2] = v[2]; T[r * 65 + c4 + 3] = v[3]; }
    __syncthreads();
    { const int n = tid >> 3, k8 = (tid & 7) * 8;
        if (n0 + n < N) { u32x4 o; float f[8];
#pragma unroll
            for (int j = 0; j < 8; ++j) f[j] = T[(k8 + j) * 65 + n];
            o.x = cvt_pk_bf16(f[0], f[1]); o.y = cvt_pk_bf16(f[2], f[3]); o.z = cvt_pk_bf16(f[4], f[5]); o.w = cvt_pk_bf16(f[6], f[7]);
            *(u32x4*)(dst + (size_t)map_row(n0 + n, map) * ldd + dcol0 + k0 + k8) = o; } }
}

__device__ __forceinline__ void phase_pre(LAS uchar* lds, const Params& P) {
    const int tid = TIDX, G = GDIM, bid = BIDX;
    uchar* ws = (P.ws + launder_z());
    LAS float* T = (LAS float*)lds;
    constexpr int T_IN = 16 * 113, T_BRA = 256, T_BRB = 128, T_OUT = 256, T_GU = 16 * 88, T_DN = 44 * 16, T_PG = 256, T_PU = 64;
    constexpr int T_L = T_IN + T_BRA + T_BRB + T_OUT + T_GU + T_DN + T_PG + T_PU;
    for (int job = bid; job < 4 * T_L; job += G) {
        const int l = job / T_L; int j = job % T_L;
        if (j < T_IN) { tr_tile(T, PIN(I_WIN) + (size_t)l * 1024 * 7184, 7184, (bf16_t*)(ws + WS_WIN) + (size_t)l * NIN * 1024, 1024, 0, (j / 113) * 64, (j % 113) * 64, 1); continue; } j -= T_IN;
        if (j < T_BRA) { tr_tile(T, PIN(I_WBRA) + (size_t)l * 1024 * 1024, 1024, (bf16_t*)(ws + WS_WBR) + (size_t)l * 1024 * 2048, 2048, 0, (j / 16) * 64, (j % 16) * 64, 0); continue; } j -= T_BRA;
        if (j < T_BRB) { tr_tile(T, PIN(I_WBRB) + (size_t)l * 512 * 1024, 1024, (bf16_t*)(ws + WS_WBR) + (size_t)l * 1024 * 2048, 2048, 1024, (j / 16) * 64, (j % 16) * 64, 0); continue; } j -= T_BRB;
        if (j < T_OUT) { tr_tile(T, PIN(I_WOUT) + (size_t)l * 1024 * 1024, 1024, (bf16_t*)(ws + WS_WOUT) + (size_t)l * 1024 * 1024, 1024, 0, (j / 16) * 64, (j % 16) * 64, 0); continue; } j -= T_OUT;
        if (j < T_GU) { tr_tile(T, PIN(I_WGU) + (size_t)l * 1024 * 5632, 5632, (bf16_t*)(ws + WS_WGU) + (size_t)l * 5632 * 1024, 1024, 0, (j / 88) * 64, (j % 88) * 64, 2); continue; } j -= T_GU;
        if (j < T_DN) { tr_tile(T, PIN(I_WDN) + (size_t)l * DFF * 1024, 1024, (bf16_t*)(ws + WS_WDN) + (size_t)l * 1024 * DFF, DFF, 0, (j / 16) * 64, (j % 16) * 64, 0); continue; } j -= T_DN;
        if (j < T_PG) { tr_tile(T, PIN(I_WPG) + (size_t)l * 1024 * 1024, 1024, (bf16_t*)(ws + WS_WPG) + (size_t)l * 1024 * 1024, 1024, 0, (j / 16) * 64, (j % 16) * 64, 0); continue; } j -= T_PG;
        tr_tile(T, PIN(I_WPU) + (size_t)l * 256 * 1024, 1024, (bf16_t*)(ws + WS_WPU) + (size_t)l * 1024 * 256, 256, 0, (j / 16) * 64, (j % 16) * 64, 0);
    }
    {
        LAS float* PW = (LAS float*)lds;
        LAS float* WC = (LAS float*)(lds + 128 * 129 * 4);
        for (int job = bid; job < 4 * 4 * 16; job += G) {
            const int l = job >> 6, g = (job >> 4) & 3, n0 = (job & 15) * 64;
            __syncthreads();
            for (int e = tid; e < 128 * 128; e += NTHR) { const int c = e >> 7, d = e & 127; PW[c * 129 + d] = PIN(I_POOLW)[((size_t)(l * 4 + g) * 128 + c) * 128 + d] * PIN(I_POOLS)[l * 512 + g * 128 + d]; }
            for (int e = tid; e < 128 * 64; e += NTHR) { const int d = e >> 6, n = e & 63; WC[d * 64 + n] = PIN(I_WBRC)[((size_t)l * 512 + g * 128 + d) * 1024 + n0 + n]; }
            __syncthreads();
            const int c = tid & 127, nq = (tid >> 7) * 16;
            float a[16];
#pragma unroll
            for (int i = 0; i < 16; ++i) a[i] = 0.f;
            for (int d = 0; d < 128; ++d) { const float pw = PW[c * 129 + d];
#pragma unroll
                for (int i = 0; i < 16; ++i) a[i] += pw * WC[d * 64 + nq + i]; }
            bf16_t* dst = (bf16_t*)(ws + WS_WBR) + (size_t)l * 1024 * 2048;
#pragma unroll
            for (int i = 0; i < 16; ++i) dst[(size_t)(n0 + nq + i) * 2048 + 1536 + g * 128 + c] = (bf16_t)(cvt_pk_bf16(a[i], 0.f) & 0xffffu);
        }
    }
    {
        const int lane = tid & 63, wv = tid >> 6;
        float* X = (float*)(ws + WS_X); bf16_t* XN = (bf16_t*)(ws + WS_XN); float* RSS = (float*)(ws + WS_RSS);
        const float* g0 = PIN(I_NMIX);
        for (int row = bid * 8 + wv; row < MT; row += G * 8) {
            const float* src = row < MPR ? PIN(I_XP) + (size_t)row * 1024 : PIN(I_XS) + (size_t)(row - MPR) * 1024;
            float ss = 0.f;
#pragma unroll
            for (int i = 0; i < 4; ++i) { const int col = i * 256 + lane * 4; const f32x4 v = *(const f32x4*)(src + col); const f32x4 gg = *(const f32x4*)(g0 + col);
                *(f32x4*)(X + (size_t)row * 1024 + col) = v; ss += v[0] * v[0] + v[1] * v[1] + v[2] * v[2] + v[3] * v[3];
                u32x2 o; o.x = cvt_pk_bf16(v[0] * gg[0], v[1] * gg[1]); o.y = cvt_pk_bf16(v[2] * gg[2], v[3] * gg[3]); *(u32x2*)(XN + (size_t)row * 1024 + col) = o; }
#pragma unroll
            for (int s = 1; s < 64; s <<= 1) ss += shx(ss, s);
            if (lane < 16) RSS[(size_t)row * 16 + lane] = lane == 0 ? ss : 0.f;
        }
    }
    {
        bf16_t* PBF = (bf16_t*)(ws + WS_PBF);
        const size_t n4 = (size_t)4 * MT * 256 / 4;
        for (size_t i = (size_t)bid * NTHR + tid; i < n4; i += (size_t)G * NTHR) {
            const size_t e = i * 4; const int l = (int)(e / ((size_t)MT * 256)); const size_t rem = e % ((size_t)MT * 256); const int row = (int)(rem >> 8), col = (int)(rem & 255);
            const float* src = row < MPR ? PIN(I_PP) + ((size_t)l * MPR + row) * 256 + col : PIN(I_PS) + ((size_t)l * 1024 + (row - MPR)) * 256 + col;
            const f32x4 v = *(const f32x4*)src; u32x2 o; o.x = cvt_pk_bf16(v[0], v[1]); o.y = cvt_pk_bf16(v[2], v[3]); *(u32x2*)(PBF + e) = o;
        }
    }
}

constexpr int L_CS = 0, L_BS = 34816, L_BDT = 69632, L_XT = 104448, L_SB = 121856, L_SC = 139264;
__device__ __forceinline__ int xbc_chan(int cc, int h, int g) { return cc < 64 ? h * 64 + cc : (cc < 192 ? 1024 + g * 128 + (cc - 64) : 1280 + g * 128 + (cc - 192)); }

__device__ __forceinline__ void ssd_prompt(LAS uchar* lds, const Params& P, int l, int b, int h) {
    const int tid = TIDX, lane = tid & 63, w = tid >> 6, fr = lane & 15, fq = lane >> 4, g = h >> 3;
    const bf16_t* PROJ = (const bf16_t*)((P.ws + launder_z()) + WS_PROJ); const float* DT = (const float*)((P.ws + launder_z()) + WS_DT);
    bf16_t* Y = (bf16_t*)((P.ws + launder_z()) + WS_Y); float* SSQ = (float*)((P.ws + launder_z()) + WS_SSQ);
    LAS float* acs = (LAS float*)(lds + L_SC); LAS float* dtv = acs + 128; LAS float* eacs = acs + 256; LAS float* decdt = acs + 384;
    const float a_h = -__expf(PIN(I_ALOG)[l * 16 + h]), dtb = PIN(I_DTB)[l * 16 + h], Dh = PIN(I_DSKIP)[l * 16 + h];
    f32x4 S[4];
#pragma unroll
    for (int i = 0; i < 4; ++i) S[i] = (f32x4){0.f, 0.f, 0.f, 0.f};
    const int cg = tid % 40, rsg = tid / 40; const int ch = xbc_chan(cg * 8, h, g);
    for (int c = 0; c < 16; ++c) {
        const int grow0 = b * 2048 + c * 128;
        __syncthreads();
        if (w == 0) {
            const float r0 = DT[(size_t)(grow0 + 2 * lane) * 16 + h], r1 = DT[(size_t)(grow0 + 2 * lane + 1) * 16 + h];
            const float d0 = softplusf_(r0 + dtb), d1 = softplusf_(r1 + dtb); const float a0 = d0 * a_h, a1 = d1 * a_h;
            float inc = a0 + a1;
#pragma unroll
            for (int s = 1; s < 64; s <<= 1) { const float o = __shfl_up(inc, s, 64); if (lane >= s) inc += o; }
            const float tot = __shfl(inc, 63, 64); const float c1 = inc, c0 = inc - a1;
            acs[2 * lane] = c0; acs[2 * lane + 1] = c1; dtv[2 * lane] = d0; dtv[2 * lane + 1] = d1;
            eacs[2 * lane] = __expf(c0); eacs[2 * lane + 1] = __expf(c1); decdt[2 * lane] = __expf(tot - c0) * d0; decdt[2 * lane + 1] = __expf(tot - c1) * d1;
        }
        __syncthreads();
        if (tid < 320) {
    float cw[4][8], cbv[8];
#pragma unroll
        for (int k = 0; k < 4; ++k) { const f32x4 a = *(const f32x4*)(PIN(I_CONVW) + (size_t)(l * 4 + k) * 1536 + ch), cc = *(const f32x4*)(PIN(I_CONVW) + (size_t)(l * 4 + k) * 1536 + ch + 4);
            cw[k][0] = a[0]; cw[k][1] = a[1]; cw[k][2] = a[2]; cw[k][3] = a[3]; cw[k][4] = cc[0]; cw[k][5] = cc[1]; cw[k][6] = cc[2]; cw[k][7] = cc[3]; }
        const f32x4 a = *(const f32x4*)(PIN(I_CONVB) + (size_t)l * 1536 + ch), cc = *(const f32x4*)(PIN(I_CONVB) + (size_t)l * 1536 + ch + 4);
        cbv[0] = a[0]; cbv[1] = a[1]; cbv[2] = a[2]; cbv[3] = a[3]; cbv[4] = cc[0]; cbv[5] = cc[1]; cbv[6] = cc[2]; cbv[7] = cc[3];
            const int lr0 = rsg * 16;
            float hx[3][8];
#pragma unroll
            for (int k = 0; k < 3; ++k) { const int pos = c * 128 + lr0 - 3 + k;
                u32x4 v = (u32x4){0u, 0u, 0u, 0u}; if (pos >= 0) v = *(const u32x4*)(PROJ + (size_t)(b * 2048 + pos) * NPROJ + C_XBC + ch);
                hx[k][0] = bf_lo(v.x); hx[k][1] = bf_hi(v.x); hx[k][2] = bf_lo(v.y); hx[k][3] = bf_hi(v.y); hx[k][4] = bf_lo(v.z); hx[k][5] = bf_hi(v.z); hx[k][6] = bf_lo(v.w); hx[k][7] = bf_hi(v.w); }
#pragma unroll 1
            for (int hh = 0; hh < 4; ++hh) {
            u32x4 rv[4];
#pragma unroll
            for (int k = 0; k < 4; ++k) rv[k] = *(const u32x4*)(PROJ + (size_t)(grow0 + lr0 + 4 * hh + k) * NPROJ + C_XBC + ch);
#pragma unroll
            for (int t2 = 0; t2 < 2; ++t2) {
                const int lr = lr0 + 4 * hh + 2 * t2;
                const u32x4 v0 = rv[2 * t2], v1 = rv[2 * t2 + 1];
                float x0[8], x1[8], o0[8], o1[8];
                x0[0] = bf_lo(v0.x); x0[1] = bf_hi(v0.x); x0[2] = bf_lo(v0.y); x0[3] = bf_hi(v0.y); x0[4] = bf_lo(v0.z); x0[5] = bf_hi(v0.z); x0[6] = bf_lo(v0.w); x0[7] = bf_hi(v0.w);
                x1[0] = bf_lo(v1.x); x1[1] = bf_hi(v1.x); x1[2] = bf_lo(v1.y); x1[3] = bf_hi(v1.y); x1[4] = bf_lo(v1.z); x1[5] = bf_hi(v1.z); x1[6] = bf_lo(v1.w); x1[7] = bf_hi(v1.w);
#pragma unroll
                for (int j = 0; j < 8; ++j) {
                    o0[j] = siluf_(cbv[j] + cw[0][j] * hx[0][j] + cw[1][j] * hx[1][j] + cw[2][j] * hx[2][j] + cw[3][j] * x0[j]);
                    o1[j] = siluf_(cbv[j] + cw[0][j] * hx[1][j] + cw[1][j] * hx[2][j] + cw[2][j] * x0[j] + cw[3][j] * x1[j]);
                    hx[0][j] = hx[2][j]; hx[1][j] = x0[j]; hx[2][j] = x1[j]; }
                if (cg < 8) {
#pragma unroll
                    for (int j = 0; j < 8; ++j) *(LAS unsigned*)(lds + L_XT + (cg * 8 + j) * PB + lr * 2) = cvt_pk_bf16(o0[j], o1[j]);
                } else if (cg < 24) {
                    const int n0 = (cg - 8) * 8; const float s0 = decdt[lr], s1 = decdt[lr + 1];
                    u32x4 q; q.x = cvt_pk_bf16(o0[0], o0[1]); q.y = cvt_pk_bf16(o0[2], o0[3]); q.z = cvt_pk_bf16(o0[4], o0[5]); q.w = cvt_pk_bf16(o0[6], o0[7]); *(LAS u32x4*)(lds + L_BS + lr * PB + n0 * 2) = q;
                    q.x = cvt_pk_bf16(o1[0], o1[1]); q.y = cvt_pk_bf16(o1[2], o1[3]); q.z = cvt_pk_bf16(o1[4], o1[5]); q.w = cvt_pk_bf16(o1[6], o1[7]); *(LAS u32x4*)(lds + L_BS + (lr + 1) * PB + n0 * 2) = q;
#pragma unroll
                    for (int j = 0; j < 8; ++j) *(LAS unsigned*)(lds + L_BDT + (n0 + j) * PB + lr * 2) = cvt_pk_bf16(o0[j] * s0, o1[j] * s1);
                } else {
                    const int n0 = (cg - 24) * 8;
                    u32x4 q; q.x = cvt_pk_bf16(o0[0], o0[1]); q.y = cvt_pk_bf16(o0[2], o0[3]); q.z = cvt_pk_bf16(o0[4], o0[5]); q.w = cvt_pk_bf16(o0[6], o0[7]); *(LAS u32x4*)(lds + L_CS + lr * PB + n0 * 2) = q;
                    q.x = cvt_pk_bf16(o1[0], o1[1]); q.y = cvt_pk_bf16(o1[2], o1[3]); q.z = cvt_pk_bf16(o1[4], o1[5]); q.w = cvt_pk_bf16(o1[6], o1[7]); *(LAS u32x4*)(lds + L_CS + (lr + 1) * PB + n0 * 2) = q;
                }
            }
            }
        }
        __syncthreads();
        {
            f32x4 cb[8];
#pragma unroll
            for (int i = 0; i < 8; ++i) cb[i] = (f32x4){0.f, 0.f, 0.f, 0.f};
            wmma<8, 4>(lds + L_CS + w * 16 * PB, lds + L_BS, PB, cb, fr, fq);
            __syncthreads();
            const int lrow = 16 * w + fr; const float al = acs[lrow];
#pragma unroll
            for (int ni = 0; ni < 8; ++ni) { const int s0 = ni * 16 + 4 * fq; float mv[4];
#pragma unroll
                for (int e = 0; e < 4; ++e) { const int s = s0 + e; const float dd = fminf(al - acs[s], 0.f); mv[e] = (s <= lrow) ? cb[ni][e] * __expf(dd) * dtv[s] : 0.f; }
                u32x2 o; o.x = cvt_pk_bf16(mv[0], mv[1]); o.y = cvt_pk_bf16(mv[2], mv[3]); *(LAS u32x2*)(lds + L_BS + lrow * PB + s0 * 2) = o; }
        }
        {
            f32x4 y[4];
#pragma unroll
            for (int i = 0; i < 4; ++i) y[i] = (f32x4){0.f, 0.f, 0.f, 0.f};
            const int lrow = 16 * w + fr;
            if (c > 0) { wmma<4, 4>(lds + L_CS + w * 16 * PB, lds + L_SB, PB, y, fr, fq); const float ea = eacs[lrow];
#pragma unroll
                for (int i = 0; i < 4; ++i) y[i] = y[i] * ea; }
            wmma<4, 4>(lds + L_BS + w * 16 * PB, lds + L_XT, PB, y, fr, fq);
            const int row = grow0 + lrow; float ssq = 0.f;
#pragma unroll
            for (int ni = 0; ni < 4; ++ni) { const int p0 = ni * 16 + 4 * fq;
                const u32x2 zz = *(const u32x2*)(PROJ + (size_t)row * NPROJ + C_Z + h * 64 + p0);
                const f32x4 ng = *(const f32x4*)(PIN(I_SSDN) + (size_t)l * 1024 + h * 64 + p0);
                float zf[4] = {bf_lo(zz.x), bf_hi(zz.x), bf_lo(zz.y), bf_hi(zz.y)}; float ov[4];
#pragma unroll
                for (int e = 0; e < 4; ++e) { const float xs = bf1(*(const LAS bf16_t*)(lds + L_XT + (p0 + e) * PB + lrow * 2)); const float v = (y[ni][e] + Dh * xs) * siluf_(zf[e]); ssq += v * v; ov[e] = v * ng[e]; }
                u32x2 o; o.x = cvt_pk_bf16(ov[0], ov[1]); o.y = cvt_pk_bf16(ov[2], ov[3]); *(u32x2*)(Y + (size_t)row * 2048 + h * 64 + p0) = o; }
            ssq += shx(ssq, 16); ssq += shx(ssq, 32);
            if (fq == 0) SSQ[(size_t)row * 16 + h] = ssq;
        }
        __syncthreads();
        {
            const float et = eacs[127];
#pragma unroll
            for (int i = 0; i < 4; ++i) S[i] = S[i] * et;
            wmma<4, 4>(lds + L_XT + (w >> 1) * 16 * PB, lds + L_BDT + (w & 1) * 64 * PB, PB, S, fr, fq);
            const int p = (w >> 1) * 16 + fr;
#pragma unroll
            for (int ni = 0; ni < 4; ++ni) { const int n0 = (w & 1) * 64 + ni * 16 + 4 * fq; u32x2 o; o.x = cvt_pk_bf16(S[ni][0], S[ni][1]); o.y = cvt_pk_bf16(S[ni][2], S[ni][3]); *(LAS u32x2*)(lds + L_SB + p * PB + n0 * 2) = o; }
        }
    }
    {
        float* dst = (P.out + launder_z()) + O_SSMP + ((size_t)((l * 8 + b) * 16 + h) * 64) * 128; const int p = (w >> 1) * 16 + fr;
#pragma unroll
        for (int ni = 0; ni < 4; ++ni) { const int n0 = (w & 1) * 64 + ni * 16 + 4 * fq; *(f32x4*)(dst + (size_t)p * 128 + n0) = S[ni]; }
    }
}

__device__ __forceinline__ void ssd_sample(LAS uchar* lds, const Params& P, int l, int b, int hp) {
    const int tid = TIDX, half = tid >> 8, t8 = tid & 255, h = hp * 2 + half, g = h >> 3;
    const bf16_t* PROJ = (const bf16_t*)((P.ws + launder_z()) + WS_PROJ); const float* DT = (const float*)((P.ws + launder_z()) + WS_DT);
    bf16_t* Y = (bf16_t*)((P.ws + launder_z()) + WS_Y); float* SSQ = (float*)((P.ws + launder_z()) + WS_SSQ);
    LAS float* xs = (LAS float*)(lds + half * 16384); LAS float* Bv = xs + 512; LAS float* Cv = xs + 1536; LAS float* sdt = xs + 2560; LAS float* sdec = xs + 2568; LAS float* yv = xs + 2576;
    const int row0 = MPR + b * 8;
    __syncthreads();
    for (int cc = t8; cc < 320; cc += 256) {
        const int ch = xbc_chan(cc, h, g);
        float xv[11];
#pragma unroll
        for (int k = 0; k < 3; ++k) xv[k] = PIN(I_SCONV)[((size_t)(l * 128 + b) * 3 + k) * 1536 + ch];
#pragma unroll
        for (int t = 0; t < 8; ++t) xv[3 + t] = bf1(PROJ[(size_t)(row0 + t) * NPROJ + C_XBC + ch]);
        const float w0 = PIN(I_CONVW)[(size_t)(l * 4 + 0) * 1536 + ch], w1 = PIN(I_CONVW)[(size_t)(l * 4 + 1) * 1536 + ch], w2 = PIN(I_CONVW)[(size_t)(l * 4 + 2) * 1536 + ch], w3 = PIN(I_CONVW)[(size_t)(l * 4 + 3) * 1536 + ch];
        const float cb = PIN(I_CONVB)[(size_t)l * 1536 + ch];
#pragma unroll
        for (int t = 0; t < 8; ++t) { const float o = siluf_(cb + w0 * xv[t] + w1 * xv[t + 1] + w2 * xv[t + 2] + w3 * xv[t + 3]);
            if (cc < 64) xs[t * 64 + cc]= o; else if (cc < 192) Bv[t * 128 + cc - 64] = o; else Cv[t * 128 + cc - 192] = o; }
    }
    if (t8 < 8) { const float d = softplusf_(DT[(size_t)(row0 + t8) * 16 + h] + PIN(I_DTB)[l * 16 + h]); sdt[t8] = d; sdec[t8] = __expf(-d * __expf(PIN(I_ALOG)[l * 16 + h])); }
    __syncthreads();
    const int l16 = t8 & 15, pr = t8 >> 4;
    const float* hin = PIN(I_SSSM) + ((size_t)((l * 128 + b) * 16 + h) * 64) * 128;
    float* hout = (P.out + launder_z()) + O_SSMS + ((size_t)((l * 128 + b) * 16 + h) * 64) * 128;
    f32x4 hs[4][2];
#pragma unroll
    for (int pi = 0; pi < 4; ++pi)
#pragma unroll
        for (int it = 0; it < 2; ++it) hs[pi][it] = *(const f32x4*)(hin + (size_t)(pi * 16 + pr) * 128 + it * 64 + l16 * 4);
#pragma unroll 1
    for (int t = 0; t < 8; ++t) {
        const float dec = sdec[t], dtt = sdt[t];
        const f32x4 B0 = *(const LAS f32x4*)(Bv + t * 128 + l16 * 4), B1 = *(const LAS f32x4*)(Bv + t * 128 + 64 + l16 * 4);
        const f32x4 C0 = *(const LAS f32x4*)(Cv + t * 128 + l16 * 4), C1 = *(const LAS f32x4*)(Cv + t * 128 + 64 + l16 * 4);
#pragma unroll
        for (int pi = 0; pi < 4; ++pi) { const float xd = xs[t * 64 + pi * 16 + pr] * dtt;
            hs[pi][0] = hs[pi][0] * dec + B0 * xd; hs[pi][1] = hs[pi][1] * dec + B1 * xd;
            const f32x4 q = hs[pi][0] * C0 + hs[pi][1] * C1; float yp = q[0] + q[1] + q[2] + q[3];
            yp += shx(yp, 1); yp += shx(yp, 2); yp += shx(yp, 4); yp += shx(yp, 8);
            if (l16 == 0) yv[t * 64 + pi * 16 + pr] = yp; }
    }
#pragma unroll
    for (int pi = 0; pi < 4; ++pi)
#pragma unroll
        for (int it = 0; it < 2; ++it) *(f32x4*)(hout + (size_t)(pi * 16 + pr) * 128 + it * 64 + l16 * 4) = hs[pi][it];
    __syncthreads();
    {
        const int t = t8 >> 5, p0 = (t8 & 31) * 2, row = row0 + t; const float Dh = PIN(I_DSKIP)[l * 16 + h];
        const unsigned zz = *(const unsigned*)(PROJ + (size_t)row * NPROJ + C_Z + h * 64 + p0);
        const float v0 = (yv[t * 64 + p0] + Dh * xs[t * 64 + p0]) * siluf_(bf_lo(zz)), v1 = (yv[t * 64 + p0 + 1] + Dh * xs[t * 64 + p0 + 1]) * siluf_(bf_hi(zz));
        float ssq = v0 * v0 + v1 * v1;
        ssq += shx(ssq, 1); ssq += shx(ssq, 2); ssq += shx(ssq, 4); ssq += shx(ssq, 8); ssq += shx(ssq, 16);
        *(unsigned*)(Y + (size_t)row * 2048 + h * 64 + p0) = cvt_pk_bf16(v0 * PIN(I_SSDN)[(size_t)l * 1024 + h * 64 + p0], v1 * PIN(I_SSDN)[(size_t)l * 1024 + h * 64 + p0 + 1]);
        if ((t8 & 31) == 0) SSQ[(size_t)row * 16 + h] = ssq;
    }
}

__device__ __forceinline__ void sgu_prompt(LAS uchar* lds, const Params& P, int l, int b, int c, int g) {
    const int tid = TIDX, lane = tid & 63, w = tid >> 6, fr = lane & 15, fq = lane >> 4;
    const bf16_t* PROJ = (const bf16_t*)((P.ws + launder_z()) + WS_PROJ); bf16_t* Y = (bf16_t*)((P.ws + launder_z()) + WS_Y);
    LAS float* smu = (LAS float*)(lds + 69632); LAS float* srs = smu + 128;
    const int grow0 = b * 2048 + c * 128;
    __syncthreads();
    {
        const int r = tid >> 2, q = tid & 3; const bf16_t* src = PROJ + (size_t)(grow0 + r) * NPROJ + C_V + q * 128;
        float s = 0.f, s2 = 0.f;
#pragma unroll
        for (int i = 0; i < 16; ++i) { const u32x4 v = *(const u32x4*)(src + i * 8);
            const float f[8] = {bf_lo(v.x), bf_hi(v.x), bf_lo(v.y), bf_hi(v.y), bf_lo(v.z), bf_hi(v.z), bf_lo(v.w), bf_hi(v.w)};
#pragma unroll
            for (int j = 0; j < 8; ++j) { s += f[j]; s2 += f[j] * f[j]; } }
        s += shx(s, 1); s += shx(s, 2); s2 += shx(s2, 1); s2 += shx(s2, 2);
        const float mu = s * (1.0f / 512.0f), var = fmaxf(s2 * (1.0f / 512.0f) - mu * mu, 0.f);
        if (q == 0) { smu[r] = mu; srs[r] = rsqrtf(var + EPS); }
        const float* wsrc = PIN(I_WSP) + ((size_t)(l * 4 + g) * 128 + r) * 128 + q * 32;
#pragma unroll
        for (int i = 0; i < 4; ++i) { const f32x4 a = *(const f32x4*)(wsrc + i * 8), bb = *(const f32x4*)(wsrc + i * 8 + 4); const int s0 = q * 32 + i * 8;
            u32x4 o; o.x = cvt_pk_bf16(s0 + 0 <= r ? a[0] : 0.f, s0 + 1 <= r ? a[1] : 0.f); o.y = cvt_pk_bf16(s0 + 2 <= r ? a[2] : 0.f, s0 + 3 <= r ? a[3] : 0.f);
            o.z = cvt_pk_bf16(s0 + 4 <= r ? bb[0] : 0.f, s0 + 5 <= r ? bb[1] : 0.f); o.w = cvt_pk_bf16(s0 + 6 <= r ? bb[2] : 0.f, s0 + 7 <= r ? bb[3] : 0.f);
            *(LAS u32x4*)(lds + r * PB + s0 * 2) = o; }
    }
    __syncthreads();
    {
        const int r = tid >> 2, q = tid & 3; const bf16_t* src = PROJ + (size_t)(grow0 + r) * NPROJ + C_V + g * 128 + q * 32;
        const float mu = smu[r], rs = srs[r];
        const float* lg = PIN(I_LNG) + (size_t)l * 512 + g * 128 + q * 32; const float* lb = PIN(I_LNB) + (size_t)l * 512 + g * 128 + q * 32;
        float* vout = (P.out + launder_z()) + O_VP + ((size_t)(l * 8 + b) * 128 + r) * 512 + g * 128 + q * 32;
#pragma unroll
        for (int i = 0; i < 4; ++i) { const u32x4 v = *(const u32x4*)(src + i * 8);
            const float f[8] = {bf_lo(v.x), bf_hi(v.x), bf_lo(v.y), bf_hi(v.y), bf_lo(v.z), bf_hi(v.z), bf_lo(v.w), bf_hi(v.w)}; float vn[8];
#pragma unroll
            for (int j = 0; j < 8; ++j) { vn[j] = (f[j] - mu) * rs * lg[i * 8 + j] + lb[i * 8 + j];
                *(LAS bf16_t*)(lds + 34816 + (q * 32 + i * 8 + j) * PB + r * 2) = (bf16_t)(cvt_pk_bf16(vn[j], 0.f) & 0xffffu); }
            if (c == 15) { *(f32x4*)(vout + i * 8) = (f32x4){vn[0], vn[1], vn[2], vn[3]}; *(f32x4*)(vout + i * 8 + 4) = (f32x4){vn[4], vn[5], vn[6], vn[7]}; } }
    }
    __syncthreads();
    {
        f32x4 acc[8];
#pragma unroll
        for (int i = 0; i < 8; ++i) acc[i] = (f32x4){0.f, 0.f, 0.f, 0.f};
        wmma<8, 4>(lds + w * 16 * PB, lds + 34816, PB, acc, fr, fq);
        const int t = 16 * w + fr, row = grow0 + t; const float bs = PIN(I_BSP)[(size_t)(l * 4 + g) * 128 + t];
#pragma unroll
        for (int ni = 0; ni < 8; ++ni) { const int d0 = ni * 16 + 4 * fq; const u32x2 uu = *(const u32x2*)(PROJ + (size_t)row * NPROJ + C_U + g * 128 + d0);
            u32x2 o; o.x = cvt_pk_bf16(bf_lo(uu.x) * (acc[ni][0] + bs), bf_hi(uu.x) * (acc[ni][1] + bs)); o.y = cvt_pk_bf16(bf_lo(uu.y) * (acc[ni][2] + bs), bf_hi(uu.y) * (acc[ni][3] + bs));
            *(u32x2*)(Y + (size_t)row * 2048 + 1024 + g * 128 + d0) = o; }
    }
}

__device__ __forceinline__ void sgu_sample(LAS uchar* lds, const Params& P, int l, int b) {
    const int tid = TIDX, lane = tid & 63, w = tid >> 6, ch = tid, g = ch >> 7;
    const bf16_t* PROJ = (const bf16_t*)((P.ws + launder_z()) + WS_PROJ); bf16_t* Y = (bf16_t*)((P.ws + launder_z()) + WS_Y);
    LAS float* red = (LAS float*)lds;
    const int row0 = MPR + b * 8;
    float v[8], u[8];
#pragma unroll
    for (int s = 0; s < 8; ++s) { v[s] = bf1(PROJ[(size_t)(row0 + s) * NPROJ + C_V + ch]); u[s] = bf1(PROJ[(size_t)(row0 + s) * NPROJ + C_U + ch]); }
    __syncthreads();
#pragma unroll
    for (int s = 0; s < 8; ++s) { float a = v[s], a2 = v[s] * v[s];
#pragma unroll
        for (int m = 1; m < 64; m <<= 1) { a += shx(a, m); a2 += shx(a2, m); }
        if (lane == 0) { red[w * 16 + s] = a; red[w * 16 + 8 + s] = a2; } }
    __syncthreads();
    const float lg = PIN(I_LNG)[(size_t)l * 512 + ch], lb = PIN(I_LNB)[(size_t)l * 512 + ch];
    float vn[8];
#pragma unroll
    for (int s = 0; s < 8; ++s) { float a = 0.f, a2 = 0.f;
#pragma unroll
        for (int ww = 0; ww < 8; ++ww) { a += red[ww * 16 + s]; a2 += red[ww * 16 + 8 + s]; }
        const float mu = a * (1.0f / 512.0f), var = fmaxf(a2 * (1.0f / 512.0f) - mu * mu, 0.f);
        vn[s] = (v[s] - mu) * rsqrtf(var + EPS) * lg + lb;
        (P.out + launder_z())[O_VS + ((size_t)(l * 128 + b) * 8 + s) * 512 + ch] = vn[s]; }
    const float* W = PIN(I_WSP) + (size_t)(l * 4 + g) * 128 * 128; const float* bsp = PIN(I_BSP) + (size_t)(l * 4 + g) * 128;
#pragma unroll
    for (int t = 0; t < 8; ++t) { float o = bsp[t];
#pragma unroll
        for (int s = 0; s <= t; ++s) o += W[t * 128 + s] * vn[s];
        Y[(size_t)(row0 + t) * 2048 + 1024 + ch] = (bf16_t)(cvt_pk_bf16(u[t] * o, 0.f) & 0xffffu); }
}

__device__ __forceinline__ void pool_prompt(const Params& P, int tile) {
    const int tid = TIDX, cgp = tid & 63, rsg = tid >> 6, ch0 = cgp * 8, wdw = 2 << (cgp >> 4);
    const bf16_t* PROJ = (const bf16_t*)((P.ws + launder_z()) + WS_PROJ); bf16_t* Y = (bf16_t*)((P.ws + launder_z()) + WS_Y);
    const int b = tile >> 4, pos0 = (tile & 15) * 128 + rsg * 16; const size_t rbase = (size_t)b * 2048;
    float S[8];
#pragma unroll
    for (int j = 0; j < 8; ++j) S[j] = 0.f;
    for (int k = 1; k < wdw; ++k) { const int pos = pos0 - k; if (pos >= 0) { const u32x4 v = *(const u32x4*)(PROJ + (rbase + pos) * NPROJ + C_POOL + ch0);
        S[0] += bf_lo(v.x); S[1] += bf_hi(v.x); S[2] += bf_lo(v.y); S[3] += bf_hi(v.y); S[4] += bf_lo(v.z); S[5] += bf_hi(v.z); S[6] += bf_lo(v.w); S[7] += bf_hi(v.w); } }
#pragma unroll 1
    for (int t = 0; t < 16; ++t) { const int pos = pos0 + t;
        const u32x4 v = *(const u32x4*)(PROJ + (rbase + pos) * NPROJ + C_POOL + ch0);
        const float x[8] = {bf_lo(v.x), bf_hi(v.x), bf_lo(v.y), bf_hi(v.y), bf_lo(v.z), bf_hi(v.z), bf_lo(v.w), bf_hi(v.w)};
        const float ic = 1.0f / (float)min(pos + 1, wdw); float d[8];
#pragma unroll
        for (int j = 0; j < 8; ++j) { S[j] += x[j]; d[j] = S[j] * ic - x[j]; }
        u32x4 o; o.x = cvt_pk_bf16(d[0], d[1]); o.y = cvt_pk_bf16(d[2], d[3]); o.z = cvt_pk_bf16(d[4], d[5]); o.w = cvt_pk_bf16(d[6], d[7]);
        *(u32x4*)(Y + (rbase + pos) * 2048 + 1536 + ch0) = o;
        const int po = pos - wdw + 1;
        if (po >= 0) { const u32x4 q = *(const u32x4*)(PROJ + (rbase + po) * NPROJ + C_POOL + ch0);
            S[0] -= bf_lo(q.x); S[1] -= bf_hi(q.x); S[2] -= bf_lo(q.y); S[3] -= bf_hi(q.y); S[4] -= bf_lo(q.z); S[5] -= bf_hi(q.z); S[6] -= bf_lo(q.w); S[7] -= bf_hi(q.w); } }
}
__device__ __forceinline__ void pool_sample(const Params& P, int l, int si) {
    const int tid = TIDX, cgp = tid & 63, ch0 = cgp * 8, wdw = 2 << (cgp >> 4), b = si * 8 + (tid >> 6);
    const bf16_t* PROJ = (const bf16_t*)((P.ws + launder_z()) + WS_PROJ); bf16_t* Y = (bf16_t*)((P.ws + launder_z()) + WS_Y);
    const float* buf = PIN(I_SPOOL) + (size_t)(l * 128 + b) * 15 * 512 + ch0;
    const size_t rbase = (size_t)MPR + b * 8;
    float S[8];
#pragma unroll
    for (int j = 0; j < 8; ++j) S[j] = 0.f;
    for (int k = 1; k < wdw; ++k) { const f32x4 a = *(const f32x4*)(buf + (size_t)(15 - k) * 512), c = *(const f32x4*)(buf + (size_t)(15 - k) * 512 + 4);
        S[0] += a[0]; S[1] += a[1]; S[2] += a[2]; S[3] += a[3]; S[4] += c[0]; S[5] += c[1]; S[6] += c[2]; S[7] += c[3]; }
    const float ic = 1.0f / (float)wdw;
#pragma unroll 1
    for (int t = 0; t < 8; ++t) {
        const u32x4 v = *(const u32x4*)(PROJ + (rbase + t) * NPROJ + C_POOL + ch0);
        const float x[8] = {bf_lo(v.x), bf_hi(v.x), bf_lo(v.y), bf_hi(v.y), bf_lo(v.z), bf_hi(v.z), bf_lo(v.w), bf_hi(v.w)}; float d[8];
#pragma unroll
        for (int j = 0; j < 8; ++j) { S[j] += x[j]; d[j] = S[j] * ic - x[j]; }
        u32x4 o; o.x = cvt_pk_bf16(d[0], d[1]); o.y = cvt_pk_bf16(d[2], d[3]); o.z = cvt_pk_bf16(d[4], d[5]); o.w = cvt_pk_bf16(d[6], d[7]);
        *(u32x4*)(Y + (rbase + t) * 2048 + 1536 + ch0) = o;
        const int po = t - wdw + 1;
        if (po >= 0) { const u32x4 q = *(const u32x4*)(PROJ + (rbase + po) * NPROJ + C_POOL + ch0);
            S[0] -= bf_lo(q.x); S[1] -= bf_hi(q.x); S[2] -= bf_lo(q.y); S[3] -= bf_hi(q.y); S[4] -= bf_lo(q.z); S[5] -= bf_hi(q.z); S[6] -= bf_lo(q.w); S[7] -= bf_hi(q.w); }
        else { const f32x4 a = *(const f32x4*)(buf + (size_t)(15 + po) * 512), c = *(const f32x4*)(buf + (size_t)(15 + po) * 512 + 4);
            S[0] -= a[0]; S[1] -= a[1]; S[2] -= a[2]; S[3] -= a[3]; S[4] -= c[0]; S[5] -= c[1]; S[6] -= c[2]; S[7] -= c[3]; } }
}
constexpr int NC_CP = 8 * 3 * 1536, NC_CS = 128 * 3 * 1536, NC_PP = 8 * 15 * 512, NC_PS = 128 * 15 * 512, NC_ALL = NC_CP + NC_CS + NC_PP + NC_PS;
__device__ __forceinline__ void state_copy(const Params& P, int l, int item) {
    const bf16_t* PROJ = (const bf16_t*)((P.ws + launder_z()) + WS_PROJ);
    for (int j = 0; j < 16; ++j) { int e = item * 8192 + j * NTHR + TIDX; if (e >= NC_ALL) return;
        if (e < NC_CP) { const int ch = e % 1536, k = (e / 1536) % 3, b = e / 4608; (P.out + launder_z())[O_CONVP + (size_t)l * NC_CP + e] = bf1(PROJ[(size_t)(b * 2048 + 2045 + k) * NPROJ + C_XBC + ch]); continue; } e -= NC_CP;
        if (e < NC_CS) { const int ch = e % 1536, k = (e / 1536) % 3, b = e / 4608; (P.out + launder_z())[O_CONVS + (size_t)l * NC_CS + e] = bf1(PROJ[(size_t)(MPR + b * 8 + 5 + k) * NPROJ + C_XBC + ch]); continue; } e -= NC_CS;
        if (e < NC_PP) { const int ch = e % 512, k = (e / 512) % 15, b = e / 7680; (P.out + launder_z())[O_POOLP + (size_t)l * NC_PP + e] = bf1(PROJ[(size_t)(b * 2048 + 2033 + k) * NPROJ + C_POOL + ch]); continue; } e -= NC_PP;
        { const int ch = e % 512, k = (e / 512) % 15, b = e / 7680;
          (P.out + launder_z())[O_POOLS + (size_t)l * NC_PS + e] = k < 7 ? PIN(I_SPOOL)[((size_t)(l * 128 + b) * 15 + 8 + k) * 512 + ch] : bf1(PROJ[(size_t)(MPR + b * 8 + (k - 7)) * NPROJ + C_POOL + ch]); }
    }
}

__device__ __forceinline__ void phase_mixer(LAS uchar* lds, const Params& P, int l) {
    const int G = GDIM, bid = BIDX;
    constexpr int N_B = 1024, N_C = 512, N_D = 128, N_E = 128, N_E2 = 16, N_F = (NC_ALL + 8191) / 8192;
    constexpr int N_REST = N_B + N_C + N_D + N_E + N_E2 + N_F;
    if (G > 128) { if (bid < 128) ssd_prompt(lds, P, l, bid >> 4, bid & 15); }
    else { for (int i = bid; i < 128; i += G) ssd_prompt(lds, P, l, i >> 4, i & 15); }
    unsigned* ctr = (unsigned*)((P.ws + launder_z()) + WS_BAR) + 3584 + 64 * l;
    volatile LAS unsigned* bc = (volatile LAS unsigned*)(lds + LDS_BYTES) + 2;
    for (;;) {
        __syncthreads();
        if (TIDX == 0) bc[0] = __hip_atomic_fetch_add(ctr, 1u, __ATOMIC_RELAXED, __HIP_MEMORY_SCOPE_AGENT);
        __syncthreads();
        int j = (int)bc[0];
        if (j >= N_REST) break;
        if (j < N_C) { sgu_prompt(lds, P, l, j >> 6, (j >> 2) & 15, j & 3); continue; } j -= N_C;
        if (j < N_B) { ssd_sample(lds, P, l, j >> 3, j & 7); continue; } j -= N_B;
        if (j < N_D) { sgu_sample(lds, P, l, j); continue; } j -= N_D;
        if (j < N_E) { pool_prompt(P, j); continue; } j -= N_E;
        if (j < N_E2) { pool_sample(P, l, j); continue; } j -= N_E2;
        state_copy(P, l, j);
    }
}


#define XB_TMO      128
#define XB_XCNT(j)  (256  + 64 * (j))
#define XB_XSUB(j)  (1280 + 64 * (j))
#define XB_XGEN(j)  (2304 + 64 * (j))
#define XB_TOP      3328
#define XB_TOPGEN   3392
#define XCD_BAR_WORDS 3456
#define XB_SPIN_CAP (1u << 20)
__device__ __forceinline__ unsigned xb_ld(unsigned* p)              { return __hip_atomic_load(p, __ATOMIC_RELAXED, __HIP_MEMORY_SCOPE_AGENT); }
__device__ __forceinline__ unsigned xb_add(unsigned* p, unsigned v) { return __hip_atomic_fetch_add(p, v, __ATOMIC_RELAXED, __HIP_MEMORY_SCOPE_AGENT); }
__device__ __forceinline__ unsigned xb_xcc_id() { return (unsigned)__builtin_amdgcn_s_getreg((3 << 11) | 20) & 0xFu; }
#define XB_SPIN(cond, bar) do { unsigned _sp = 0; while (cond) { __builtin_amdgcn_s_sleep(1); \
    if ((++_sp & 255u) == 0u) { if (xb_ld(&(bar)[XB_TMO])) break; if (_sp > XB_SPIN_CAP) { atomicAdd(&(bar)[XB_TMO], 1u); break; } } } } while (0)
struct XcdBarrier { unsigned* bar; unsigned x; volatile LAS unsigned* st; };
__device__ __forceinline__ XcdBarrier xcd_barrier_post(unsigned* bar, volatile LAS unsigned* st) {
    XcdBarrier b; b.bar = bar; b.x = xb_xcc_id(); b.st = st;
    if (threadIdx.x == 0) (void)xb_add(&bar[XB_XCNT(b.x)], 1u);
    return b;
}
__device__ __forceinline__ void xcd_barrier_complete(unsigned* bar, unsigned x, unsigned& nloc, unsigned& nx) {
    const unsigned G = gridDim.x * gridDim.y * gridDim.z;
    unsigned sum, cnt, mine, sp = 0u;
    for (;;) {
        sum = 0u; cnt = 0u; mine = 0u;
#pragma unroll
        for (unsigned j = 0; j < 16; ++j) { const unsigned c = xb_ld(&bar[XB_XCNT(j)]); sum += c; cnt += (c > 0u) ? 1u : 0u; mine = (j == x) ? c : mine; }
        if (sum == G) break;
        __builtin_amdgcn_s_sleep(1);
        if ((++sp & 255u) == 0u) { if (xb_ld(&bar[XB_TMO])) break; if (sp > XB_SPIN_CAP) { atomicAdd(&bar[XB_TMO], 1u); break; } }
    }
    nloc = mine > 0u ? mine : 1u; nx = cnt > 0u ? cnt : 1u;
}
__device__ __forceinline__ void xcd_barrier(const XcdBarrier& b) {
    asm volatile("s_waitcnt vmcnt(0)" ::: "memory");
    __syncthreads();
    if (threadIdx.x == 0) {
        unsigned* bar = b.bar;
        __builtin_amdgcn_s_waitcnt(0);
        unsigned nloc = b.st[0], nx = b.st[1];
        if (nloc == 0u) { xcd_barrier_complete(bar, b.x, nloc, nx); b.st[0] = nloc; b.st[1] = nx; }
        const unsigned old = xb_add(&bar[XB_XSUB(b.x)], 1u);
        const unsigned gen = old / nloc;
        if (old + 1u == (gen + 1u) * nloc) {
            __builtin_amdgcn_fence(__ATOMIC_RELEASE, "agent");
            asm volatile("s_waitcnt vmcnt(0)" ::: "memory");
            const unsigned og = xb_add(&bar[XB_TOP], 1u);
            const unsigned tg = og / nx;
            if (og + 1u == (tg + 1u) * nx) xb_add(&bar[XB_TOPGEN], 1u);
            else XB_SPIN(xb_ld(&bar[XB_TOPGEN]) == tg, bar);
            __builtin_amdgcn_fence(__ATOMIC_ACQUIRE, "agent");
            xb_add(&bar[XB_XGEN(b.x)], 1u);
            asm volatile("s_waitcnt vmcnt(0)" ::: "memory");
        } else {
            XB_SPIN(xb_ld(&bar[XB_XGEN(b.x)]) == gen, bar);
            __builtin_amdgcn_fence(__ATOMIC_ACQUIRE, "agent");
            asm volatile("s_waitcnt vmcnt(0)" ::: "memory");
        }
    }
    __syncthreads();
}

__device__ __forceinline__ void run_phase(LAS uchar* lds, const Params& P, int ph) {
    uchar* ws = (P.ws + launder_z());
    float* RSS = (float*)(ws + WS_RSS);
    if (ph == 0) { phase_pre(lds, P); return; }
    if (ph == 30) {
        const int tid = TIDX, lane = tid & 63, wv = tid >> 6; const float* X = (const float*)(ws + WS_X); const float* fg = PIN(I_FN);
        for (int row = BIDX * 8 + wv; row < MT; row += GDIM * 8) { const float r = rownorm(RSS + (size_t)12 * MT * 16, row);
#pragma unroll
            for (int i = 0; i < 4; ++i) { const int col = i * 256 + lane * 4; const f32x4 v = *(const f32x4*)(X + (size_t)row * 1024 + col), gg = *(const f32x4*)(fg + col);
                *(f32x4*)((P.out + launder_z()) + O_Y + (size_t)row * 1024 + col) = (f32x4){v[0] * r * gg[0], v[1] * r * gg[1], v[2] * r * gg[2], v[3] * r * gg[3]}; } }
        return; }
    const int l = ph >= 2 ? (ph - 2) / 7 : 0, s = ph >= 2 ? (ph - 2) % 7 : -1;
    if (s == 1) { phase_mixer(lds, P, l); return; }
    bf16_t* xn_cur = (bf16_t*)(ws + ((l & 1) ? WS_XN2 : WS_XN)); bf16_t* xn_alt = (bf16_t*)(ws + ((l & 1) ? WS_XN : WS_XN2));
#define GINIT GPh g; g.G = GDIM; g.c = BIDX; g.nseg = 1; g.nlay = 1; g.a_lay = 0; g.b_lay = 0; g.nM = MT / 256; \
    g.rss = nullptr; g.rss_next = nullptr; g.gnext = nullptr; g.X = (float*)(ws + WS_X); g.XN = xn_alt; g.O = nullptr; g.DT = (float*)(ws + WS_DT); \
    g.PROJ = (const bf16_t*)(ws + WS_PROJ); g.SSQ = (const float*)(ws + WS_SSQ); g.UPB = nullptr; \
    g.A = xn_cur; g.lda = 1024; g.ldb = 1024; g.K = 1024; g.nN = 4;
    switch (s) {
    case -1: { GINIT g.A = (const bf16_t*)(ws + WS_PBF); g.Bt = (const bf16_t*)(ws + WS_WPU); g.lda = 256; g.ldb = 256; g.K = 256; g.nlay = 4; g.a_lay = (size_t)MT * 256; g.b_lay = (size_t)1024 * 256;
        g.O = (bf16_t*)(ws + WS_UP); gemm_phase<EPI_UP>(lds, g); } break;
    case 0: { GINIT g.Bt = (const bf16_t*)(ws + WS_WIN) + (size_t)l * NIN * 1024; g.nN = NIN / 256;
        g.rss = RSS + (size_t)(3 * l) * MT * 16; g.O = (bf16_t*)(ws + WS_PROJ); gemm_phase<EPI_P1>(lds, g); } break;
    case 2: { GINIT g.A = (const bf16_t*)(ws + WS_Y); g.Bt = (const bf16_t*)(ws + WS_WBR) + (size_t)l * 1024 * 2048; g.lda = 2048; g.ldb = 2048; g.K = 512; g.nseg = 4;
        g.O = (bf16_t*)(ws + WS_MRG); g.nM = 64; gemm_phase<EPI_P3>(lds, g); mini_gemm<EPI_P3>(lds, g); } break;
    case 3: { GINIT g.A = (const bf16_t*)(ws + WS_MRG); g.Bt = (const bf16_t*)(ws + WS_WOUT) + (size_t)l * 1024 * 1024;
        g.rss_next = RSS + (size_t)(3 * l + 1) * MT * 16; g.gnext = PIN(I_NFFN) + (size_t)l * 1024; g.nM = 64; gemm_phase<EPI_P4>(lds, g); mini_gemm<EPI_P4>(lds, g); } break;
    case 4: { GINIT g.A = xn_alt; g.Bt = (const bf16_t*)(ws + WS_WGU) + (size_t)l * 5632 * 1024; g.nN = 22;
        g.rss = RSS + (size_t)(3 * l + 1) * MT * 16; g.O = (bf16_t*)(ws + WS_ACT); gemm_phase<EPI_P5>(lds, g); } break;
    case 5: { GINIT g.A = (const bf16_t*)(ws + WS_ACT); g.Bt = (const bf16_t*)(ws + WS_WDN) + (size_t)l * 1024 * DFF; g.lda = DFF; g.ldb = DFF; g.K = DFF;
        g.XN = xn_cur; g.rss_next = RSS + (size_t)(3 * l + 2) * MT * 16; g.gnext = PIN(I_NPLE) + (size_t)l * 1024; g.nM = 64; gemm_phase<EPI_P6>(lds, g); mini_gemm<EPI_P6>(lds, g); } break;
    default: { GINIT g.Bt = (const bf16_t*)(ws + WS_WPG) + (size_t)l * 1024 * 1024;
        g.rss = RSS + (size_t)(3 * l + 2) * MT * 16; g.rss_next = RSS + (size_t)(3 * l + 3) * MT * 16; g.gnext = l < 3 ? PIN(I_NMIX) + (size_t)(l + 1) * 1024 : PIN(I_FN);
        g.UPB = (const bf16_t*)(ws + WS_UP) + (size_t)l * MT * 1024; g.nM = 64; gemm_phase<EPI_P7>(lds, g); mini_gemm<EPI_P7>(lds, g); } break;
    }
#undef GINIT
}

__global__ void __launch_bounds__(NTHR, 2) hybrid_fwd(Params P) {
    extern __shared__ __attribute__((aligned(16))) uchar smem[];
    LAS uchar* lds = (LAS uchar*)smem;
    cg::grid_group grid = cg::this_grid();
    volatile LAS unsigned* st = (volatile LAS unsigned*)(lds + LDS_BYTES);
    if (threadIdx.x < 4) st[threadIdx.x] = 0u;
    __syncthreads();
    const XcdBarrier xbar = xcd_barrier_post((unsigned*)(P.ws + WS_BAR), st);
    for (int ph = P.ph_lo; ph < P.ph_hi; ++ph) {
        int nrep_ = 1;
#ifdef PROBE_REP
        { const int s_ = ph >= 2 && ph < 30 ? (ph - 2) % 7 : (ph == 0 ? 7 : (ph == 1 ? 8 : 9)); if ((PROBE_REP >> s_) & 1) nrep_ = 2; }
#endif
#pragma unroll 1
        for (int r_ = 0; r_ < nrep_; ++r_) { run_phase(lds, P, ph); __syncthreads(); }
        if (ph + 1 < P.ph_hi) {
            if (ph == P.ph_lo) {
                asm volatile("s_waitcnt vmcnt(0)" ::: "memory");
                __syncthreads();
                if (threadIdx.x < 64) { __builtin_amdgcn_fence(__ATOMIC_RELEASE, "agent"); asm volatile("s_waitcnt vmcnt(0)" ::: "memory"); }
                __syncthreads();
                grid.sync();
                if (threadIdx.x < 64) { __builtin_amdgcn_fence(__ATOMIC_ACQUIRE, "agent"); asm volatile("s_waitcnt vmcnt(0)" ::: "memory"); }
                __syncthreads();
            } else xcd_barrier(xbar);
        }
    }
}

extern "C" void kernel_launch(void* const* d_in, const int* in_sizes, int n_in, void* d_out, int out_size, void* d_ws, size_t ws_size, hipStream_t stream) {
    static int grid = 0;
    if (grid == 0) {
        if (n_in != 32 || (size_t)out_size != O_END || ws_size < WS_END) { fprintf(stderr, "kernel_launch: shape mismatch n_in %d out %d (want %zu) ws %zu (want %zu)\n", n_in, out_size, (size_t)O_END, ws_size, (size_t)WS_END); grid = -1; return; }
        int dev = 0, cus = 0, per_cu = 0;
        hipGetDevice(&dev); hipDeviceGetAttribute(&cus, hipDeviceAttributeMultiprocessorCount, dev);
        if (hipFuncSetAttribute((const void*)hybrid_fwd, hipFuncAttributeMaxDynamicSharedMemorySize, LDS_BYTES + 16) != hipSuccess) { fprintf(stderr, "kernel_launch: hipFuncSetAttribute failed\n"); grid = -1; return; }
        hipOccupancyMaxActiveBlocksPerMultiprocessor(&per_cu, (const void*)hybrid_fwd, NTHR, LDS_BYTES + 16);
        if (per_cu < 1) { fprintf(stderr, "kernel_launch: occupancy query says %d blocks per CU\n", per_cu); per_cu = 1; }
        grid = cus * 1;
        fprintf(stderr, "kernel_launch: cus %d per_cu %d grid %d\n", cus, per_cu, grid);
    }
    if (grid < 0) return;
    hipMemsetAsync((char*)d_ws + WS_BAR, 0, 16384, stream);
    Params p{};
    for (int i = 0; i < 32; ++i) p.in[i] = (const float*)d_in[i];
    p.out = (float*)d_out; p.ws = (uchar*)d_ws;
#if MULTI_LAUNCH
    for (int ph = 0; ph < 31; ++ph) { p.ph_lo = ph; p.ph_hi = ph + 1; hipLaunchKernelGGL(hybrid_fwd, dim3(grid), dim3(NTHR), LDS_BYTES + 16, stream, p); }
#else
    p.ph_lo = 0; p.ph_hi = 31;
    void* args[] = {&p};
    hipError_t e = hipLaunchCooperativeKernel((const void*)hybrid_fwd, dim3(grid), dim3(NTHR), args, LDS_BYTES + 16, stream);
    if (e != hipSuccess) fprintf(stderr, "cooperative launch failed: %s (grid %d)\n", hipGetErrorString(e), grid);
#endif
}
```

```cpp
#include <hip/hip_runtime.h>
#include <hip/hip_cooperative_groups.h>
#include <cstdio>
namespace cg = cooperative_groups;

#define LAS __attribute__((address_space(3)))
typedef unsigned short bf16_t;
typedef unsigned char uchar;
typedef short bf16x8 __attribute__((ext_vector_type(8)));
typedef float f32x4 __attribute__((ext_vector_type(4)));
typedef unsigned u32x4 __attribute__((ext_vector_type(4)));
typedef unsigned u32x2 __attribute__((ext_vector_type(2)));

#ifndef MULTI_LAUNCH
#define MULTI_LAUNCH 0
#endif

constexpr int MT = 17408, MPR = 16384, DM = 1024, NPROJ = 7168, NIN = 7424, DFF = 2816;
constexpr float EPS = 1e-6f;
constexpr int NTHR = 512;
constexpr int LDS_BYTES = 143360;
constexpr int C_Z = 0, C_XBC = 1024, C_U = 2560, C_V = 3072, C_POOL = 3584, C_GA = 4096, C_GB = 5120, C_GC = 6144;
constexpr size_t al256(size_t x) { return (x + 255) & ~(size_t)255; }
constexpr size_t WS_WIN = 0;
constexpr size_t WS_WBR = WS_WIN + (size_t)4 * NIN * 1024 * 2;
constexpr size_t WS_WOUT = WS_WBR + (size_t)4 * 1024 * 2048 * 2;
constexpr size_t WS_WGU = WS_WOUT + (size_t)4 * 1024 * 1024 * 2;
constexpr size_t WS_WDN = WS_WGU + (size_t)4 * 5632 * 1024 * 2;
constexpr size_t WS_WPG = WS_WDN + (size_t)4 * 1024 * 2816 * 2;
constexpr size_t WS_WPU = WS_WPG + (size_t)4 * 1024 * 1024 * 2;
constexpr size_t WS_X = WS_WPU + (size_t)4 * 1024 * 256 * 2;
constexpr size_t WS_XN = WS_X + (size_t)MT * 1024 * 4;
constexpr size_t WS_RSS = WS_XN + (size_t)MT * 1024 * 2;
constexpr size_t WS_PROJ = al256(WS_RSS + (size_t)13 * MT * 16 * 4);
constexpr size_t WS_DT = WS_PROJ + (size_t)MT * NPROJ * 2;
constexpr size_t WS_Y = WS_DT + (size_t)MT * 16 * 4;
constexpr size_t WS_SSQ = WS_Y + (size_t)MT * 2048 * 2;
constexpr size_t WS_MRG = WS_SSQ + (size_t)MT * 16 * 4;
constexpr size_t WS_ACT = WS_MRG + (size_t)MT * 1024 * 2;
constexpr size_t WS_UP = WS_ACT + (size_t)MT * DFF * 2;
constexpr size_t WS_PBF = WS_UP + (size_t)4 * MT * 1024 * 2;
constexpr size_t WS_XN2 = WS_PBF + (size_t)4 * MT * 256 * 2;
constexpr size_t WS_BAR = WS_XN2 + (size_t)MT * 1024 * 2;
constexpr size_t WS_END = WS_BAR + 16384;
constexpr size_t O_Y = 0;
constexpr size_t O_CONVP = (size_t)MT * 1024;
constexpr size_t O_SSMP = O_CONVP + (size_t)4 * 8 * 3 * 1536;
constexpr size_t O_POOLP = O_SSMP + (size_t)4 * 8 * 16 * 64 * 128;
constexpr size_t O_VP = O_POOLP + (size_t)4 * 8 * 15 * 512;
constexpr size_t O_CONVS = O_VP + (size_t)4 * 8 * 128 * 512;
constexpr size_t O_SSMS = O_CONVS + (size_t)4 * 128 * 3 * 1536;
constexpr size_t O_POOLS = O_SSMS + (size_t)4 * 128 * 16 * 64 * 128;
constexpr size_t O_VS = O_POOLS + (size_t)4 * 128 * 15 * 512;
constexpr size_t O_END = O_VS + (size_t)4 * 128 * 8 * 512;

struct Params {
    const float* in[32];
    float* out;
    uchar* ws;
    int ph_lo, ph_hi;
};
enum { I_XP = 0, I_XS, I_SCONV, I_SSSM, I_SPOOL, I_PP, I_PS, I_NMIX, I_WIN, I_CONVW, I_CONVB, I_DTB, I_ALOG, I_DSKIP, I_SSDN, I_LNG, I_LNB, I_WSP, I_BSP,
       I_POOLW, I_POOLS, I_WBRA, I_WBRB, I_WBRC, I_WOUT, I_NFFN, I_WGU, I_WDN, I_NPLE, I_WPG, I_WPU, I_FN };


__device__ __forceinline__ int launder_s(int i) { asm volatile("" : "+s"(i)); return i; }
__device__ __forceinline__ int launder_v(int i) { asm volatile("" : "+v"(i)); return i; }
template <class T> __device__ __forceinline__ T* launder_p(T* p) { asm volatile("" : "+s"(p)); return p; }
__device__ __forceinline__ size_t launder_z() { size_t z = 0; asm volatile("" : "+s"(z)); return z; }
typedef const float __attribute__((address_space(1)))* gcf_t;
#define PIN(i) ((const float*)(gcf_t)(P.in[launder_s(i)]))
#define TIDX launder_v((int)threadIdx.x)
#define BIDX launder_s((int)blockIdx.x)
#define GDIM launder_s((int)gridDim.x)
__device__ __forceinline__ unsigned cvt_pk_bf16(float lo, float hi) { unsigned r; asm("v_cvt_pk_bf16_f32 %0, %1, %2" : "=v"(r) : "v"(lo), "v"(hi)); return r; }
__device__ __forceinline__ float bf_lo(unsigned w) { return __uint_as_float(w << 16); }
__device__ __forceinline__ float bf_hi(unsigned w) { return __uint_as_float(w & 0xffff0000u); }
__device__ __forceinline__ float bf1(bf16_t b) { return __uint_as_float(((unsigned)b) << 16); }
__device__ __forceinline__ float frcp(float x) { return __builtin_amdgcn_rcpf(x); }
__device__ __forceinline__ float sigmoidf_(float x) { return frcp(1.0f + __expf(-x)); }
__device__ __forceinline__ float siluf_(float x) { return x * sigmoidf_(x); }
__device__ __forceinline__ float gelu_tanh(float x) { const float u = 1.5957691216057308f * (x + 0.044715f * x * x * x); return x * sigmoidf_(u); }
__device__ __forceinline__ float softplusf_(float x) {
    const float e = __expf(-fabsf(x));
    const float l = e < 0.03f ? e * (1.0f - e * (0.5f - e * (0.33333334f - e * 0.25f))) : __logf(1.0f + e);
    return fmaxf(x, 0.f) + l;
}
__device__ __forceinline__ float shx(float v, int m) { return __shfl_xor(v, m, 64); }

__device__ __forceinline__ float rownorm(const float* rssp, int row) {
    const f32x4 a = *(const f32x4*)(rssp + (size_t)row * 16), b = *(const f32x4*)(rssp + (size_t)row * 16 + 4), c = *(const f32x4*)(rssp + (size_t)row * 16 + 8), d = *(const f32x4*)(rssp + (size_t)row * 16 + 12);
    const float s = ((a[0] + a[1]) + (a[2] + a[3])) + ((b[0] + b[1]) + (b[2] + b[3])) + ((c[0] + c[1]) + (c[2] + c[3])) + ((d[0] + d[1]) + (d[2] + d[3]));
    return rsqrtf(s * (1.0f / 1024.0f) + EPS);
}
constexpr int BM = 256, BK = 64, HALF = 128, HTB = HALF * BK * 2, NXCD = 8, WGM = 8;
__device__ __forceinline__ int lds_byte(int r, int c) { const int st = (r >> 4) * 2 + (c >> 5), rr = r & 15, cc = c & 31, ob = rr * 64 + cc * 2; return st * 1024 + (ob ^ (((ob >> 9) & 1) << 5)); }
__device__ __forceinline__ void stage_rc(int b, int& R, int& C) { const int st = b / 1024, sb = b % 1024, swz = sb ^ (((sb >> 9) & 1) << 5); R = (st >> 1) * 16 + swz / 64; C = (st & 1) * 32 + (swz % 64) / 2; }

struct Unit { int pm, pn, seg, lay; };
enum { EPI_UP = 0, EPI_P1, EPI_P3, EPI_P4, EPI_P5, EPI_P6, EPI_P7 };

struct GPh {
    const bf16_t* A; const bf16_t* Bt; int lda, ldb, K, nM, nN, nseg, nlay; size_t a_lay, b_lay;
    int G, c;
    const float* rss; float* rss_next; const float* gnext; float* X; bf16_t* XN; bf16_t* O; float* DT; const bf16_t* PROJ; const float* SSQ; const bf16_t* UPB;
    __device__ __forceinline__ bool next(int i, Unit& u) const {
        const int tiles = nM * nN; const long L = (long)(i / nseg) * G + c; if (L >= (long)tiles * nlay) return false;
        u.seg = i % nseg; u.lay = (int)(L / tiles); int wgid = (int)(L % tiles);
        { const int q = tiles / NXCD, r = tiles % NXCD, xcd = wgid % NXCD, off = wgid / NXCD; wgid = (xcd < r ? xcd * (q + 1) : r * (q + 1) + (xcd - r) * q) + off; }
        const int nig = WGM * nN, gid = wgid / nig, fm = gid * WGM, gsz = (nM - fm) < WGM ? (nM - fm) : WGM;
        u.pm = fm + ((wgid % nig) % gsz); u.pn = (wgid % nig) / gsz; return true;
    }
    __device__ __forceinline__ const char* pa(const Unit& u) const { return (const char*)(A + u.lay * a_lay + (size_t)u.pm * BM * lda + (size_t)u.seg * K); }
    __device__ __forceinline__ const char* pb(const Unit& u) const { return (const char*)(Bt + u.lay * b_lay + (size_t)u.pn * BM * ldb + (size_t)u.seg * K); }
};

__device__ __forceinline__ void p3_rowscale(const GPh& P, const int row, const int seg, float& rs0, float& rs1) {
    rs0 = 1.f; rs1 = 1.f;
    if (seg < 2) { const f32x4 a0 = *(const f32x4*)(P.SSQ + (size_t)row * 16), a1 = *(const f32x4*)(P.SSQ + (size_t)row * 16 + 4), b0 = *(const f32x4*)(P.SSQ + (size_t)row * 16 + 8), b1 = *(const f32x4*)(P.SSQ + (size_t)row * 16 + 12);
        rs0 = rsqrtf((a0[0] + a0[1] + a0[2] + a0[3] + a1[0] + a1[1] + a1[2] + a1[3]) * (1.0f / 512.0f) + EPS);
        rs1 = rsqrtf((b0[0] + b0[1] + b0[2] + b0[3] + b1[0] + b1[1] + b1[2] + b1[3]) * (1.0f / 512.0f) + EPS); }
}
__device__ __forceinline__ void p3_elem(const GPh& P, f32x4& v, const int row, const int col, const int seg, const float rs0, const float rs1) {
    const bf16_t* prow = P.PROJ + (size_t)row * NPROJ;
    if (seg == 0) { v = v * (rs0 * frcp(rs1)); }
    else if (seg == 1) { const u32x2 ga = *(const u32x2*)(prow + C_GA + col), gb = *(const u32x2*)(prow + C_GB + col);
        v[0] *= rs1 * bf_lo(ga.x) * frcp(bf_lo(gb.x)); v[1] *= rs1 * bf_hi(ga.x) * frcp(bf_hi(gb.x)); v[2] *= rs1 * bf_lo(ga.y) * frcp(bf_lo(gb.y)); v[3] *= rs1 * bf_hi(ga.y) * frcp(bf_hi(gb.y)); }
    else if (seg == 2) { const u32x2 ga = *(const u32x2*)(prow + C_GB + col), gb = *(const u32x2*)(prow + C_GC + col);
        v[0] *= bf_lo(ga.x) * frcp(bf_lo(gb.x)); v[1] *= bf_hi(ga.x) * frcp(bf_hi(gb.x)); v[2] *= bf_lo(ga.y) * frcp(bf_lo(gb.y)); v[3] *= bf_hi(ga.y) * frcp(bf_hi(gb.y)); }
    else { const u32x2 gc = *(const u32x2*)(prow + C_GC + col);
        u32x2 o; o.x = cvt_pk_bf16(v[0] * bf_lo(gc.x), v[1] * bf_hi(gc.x)); o.y = cvt_pk_bf16(v[2] * bf_lo(gc.y), v[3] * bf_hi(gc.y)); *(u32x2*)(P.O + (size_t)row * 1024 + col) = o; }
}
template <int EPI>
__device__ __forceinline__ void epi_row(const GPh& P, f32x4 (&a)[2][2], const int row, const int col0, const int pn, const int wc, const int fq, const int seg, const int lay) {
    if constexpr (EPI == EPI_UP) {
        bf16_t* O = P.O + (size_t)lay * MT * 1024;
#pragma unroll
        for (int bj = 0; bj < 2; ++bj)
#pragma unroll
            for (int n = 0; n < 2; ++n) { const int col = col0 + bj * HALF + n * 16; const f32x4 v = a[bj][n];
                u32x2 o; o.x = cvt_pk_bf16(v[0], v[1]); o.y = cvt_pk_bf16(v[2], v[3]); *(u32x2*)(O + (size_t)row * 1024 + col) = o; }
    } else if constexpr (EPI == EPI_P1) {
        const float r = rownorm(P.rss, row);
#pragma unroll
        for (int bj = 0; bj < 2; ++bj)
#pragma unroll
            for (int n = 0; n < 2; ++n) { const int col = col0 + bj * HALF + n * 16; f32x4 v = a[bj][n] * r;
                if (pn == 28) { if (col - NPROJ < 16) *(f32x4*)(P.DT + (size_t)row * 16 + (col - NPROJ)) = v; }
                else {
                    if (pn >= 10 && pn < 14) { v[0] = gelu_tanh(v[0]); v[1] = gelu_tanh(v[1]); v[2] = gelu_tanh(v[2]); v[3] = gelu_tanh(v[3]); }
                    else if (pn >= 16) { v[0] = sigmoidf_(v[0]); v[1] = sigmoidf_(v[1]); v[2] = sigmoidf_(v[2]); v[3] = sigmoidf_(v[3]); }
                    u32x2 o; o.x = cvt_pk_bf16(v[0], v[1]); o.y = cvt_pk_bf16(v[2], v[3]); *(u32x2*)(P.O + (size_t)row * NPROJ + col) = o; } }
    } else if constexpr (EPI == EPI_P3) {
        float rs0, rs1; p3_rowscale(P, row, seg, rs0, rs1);
#pragma unroll
        for (int bj = 0; bj < 2; ++bj)
#pragma unroll
            for (int n = 0; n < 2; ++n) p3_elem(P, a[bj][n], row, col0 + bj * HALF + n * 16, seg, rs0, rs1);
    } else if constexpr (EPI == EPI_P5) {
        const float r = rownorm(P.rss, row);
#pragma unroll
        for (int bj = 0; bj < 2; ++bj) { const f32x4 g = a[bj][0] * r, uu = a[bj][1] * r;
            const int ocol = 16 * (8 * pn + 4 * bj + wc) + 4 * fq;
            u32x2 o; o.x = cvt_pk_bf16(siluf_(g[0]) * uu[0], siluf_(g[1]) * uu[1]); o.y = cvt_pk_bf16(siluf_(g[2]) * uu[2], siluf_(g[3]) * uu[3]);
            *(u32x2*)(P.O + (size_t)row * DFF + ocol) = o; }
    } else {
        float ss = 0.f; float r7 = 0.f;
        if constexpr (EPI == EPI_P7) r7 = rownorm(P.rss, row);
#pragma unroll
        for (int bj = 0; bj < 2; ++bj)
#pragma unroll
            for (int n = 0; n < 2; ++n) { const int col = col0 + bj * HALF + n * 16; const f32x4 v = a[bj][n];
                f32x4 xv = *(const f32x4*)(P.X + (size_t)row * 1024 + col);
                if constexpr (EPI == EPI_P7) { const u32x2 up = *(const u32x2*)(P.UPB + (size_t)row * 1024 + col);
                    xv[0] += bf_lo(up.x) * sigmoidf_(v[0] * r7); xv[1] += bf_hi(up.x) * sigmoidf_(v[1] * r7); xv[2] += bf_lo(up.y) * sigmoidf_(v[2] * r7); xv[3] += bf_hi(up.y) * sigmoidf_(v[3] * r7); }
                else xv += v;
                *(f32x4*)(P.X + (size_t)row * 1024 + col) = xv;
                ss += xv[0] * xv[0] + xv[1] * xv[1] + xv[2] * xv[2] + xv[3] * xv[3];
                const f32x4 gn = *(const f32x4*)(P.gnext + col);
                u32x2 o; o.x = cvt_pk_bf16(xv[0] * gn[0], xv[1] * gn[1]); o.y = cvt_pk_bf16(xv[2] * gn[2], xv[3] * gn[3]); *(u32x2*)(P.XN + (size_t)row * 1024 + col) = o; }
        ss += shx(ss, 16); ss += shx(ss, 32);
        if (fq == 0) P.rss_next[(size_t)row * 16 + pn * 4 + wc] = ss;
    }
}
template <int EPI>
__device__ __forceinline__ void epilogue(const GPh& P, f32x4 (&acc)[2][2][4][2], const Unit& u, int, int, int, int) {
    const int tid_ = TIDX, wid_ = tid_ >> 6, wr = wid_ >> 2, wc = wid_ & 3, fr = tid_ & 15, fq = (tid_ >> 4) & 3;
    const int row0 = u.pm * BM + wr * 64 + fr, col0 = u.pn * BM + wc * 32 + 4 * fq;
#pragma unroll
    for (int ai = 0; ai < 2; ++ai)
#pragma unroll
        for (int m = 0; m < 4; ++m) {
            const int row = row0 + ai * HALF + m * 16;
            if constexpr (EPI == EPI_P3) {
                float rs0, rs1; p3_rowscale(P, row, u.seg, rs0, rs1);
#pragma unroll
                for (int bj = 0; bj < 2; ++bj)
#pragma unroll
                    for (int n = 0; n < 2; ++n) p3_elem(P, acc[ai][bj][m][n], row, col0 + bj * HALF + n * 16, u.seg, rs0, rs1);
            } else {
                f32x4 a[2][2] = {{acc[ai][0][m][0], acc[ai][0][m][1]}, {acc[ai][1][m][0], acc[ai][1][m][1]}};
                epi_row<EPI>(P, a, row, col0, u.pn, wc, fq, u.seg, u.lay);
            }
        }
}

template <int EPI>
__device__ __forceinline__ void mini_gemm(LAS uchar* lds, const GPh& P) {
    const int tid = TIDX, wid = tid >> 6, lane = tid & 63, kh = wid >> 2, wc = wid & 3, fr = lane & 15, fq = lane >> 4;
    const int nseg = P.nseg, K = P.K, Kh = K >> 1;
    for (int su = P.c; su < 256; su += P.G) {
        const int strip = su >> 2, pn = su & 3; const int row = MPR + strip * 16 + fr;
        const bf16_t* Ap = P.A + (size_t)row * P.lda + fq * 8;
        const bf16_t* Bp = P.Bt + (size_t)(pn * 256 + wc * 32 + fr) * P.ldb + fq * 8;
        f32x4 a[2][2];
#pragma unroll
        for (int bj = 0; bj < 2; ++bj)
#pragma unroll
            for (int n = 0; n < 2; ++n) a[bj][n] = (f32x4){0.f, 0.f, 0.f, 0.f};
        __syncthreads();
        for (int seg = 0; seg < nseg; ++seg) {
            const int kbeg = seg * K + kh * Kh;
#pragma unroll 1
            for (int k0 = kbeg; k0 < kbeg + Kh; k0 += 128) {
                bf16x8 af[4], bfr[4][2][2];
#pragma unroll
                for (int s = 0; s < 4; ++s) { af[s] = *(const bf16x8*)(Ap + k0 + s * 32);
#pragma unroll
                    for (int bj = 0; bj < 2; ++bj)
#pragma unroll
                        for (int n = 0; n < 2; ++n) bfr[s][bj][n] = *(const bf16x8*)(Bp + (size_t)(bj * HALF + n * 16) * P.ldb + k0 + s * 32); }
#pragma unroll
                for (int s = 0; s < 4; ++s)
#pragma unroll
                    for (int bj = 0; bj < 2; ++bj)
#pragma unroll
                        for (int n = 0; n < 2; ++n) a[bj][n] = __builtin_amdgcn_mfma_f32_16x16x32_bf16(bfr[s][bj][n], af[s], a[bj][n], 0, 0, 0);
            }
            if (EPI == EPI_P3 && seg < 3) epi_row<EPI>(P, a, row, pn * 256 + wc * 32 + 4 * fq, pn, wc, fq, seg, 0);
        }
        LAS f32x4* xch = (LAS f32x4*)lds;
        if (kh == 1) {
#pragma unroll
            for (int bj = 0; bj < 2; ++bj)
#pragma unroll
                for (int n = 0; n < 2; ++n) xch[((wc * 4 + bj * 2 + n) * 64) + lane] = a[bj][n];
        }
        __syncthreads();
        if (kh == 0) {
#pragma unroll
            for (int bj = 0; bj < 2; ++bj)
#pragma unroll
                for (int n = 0; n < 2; ++n) a[bj][n] += xch[((wc * 4 + bj * 2 + n) * 64) + lane];
            epi_row<EPI>(P, a, row, pn * 256 + wc * 32 + 4 * fq, pn, wc, fq, nseg - 1, 0);
        }
    }
}

template <int EPI>
__device__ __forceinline__ void gemm_phase(LAS uchar* lds, const GPh& P) {
    const int tid = TIDX, wid = __builtin_amdgcn_readfirstlane(tid >> 6), lane = tid & 63, wr = wid >> 2, wc = wid & 3, fr = lane & 15, fq = lane >> 4;
    const int K = P.K, nt = K / BK;
    unsigned voffA[2], voffB[2];
#pragma unroll
    for (int i = 0; i < 2; ++i) { int R, C; stage_rc(tid * 16 + i * 8192, R, C); voffA[i] = (unsigned)(R * P.lda + C) * 2u; voffB[i] = (unsigned)(R * P.ldb + C) * 2u; }
    const size_t kstep = (size_t)(BK * 2);
    const size_t hstepA = (size_t)HALF * P.lda * 2, hstepB = (size_t)HALF * P.ldb * 2;
    const unsigned ldsw = (unsigned)wid * 1024u;
    const int aoff = lds_byte(wr * 64 + fr, fq * 8), boff = lds_byte(wc * 32 + fr, fq * 8);
#define PG8_SA(b, h) (((b) * 2 + (h)) * HTB)
#define PG8_SB(b, h) ((4 + (b) * 2 + (h)) * HTB)
#define PG8_STAGE(bufoff, gbase, voff) do { _Pragma("unroll") for (int _i = 0; _i < 2; ++_i) \
        __builtin_amdgcn_global_load_lds((const unsigned*)((const char*)(gbase) + (voff)[_i]), (LAS unsigned*)(lds + (bufoff) + ldsw + _i * 8192), 16, 0, 0); } while (0)
#define PG8_LDA(dst, b, h) do { _Pragma("unroll") for (int m = 0; m < 4; ++m) _Pragma("unroll") for (int k = 0; k < 2; ++k) dst[m][k] = *(const LAS bf16x8*)(lds + PG8_SA(b, h) + aoff + m * 2048 + k * 1024); } while (0)
#define PG8_LDB(dst, b, h) do { _Pragma("unroll") for (int n = 0; n < 2; ++n) _Pragma("unroll") for (int k = 0; k < 2; ++k) dst[n][k] = *(const LAS bf16x8*)(lds + PG8_SB(b, h) + boff + n * 2048 + k * 1024); } while (0)
#define PG8_MMA(ai, bj, At, Bt) do { __builtin_amdgcn_s_setprio(1); _Pragma("unroll") for (int m = 0; m < 4; ++m) _Pragma("unroll") for (int n = 0; n < 2; ++n) _Pragma("unroll") for (int k = 0; k < 2; ++k) \
        acc[ai][bj][m][n] = __builtin_amdgcn_mfma_f32_16x16x32_bf16(Bt[n][k], At[m][k], acc[ai][bj][m][n], 0, 0, 0); __builtin_amdgcn_s_setprio(0); } while (0)
#define PG8_WAIT_V(n) asm volatile("s_waitcnt vmcnt(" #n ")" ::: "memory")
#define PG8_WAIT_L(n) asm volatile("s_waitcnt lgkmcnt(" #n ")" ::: "memory")
#define PG8_BAR __builtin_amdgcn_s_barrier()
#define PG8_SCHED __builtin_amdgcn_sched_barrier(0)
    Unit cur, nxt; int ui = 0;
    if (!P.next(0, cur)) return;
    f32x4 acc[2][2][4][2];
#pragma unroll
    for (int a = 0; a < 2; ++a)
#pragma unroll
        for (int b = 0; b < 2; ++b)
#pragma unroll
            for (int m = 0; m < 4; ++m)
#pragma unroll
                for (int n = 0; n < 2; ++n) acc[a][b][m][n] = (f32x4){0.f, 0.f, 0.f, 0.f};
    bf16x8 At[4][2], B0[2][2], B1[2][2];
    const char* cA = P.pa(cur); const char* cB = P.pb(cur);
    PG8_STAGE(PG8_SB(0, 0), cB, voffB); PG8_STAGE(PG8_SA(0, 0), cA, voffA); PG8_STAGE(PG8_SB(0, 1), cB + hstepB, voffB); PG8_STAGE(PG8_SA(0, 1), cA + hstepA, voffA);
    if (wr == 1) PG8_BAR;
    PG8_WAIT_V(4); PG8_BAR;
    PG8_STAGE(PG8_SB(1, 0), cB + kstep, voffB); PG8_STAGE(PG8_SA(1, 0), cA + kstep, voffA); PG8_STAGE(PG8_SB(1, 1), cB + hstepB + kstep, voffB);
    PG8_WAIT_V(6); PG8_BAR;
    for (;;) {
        const bool has_next = P.next(ui + 1, nxt);
        const char* nA = has_next ? P.pa(nxt) : cA; const char* nB = has_next ? P.pb(nxt) : cB;
        for (int t = 0; t < nt; t += 2) {
            const bool last = (t == nt - 2);
            const char* a1 = cA + (size_t)(t + 1) * kstep;
            const char* a2 = last ? nA : cA + (size_t)(t + 2) * kstep; const char* b2 = last ? nB : cB + (size_t)(t + 2) * kstep;
            const char* a3 = a2 + kstep; const char* b3 = b2 + kstep;
            PG8_LDB(B0, 0, 0); PG8_SCHED; PG8_LDA(At, 0, 0); PG8_STAGE(PG8_SA(1, 1), a1 + hstepA, voffA);
            PG8_WAIT_L(8); PG8_BAR; PG8_WAIT_L(0); PG8_MMA(0, 0, At, B0); PG8_BAR; PG8_SCHED;
            PG8_LDB(B1, 0, 1); PG8_STAGE(PG8_SB(0, 0), b2, voffB);
            PG8_BAR; PG8_WAIT_L(0); PG8_MMA(0, 1, At, B1); PG8_BAR;
            PG8_LDA(At, 0, 1); PG8_STAGE(PG8_SA(0, 0), a2, voffA);
            PG8_BAR; PG8_WAIT_L(0); PG8_MMA(1, 0, At, B0); PG8_BAR; PG8_SCHED;
            PG8_STAGE(PG8_SB(0, 1), b2 + hstepB, voffB);
            PG8_WAIT_V(6); PG8_BAR; PG8_MMA(1, 1, At, B1); PG8_BAR;
            PG8_LDB(B0, 1, 0); PG8_SCHED; PG8_LDA(At, 1, 0); PG8_STAGE(PG8_SA(0, 1), a2 + hstepA, voffA);
            PG8_WAIT_L(8); PG8_BAR; PG8_WAIT_L(0); PG8_MMA(0, 0, At, B0); PG8_BAR; PG8_SCHED;
            PG8_LDB(B1, 1, 1); PG8_STAGE(PG8_SB(1, 0), b3, voffB);
            PG8_BAR; PG8_WAIT_L(0); PG8_MMA(0, 1, At, B1); PG8_BAR;
            PG8_LDA(At, 1, 1); PG8_STAGE(PG8_SA(1, 0), a3, voffA);
            PG8_BAR; PG8_WAIT_L(0); PG8_MMA(1, 0, At, B0); PG8_BAR; PG8_SCHED;
            PG8_STAGE(PG8_SB(1, 1), b3 + hstepB, voffB);
            PG8_WAIT_V(6); PG8_BAR; PG8_MMA(1, 1, At, B1); PG8_BAR;
        }
        epilogue<EPI>(P, acc, cur, wr, wc, fr, fq);
        if (!has_next) break;
        if (EPI != EPI_P3 || cur.seg == 3) {
#pragma unroll
            for (int a = 0; a < 2; ++a)
#pragma unroll
                for (int b = 0; b < 2; ++b)
#pragma unroll
                    for (int m = 0; m < 4; ++m)
#pragma unroll
                        for (int n = 0; n < 2; ++n) acc[a][b][m][n] = (f32x4){0.f, 0.f, 0.f, 0.f};
        }
        cur = nxt; cA = nA; cB = nB; ++ui;
    }
    PG8_WAIT_V(0);
    if (wr == 0) PG8_BAR;
    PG8_BAR;
#undef PG8_SA
#undef PG8_SB
#undef PG8_STAGE
#undef PG8_LDA
#undef PG8_LDB
#undef PG8_MMA
#undef PG8_WAIT_V
#undef PG8_WAIT_L
#undef PG8_BAR
#undef PG8_SCHED
}

template <int NT, int KS>
__device__ __forceinline__ void wmma(const LAS uchar* A, const LAS uchar* B, int pitch, f32x4 (&acc)[NT], int fr, int fq) {
#pragma unroll 1
    for (int ks = 0; ks < KS; ++ks) {
        const bf16x8 a = *(const LAS bf16x8*)(A + fr * pitch + (ks * 32 + fq * 8) * 2);
#pragma unroll
        for (int ni = 0; ni < NT; ++ni) {
            const bf16x8 b = *(const LAS bf16x8*)(B + (ni * 16 + fr) * pitch + (ks * 32 + fq * 8) * 2);
            acc[ni] = __builtin_amdgcn_mfma_f32_16x16x32_bf16(b, a, acc[ni], 0, 0, 0);
        }
    }
}
constexpr int PB = 272;

__device__ __forceinline__ int map_row(int n, int map) {
    if (map == 1) return n < 2560 ? n : (n < 2576 ? 7168 + (n - 2560) : n - 16);
    if (map == 2) { const int up = n >= DFF, nn = up ? n - DFF : n; return 32 * (nn >> 4) + 16 * up + (nn & 15); }
    return n;
}
__device__ __forceinline__ void tr_tile(LAS float* T, const float* src, int N, bf16_t* dst, int ldd, int dcol0, int k0, int n0, int map) {
    const int tid = TIDX;
    __syncthreads();
#pragma unroll
    for (int ps = 0; ps < 2; ++ps) { const int r = ps * 32 + (tid >> 4), c4 = (tid & 15) * 4; const int n = n0 + c4;
        f32x4 v = (f32x4){0.f, 0.f, 0.f, 0.f}; if (n < N) v = *(const f32x4*)(src + (size_t)(k0 + r) * N + n);
        T[r * 65 + c4 + 0] = v[0]; T[r * 65 + c4 + 1] = v[1]; T[r * 65 + c4 + 2] = v[2]; T[r * 65 + c4 + 3] = v[3]; }
    __syncthreads();
    { const int n = tid >> 3, k8 = (tid & 7) * 8;
        if (n0 + n < N) { u32x4 o; float f[8];
#pragma unroll
            for (int j = 0; j < 8; ++j) f[j] = T[(k8 + j) * 65 + n];
            o.x = cvt_pk_bf16(f[0], f[1]); o.y = cvt_pk_bf16(f[2], f[3]); o.z = cvt_pk_bf16(f[4], f[5]); o.w = cvt_pk_bf16(f[6], f[7]);
            *(u32x4*)(dst + (size_t)map_row(n0 + n, map) * ldd + dcol0 + k0 + k8) = o; } }
}

__device__ __forceinline__ void phase_pre(LAS uchar* lds, const Params& P) {
    const int tid = TIDX, G = GDIM, bid = BIDX;
    uchar* ws = (P.ws + launder_z());
    LAS float* T = (LAS float*)lds;
    constexpr int T_IN = 16 * 113, T_BRA = 256, T_BRB = 128, T_OUT = 256, T_GU = 16 * 88, T_DN = 44 * 16, T_PG = 256, T_PU = 64;
    constexpr int T_L = T_IN + T_BRA + T_BRB + T_OUT + T_GU + T_DN + T_PG + T_PU;
    for (int job = bid; job < 4 * T_L; job += G) {
        const int l = job / T_L; int j = job % T_L;
        if (j < T_IN) { tr_tile(T, PIN(I_WIN) + (size_t)l * 1024 * 7184, 7184, (bf16_t*)(ws + WS_WIN) + (size_t)l * NIN * 1024, 1024, 0, (j / 113) * 64, (j % 113) * 64, 1); continue; } j -= T_IN;
        if (j < T_BRA) { tr_tile(T, PIN(I_WBRA) + (size_t)l * 1024 * 1024, 1024, (bf16_t*)(ws + WS_WBR) + (size_t)l * 1024 * 2048, 2048, 0, (j / 16) * 64, (j % 16) * 64, 0); continue; } j -= T_BRA;
        if (j < T_BRB) { tr_tile(T, PIN(I_WBRB) + (size_t)l * 512 * 1024, 1024, (bf16_t*)(ws + WS_WBR) + (size_t)l * 1024 * 2048, 2048, 1024, (j / 16) * 64, (j % 16) * 64, 0); continue; } j -= T_BRB;
        if (j < T_OUT) { tr_tile(T, PIN(I_WOUT) + (size_t)l * 1024 * 1024, 1024, (bf16_t*)(ws + WS_WOUT) + (size_t)l * 1024 * 1024, 1024, 0, (j / 16) * 64, (j % 16) * 64, 0); continue; } j -= T_OUT;
        if (j < T_GU) { tr_tile(T, PIN(I_WGU) + (size_t)l * 1024 * 5632, 5632, (bf16_t*)(ws + WS_WGU) + (size_t)l * 5632 * 1024, 1024, 0, (j / 88) * 64, (j % 88) * 64, 2); continue; } j -= T_GU;
        if (j < T_DN) { tr_tile(T, PIN(I_WDN) + (size_t)l * DFF * 1024, 1024, (bf16_t*)(ws + WS_WDN) + (size_t)l * 1024 * DFF, DFF, 0, (j / 16) * 64, (j % 16) * 64, 0); continue; } j -= T_DN;
        if (j < T_PG) { tr_tile(T, PIN(I_WPG) + (size_t)l * 1024 * 1024, 1024, (bf16_t*)(ws + WS_WPG) + (size_t)l * 1024 * 1024, 1024, 0, (j / 16) * 64, (j % 16) * 64, 0); continue; } j -= T_PG;
        tr_tile(T, PIN(I_WPU) + (size_t)l * 256 * 1024, 1024, (bf16_t*)(ws + WS_WPU) + (size_t)l * 1024 * 256, 256, 0, (j / 16) * 64, (j % 16) * 64, 0);
    }
    {
        LAS float* PW = (LAS float*)lds;
        LAS float* WC = (LAS float*)(lds + 128 * 129 * 4);
        for (int job = bid; job < 4 * 4 * 16; job += G) {
            const int l = job >> 6, g = (job >> 4) & 3, n0 = (job & 15) * 64;
            __syncthreads();
            for (int e = tid; e < 128 * 128; e += NTHR) { const int c = e >> 7, d = e & 127; PW[c * 129 + d] = PIN(I_POOLW)[((size_t)(l * 4 + g) * 128 + c) * 128 + d] * PIN(I_POOLS)[l * 512 + g * 128 + d]; }
            for (int e = tid; e < 128 * 64; e += NTHR) { const int d = e >> 6, n = e & 63; WC[d * 64 + n] = PIN(I_WBRC)[((size_t)l * 512 + g * 128 + d) * 1024 + n0 + n]; }
            __syncthreads();
            const int c = tid & 127, nq = (tid >> 7) * 16;
            float a[16];
#pragma unroll
            for (int i = 0; i < 16; ++i) a[i] = 0.f;
            for (int d = 0; d < 128; ++d) { const float pw = PW[c * 129 + d];
#pragma unroll
                for (int i = 0; i < 16; ++i) a[i] += pw * WC[d * 64 + nq + i]; }
            bf16_t* dst = (bf16_t*)(ws + WS_WBR) + (size_t)l * 1024 * 2048;
#pragma unroll
            for (int i = 0; i < 16; ++i) dst[(size_t)(n0 + nq + i) * 2048 + 1536 + g * 128 + c] = (bf16_t)(cvt_pk_bf16(a[i], 0.f) & 0xffffu);
        }
    }
    {
        const int lane = tid & 63, wv = tid >> 6;
        float* X = (float*)(ws + WS_X); bf16_t* XN = (bf16_t*)(ws + WS_XN); float* RSS = (float*)(ws + WS_RSS);
        const float* g0 = PIN(I_NMIX);
        for (int row = bid * 8 + wv; row < MT; row += G * 8) {
            const float* src = row < MPR ? PIN(I_XP) + (size_t)row * 1024 : PIN(I_XS) + (size_t)(row - MPR) * 1024;
            float ss = 0.f;
#pragma unroll
            for (int i = 0; i < 4; ++i) { const int col = i * 256 + lane * 4; const f32x4 v = *(const f32x4*)(src + col); const f32x4 gg = *(const f32x4*)(g0 + col);
                *(f32x4*)(X + (size_t)row * 1024 + col) = v; ss += v[0] * v[0] + v[1] * v[1] + v[2] * v[2] + v[3] * v[3];
                u32x2 o; o.x = cvt_pk_bf16(v[0] * gg[0], v[1] * gg[1]); o.y = cvt_pk_bf16(v[2] * gg[2], v[3] * gg[3]); *(u32x2*)(XN + (size_t)row * 1024 + col) = o; }
#pragma unroll
            for (int s = 1; s < 64; s <<= 1) ss += shx(ss, s);
            if (lane < 16) RSS[(size_t)row * 16 + lane] = lane == 0 ? ss : 0.f;
        }
    }
    {
        bf16_t* PBF = (bf16_t*)(ws + WS_PBF);
        const size_t n4 = (size_t)4 * MT * 256 / 4;
        for (size_t i = (size_t)bid * NTHR + tid; i < n4; i += (size_t)G * NTHR) {
            const size_t e = i * 4; const int l = (int)(e / ((size_t)MT * 256)); const size_t rem = e % ((size_t)MT * 256); const int row = (int)(rem >> 8), col = (int)(rem & 255);
            const float* src = row < MPR ? PIN(I_PP) + ((size_t)l * MPR + row) * 256 + col : PIN(I_PS) + ((size_t)l * 1024 + (row - MPR)) * 256 + col;
            const f32x4 v = *(const f32x4*)src; u32x2 o; o.x = cvt_pk_bf16(v[0], v[1]); o.y = cvt_pk_bf16(v[2], v[3]); *(u32x2*)(PBF + e) = o;
        }
    }
}

constexpr int L_CS = 0, L_BS = 34816, L_BDT = 69632, L_XT = 104448, L_SB = 121856, L_SC = 139264;
__device__ __forceinline__ int xbc_chan(int cc, int h, int g) { return cc < 64 ? h * 64 + cc : (cc < 192 ? 1024 + g * 128 + (cc - 64) : 1280 + g * 128 + (cc - 192)); }

__device__ __forceinline__ void ssd_prompt(LAS uchar* lds, const Params& P, int l, int b, int h) {
    const int tid = TIDX, lane = tid & 63, w = tid >> 6, fr = lane & 15, fq = lane >> 4, g = h >> 3;
    const bf16_t* PROJ = (const bf16_t*)((P.ws + launder_z()) + WS_PROJ); const float* DT = (const float*)((P.ws + launder_z()) + WS_DT);
    bf16_t* Y = (bf16_t*)((P.ws + launder_z()) + WS_Y); float* SSQ = (float*)((P.ws + launder_z()) + WS_SSQ);
    const float a_h = -__expf(PIN(I_ALOG)[l * 16 + h]), dtb = PIN(I_DTB)[l * 16 + h], Dh = PIN(I_DSKIP)[l * 16 + h];
    f32x4 S[4];
#pragma unroll
    for (int i = 0; i < 4; ++i) S[i] = (f32x4){0.f, 0.f, 0.f, 0.f};
    const int wu = __builtin_amdgcn_readfirstlane(w);
    const bf16_t* xsrc = PROJ + (size_t)(b * 2048) * NPROJ + C_XBC;
    const float* cwp = PIN(I_CONVW) + (size_t)l * 4 * 1536; const float* cbp = PIN(I_CONVB) + (size_t)l * 1536;
    float dN0 = 0.f, dN1 = 0.f;
#define SSD_LD1(cc, i, dst) do { const int ch_ = xbc_chan((8 * (i) + wu) * 8, h, g); \
            _Pragma("unroll") for (int k = 0; k < 5; ++k) { const int pos = (cc) * 128 + 2 * lane - 3 + k; \
                dst[k] = (u32x4){0u, 0u, 0u, 0u}; if (pos >= 0) dst[k] = *(const u32x4*)(xsrc + (size_t)pos * NPROJ + ch_); } } while (0)
#define SSD_DTLOAD(cc) do { if (w == 0) { dN0 = DT[(size_t)(b * 2048 + (cc) * 128 + 2 * lane) * 16 + h]; dN1 = DT[(size_t)(b * 2048 + (cc) * 128 + 2 * lane + 1) * 16 + h]; } } while (0)
#define SSD_SCAL(sb) do { if (w == 0) { LAS float* acs_ = (LAS float*)(lds + L_SC + (sb) * 2048); \
            const float d0 = softplusf_(dN0 + dtb), d1 = softplusf_(dN1 + dtb); const float a0 = d0 * a_h, a1 = d1 * a_h; float inc = a0 + a1; \
            _Pragma("unroll") for (int s = 1; s < 64; s <<= 1) { const float o = __shfl_up(inc, s, 64); if (lane >= s) inc += o; } \
            const float tot = __shfl(inc, 63, 64); const float c1 = inc, c0 = inc - a1; \
            acs_[2 * lane] = c0; acs_[2 * lane + 1] = c1; acs_[128 + 2 * lane] = d0; acs_[128 + 2 * lane + 1] = d1; \
            acs_[256 + 2 * lane] = __expf(c0); acs_[256 + 2 * lane + 1] = __expf(c1); acs_[384 + 2 * lane] = __expf(tot - c0) * d0; acs_[384 + 2 * lane + 1] = __expf(tot - c1) * d1; } } while (0)
#define SSD_CONV(sb, cc) do { const int lr = 2 * launder_v(lane); const LAS float* decdt_ = (const LAS float*)(lds + L_SC + (sb) * 2048) + 384; \
        u32x4 xr[2][5]; SSD_LD1(cc, 0, xr[0]); \
        _Pragma("unroll") for (int i = 0; i < 5; ++i) { const int cgx = 8 * i + wu; const int ch_ = xbc_chan(cgx * 8, h, g); \
            if (i < 4) SSD_LD1(cc, i + 1, xr[(i + 1) & 1]); \
            float xf[5][8]; \
            _Pragma("unroll") for (int k = 0; k < 5; ++k) { const u32x4 v = xr[i & 1][k]; \
                xf[k][0] = bf_lo(v.x); xf[k][1] = bf_hi(v.x); xf[k][2] = bf_lo(v.y); xf[k][3] = bf_hi(v.y); xf[k][4] = bf_lo(v.z); xf[k][5] = bf_hi(v.z); xf[k][6] = bf_lo(v.w); xf[k][7] = bf_hi(v.w); } \
            float o0[8], o1[8]; \
            _Pragma("unroll") for (int j = 0; j < 8; ++j) { \
                const float w0 = cwp[ch_ + j], w1 = cwp[1536 + ch_ + j], w2 = cwp[3072 + ch_ + j], w3 = cwp[4608 + ch_ + j]; \
                const float bb = cbp[ch_ + j]; \
                o0[j] = siluf_(bb + w0 * xf[0][j] + w1 * xf[1][j] + w2 * xf[2][j] + w3 * xf[3][j]); \
                o1[j] = siluf_(bb + w0 * xf[1][j] + w1 * xf[2][j] + w2 * xf[3][j] + w3 * xf[4][j]); } \
            if (cgx < 8) { _Pragma("unroll") for (int j = 0; j < 8; ++j) *(LAS unsigned*)(lds + L_XT + (cgx * 8 + j) * PB + lr * 2) = cvt_pk_bf16(o0[j], o1[j]); } \
            else if (cgx < 24) { const int n0 = (cgx - 8) * 8; const float s0 = decdt_[lr], s1 = decdt_[lr + 1]; \
                u32x4 q; q.x = cvt_pk_bf16(o0[0], o0[1]); q.y = cvt_pk_bf16(o0[2], o0[3]); q.z = cvt_pk_bf16(o0[4], o0[5]); q.w = cvt_pk_bf16(o0[6], o0[7]); *(LAS u32x4*)(lds + L_BS + lr * PB + n0 * 2) = q; \
                q.x = cvt_pk_bf16(o1[0], o1[1]); q.y = cvt_pk_bf16(o1[2], o1[3]); q.z = cvt_pk_bf16(o1[4], o1[5]); q.w = cvt_pk_bf16(o1[6], o1[7]); *(LAS u32x4*)(lds + L_BS + (lr + 1) * PB + n0 * 2) = q; \
                _Pragma("unroll") for (int j = 0; j < 8; ++j) *(LAS unsigned*)(lds + L_BDT + (n0 + j) * PB + lr * 2) = cvt_pk_bf16(o0[j] * s0, o1[j] * s1); } \
            else { const int n0 = (cgx - 24) * 8; \
                u32x4 q; q.x = cvt_pk_bf16(o0[0], o0[1]); q.y = cvt_pk_bf16(o0[2], o0[3]); q.z = cvt_pk_bf16(o0[4], o0[5]); q.w = cvt_pk_bf16(o0[6], o0[7]); *(LAS u32x4*)(lds + L_CS + lr * PB + n0 * 2) = q; \
                q.x = cvt_pk_bf16(o1[0], o1[1]); q.y = cvt_pk_bf16(o1[2], o1[3]); q.z = cvt_pk_bf16(o1[4], o1[5]); q.w = cvt_pk_bf16(o1[6], o1[7]); *(LAS u32x4*)(lds + L_CS + (lr + 1) * PB + n0 * 2) = q; } } } while (0)

    __syncthreads();
    SSD_DTLOAD(0);
    SSD_SCAL(0);
    __syncthreads();
    SSD_CONV(0, 0);
#pragma unroll 1
    for (int c = 0; c < 16; ++c) {
        const int grow0 = b * 2048 + c * 128, sb = c & 1;
        LAS float* acs = (LAS float*)(lds + L_SC + sb * 2048); LAS float* dtv = acs + 128; LAS float* eacs = acs + 256;
        __syncthreads();
        if (c < 15) SSD_DTLOAD(c + 1);
        const int lrow = 16 * w + fr, row = grow0 + lrow;
        u32x2 zz[4];
#pragma unroll
        for (int ni = 0; ni < 4; ++ni) zz[ni] = *(const u32x2*)(PROJ + (size_t)row * NPROJ + C_Z + h * 64 + ni * 16 + 4 * fq);
        if (c < 15) SSD_SCAL(sb ^ 1);
        {
            f32x4 cb[8];
#pragma unroll
            for (int i = 0; i < 8; ++i) cb[i] = (f32x4){0.f, 0.f, 0.f, 0.f};
            wmma<8, 4>(lds + L_CS + w * 16 * PB, lds + L_BS, PB, cb, fr, fq);
            __syncthreads();
            const float al = acs[lrow];
#pragma unroll
            for (int ni = 0; ni < 8; ++ni) { const int s0 = ni * 16 + 4 * fq; float mv[4];
#pragma unroll
                for (int e = 0; e < 4; ++e) { const int s = s0 + e; const float dd = fminf(al - acs[s], 0.f); mv[e] = (s <= lrow) ? cb[ni][e] * __expf(dd) * dtv[s] : 0.f; }
                u32x2 o; o.x = cvt_pk_bf16(mv[0], mv[1]); o.y = cvt_pk_bf16(mv[2], mv[3]); *(LAS u32x2*)(lds + L_BS + lrow * PB + s0 * 2) = o; }
        }
        __syncthreads();
        {
            f32x4 y[4];
#pragma unroll
            for (int i = 0; i < 4; ++i) y[i] = (f32x4){0.f, 0.f, 0.f, 0.f};
            if (c > 0) { wmma<4, 4>(lds + L_CS + w * 16 * PB, lds + L_SB, PB, y, fr, fq); const float ea = eacs[lrow];
#pragma unroll
                for (int i = 0; i < 4; ++i) y[i] = y[i] * ea; }
            wmma<4, 4>(lds + L_BS + w * 16 * PB, lds + L_XT, PB, y, fr, fq);
            float ssq = 0.f;
#pragma unroll
            for (int ni = 0; ni < 4; ++ni) { const int p0 = ni * 16 + 4 * fq;
                const f32x4 ng = *(const f32x4*)(PIN(I_SSDN) + (size_t)l * 1024 + h * 64 + p0);
                float zf[4] = {bf_lo(zz[ni].x), bf_hi(zz[ni].x), bf_lo(zz[ni].y), bf_hi(zz[ni].y)}; float ov[4];
#pragma unroll
                for (int e = 0; e < 4; ++e) { const float xs = bf1(*(const LAS bf16_t*)(lds + L_XT + (p0 + e) * PB + lrow * 2)); const float v = (y[ni][e] + Dh * xs) * siluf_(zf[e]); ssq += v * v; ov[e] = v * ng[e]; }
                u32x2 o; o.x = cvt_pk_bf16(ov[0], ov[1]); o.y = cvt_pk_bf16(ov[2], ov[3]); *(u32x2*)(Y + (size_t)row * 2048 + h * 64 + p0) = o; }
            ssq += shx(ssq, 16); ssq += shx(ssq, 32);
            if (fq == 0) SSQ[(size_t)row * 16 + h] = ssq;
        }
        __syncthreads();
        {
            const float et = eacs[127];
#pragma unroll
            for (int i = 0; i < 4; ++i) S[i] = S[i] * et;
            wmma<4, 4>(lds + L_XT + (w >> 1) * 16 * PB, lds + L_BDT + (w & 1) * 64 * PB, PB, S, fr, fq);
            const int p = (w >> 1) * 16 + fr;
#pragma unroll
            for (int ni = 0; ni < 4; ++ni) { const int n0 = (w & 1) * 64 + ni * 16 + 4 * fq; u32x2 o; o.x = cvt_pk_bf16(S[ni][0], S[ni][1]); o.y = cvt_pk_bf16(S[ni][2], S[ni][3]); *(LAS u32x2*)(lds + L_SB + p * PB + n0 * 2) = o; }
        }
        __syncthreads();
        if (c < 15) SSD_CONV(sb ^ 1, c + 1);
    }
#undef SSD_LD1
#undef SSD_DTLOAD
#undef SSD_SCAL
#undef SSD_CONV
    {
        float* dst = (P.out + launder_z()) + O_SSMP + ((size_t)((l * 8 + b) * 16 + h) * 64) * 128; const int p = (w >> 1) * 16 + fr;
#pragma unroll
        for (int ni = 0; ni < 4; ++ni) { const int n0 = (w & 1) * 64 + ni * 16 + 4 * fq; *(f32x4*)(dst + (size_t)p * 128 + n0) = S[ni]; }
    }
}

__device__ __forceinline__ void ssd_sample(LAS uchar* lds, const Params& P, int l, int b, int hp) {
    const int tid = TIDX, half = tid >> 8, t8 = tid & 255, h = hp * 2 + half, g = h >> 3;
    const bf16_t* PROJ = (const bf16_t*)((P.ws + launder_z()) + WS_PROJ); const float* DT = (const float*)((P.ws + launder_z()) + WS_DT);
    bf16_t* Y = (bf16_t*)((P.ws + launder_z()) + WS_Y); float* SSQ = (float*)((P.ws + launder_z()) + WS_SSQ);
    LAS float* xs = (LAS float*)(lds + half * 16384); LAS float* Bv = xs + 512; LAS float* Cv = xs + 1536; LAS float* sdt = xs + 2560; LAS float* sdec = xs + 2568; LAS float* yv = xs + 2576;
    const int row0 = MPR + b * 8;
    __syncthreads();
    for (int cc = t8; cc < 320; cc += 256) {
        const int ch = xbc_chan(cc, h, g);
        float xv[11];
#pragma unroll
        for (int k = 0; k < 3; ++k) xv[k] = PIN(I_SCONV)[((size_t)(l * 128 + b) * 3 + k) * 1536 + ch];
#pragma unroll
        for (int t = 0; t < 8; ++t) xv[3 + t] = bf1(PROJ[(size_t)(row0 + t) * NPROJ + C_XBC + ch]);
        const float w0 = PIN(I_CONVW)[(size_t)(l * 4 + 0) * 1536 + ch], w1 = PIN(I_CONVW)[(size_t)(l * 4 + 1) * 1536 + ch], w2 = PIN(I_CONVW)[(size_t)(l * 4 + 2) * 1536 + ch], w3 = PIN(I_CONVW)[(size_t)(l * 4 + 3) * 1536 + ch];
        const float cb = PIN(I_CONVB)[(size_t)l * 1536 + ch];
#pragma unroll
        for (int t = 0; t < 8; ++t) { const float o = siluf_(cb + w0 * xv[t] + w1 * xv[t + 1] + w2 * xv[t + 2] + w3 * xv[t + 3]);
            if (cc < 64) xs[t * 64 + cc]= o; else if (cc < 192) Bv[t * 128 + cc - 64] = o; else Cv[t * 128 + cc - 192] = o; }
    }
    if (t8 < 8) { const float d = softplusf_(DT[(size_t)(row0 + t8) * 16 + h] + PIN(I_DTB)[l * 16 + h]); sdt[t8] = d; sdec[t8] = __expf(-d * __expf(PIN(I_ALOG)[l * 16 + h])); }
    __syncthreads();
    const int l16 = t8 & 15, pr = t8 >> 4;
    const float* hin = PIN(I_SSSM) + ((size_t)((l * 128 + b) * 16 + h) * 64) * 128;
    float* hout = (P.out + launder_z()) + O_SSMS + ((size_t)((l * 128 + b) * 16 + h) * 64) * 128;
    f32x4 hs[4][2];
#pragma unroll
    for (int pi = 0; pi < 4; ++pi)
#pragma unroll
        for (int it = 0; it < 2; ++it) hs[pi][it] = *(const f32x4*)(hin + (size_t)(pi * 16 + pr) * 128 + it * 64 + l16 * 4);
#pragma unroll 1
    for (int t = 0; t < 8; ++t) {
        const float dec = sdec[t], dtt = sdt[t];
        const f32x4 B0 = *(const LAS f32x4*)(Bv + t * 128 + l16 * 4), B1 = *(const LAS f32x4*)(Bv + t * 128 + 64 + l16 * 4);
        const f32x4 C0 = *(const LAS f32x4*)(Cv + t * 128 + l16 * 4), C1 = *(const LAS f32x4*)(Cv + t * 128 + 64 + l16 * 4);
#pragma unroll
        for (int pi = 0; pi < 4; ++pi) { const float xd = xs[t * 64 + pi * 16 + pr] * dtt;
            hs[pi][0] = hs[pi][0] * dec + B0 * xd; hs[pi][1] = hs[pi][1] * dec + B1 * xd;
            const f32x4 q = hs[pi][0] * C0 + hs[pi][1] * C1; float yp = q[0] + q[1] + q[2] + q[3];
            yp += shx(yp, 1); yp += shx(yp, 2); yp += shx(yp, 4); yp += shx(yp, 8);
            if (l16 == 0) yv[t * 64 + pi * 16 + pr] = yp; }
    }
#pragma unroll
    for (int pi = 0; pi < 4; ++pi)
#pragma unroll
        for (int it = 0; it < 2; ++it) *(f32x4*)(hout + (size_t)(pi * 16 + pr) * 128 + it * 64 + l16 * 4) = hs[pi][it];
    __syncthreads();
    {
        const int t = t8 >> 5, p0 = (t8 & 31) * 2, row = row0 + t; const float Dh = PIN(I_DSKIP)[l * 16 + h];
        const unsigned zz = *(const unsigned*)(PROJ + (size_t)row * NPROJ + C_Z + h * 64 + p0);
        const float v0 = (yv[t * 64 + p0] + Dh * xs[t * 64 + p0]) * siluf_(bf_lo(zz)), v1 = (yv[t * 64 + p0 + 1] + Dh * xs[t * 64 + p0 + 1]) * siluf_(bf_hi(zz));
        float ssq = v0 * v0 + v1 * v1;
        ssq += shx(ssq, 1); ssq += shx(ssq, 2); ssq += shx(ssq, 4); ssq += shx(ssq, 8); ssq += shx(ssq, 16);
        *(unsigned*)(Y + (size_t)row * 2048 + h * 64 + p0) = cvt_pk_bf16(v0 * PIN(I_SSDN)[(size_t)l * 1024 + h * 64 + p0], v1 * PIN(I_SSDN)[(size_t)l * 1024 + h * 64 + p0 + 1]);
        if ((t8 & 31) == 0) SSQ[(size_t)row * 16 + h] = ssq;
    }
}

__device__ __forceinline__ void sgu_prompt(LAS uchar* lds, const Params& P, int l, int b, int c, int g) {
    const int tid = TIDX, lane = tid & 63, w = tid >> 6, fr = lane & 15, fq = lane >> 4;
    const bf16_t* PROJ = (const bf16_t*)((P.ws + launder_z()) + WS_PROJ); bf16_t* Y = (bf16_t*)((P.ws + launder_z()) + WS_Y);
    LAS float* smu = (LAS float*)(lds + 69632); LAS float* srs = smu + 128;
    const int grow0 = b * 2048 + c * 128;
    __syncthreads();
    {
        const int r = tid >> 2, q = tid & 3; const bf16_t* src = PROJ + (size_t)(grow0 + r) * NPROJ + C_V + q * 128;
        float s = 0.f, s2 = 0.f;
#pragma unroll
        for (int i = 0; i < 16; ++i) { const u32x4 v = *(const u32x4*)(src + i * 8);
            const float f[8] = {bf_lo(v.x), bf_hi(v.x), bf_lo(v.y), bf_hi(v.y), bf_lo(v.z), bf_hi(v.z), bf_lo(v.w), bf_hi(v.w)};
#pragma unroll
            for (int j = 0; j < 8; ++j) { s += f[j]; s2 += f[j] * f[j]; } }
        s += shx(s, 1); s += shx(s, 2); s2 += shx(s2, 1); s2 += shx(s2, 2);
        const float mu = s * (1.0f / 512.0f), var = fmaxf(s2 * (1.0f / 512.0f) - mu * mu, 0.f);
        if (q == 0) { smu[r] = mu; srs[r] = rsqrtf(var + EPS); }
        const float* wsrc = PIN(I_WSP) + ((size_t)(l * 4 + g) * 128 + r) * 128 + q * 32;
#pragma unroll
        for (int i = 0; i < 4; ++i) { const f32x4 a = *(const f32x4*)(wsrc + i * 8), bb = *(const f32x4*)(wsrc + i * 8 + 4); const int s0 = q * 32 + i * 8;
            u32x4 o; o.x = cvt_pk_bf16(s0 + 0 <= r ? a[0] : 0.f, s0 + 1 <= r ? a[1] : 0.f); o.y = cvt_pk_bf16(s0 + 2 <= r ? a[2] : 0.f, s0 + 3 <= r ? a[3] : 0.f);
            o.z = cvt_pk_bf16(s0 + 4 <= r ? bb[0] : 0.f, s0 + 5 <= r ? bb[1] : 0.f); o.w = cvt_pk_bf16(s0 + 6 <= r ? bb[2] : 0.f, s0 + 7 <= r ? bb[3] : 0.f);
            *(LAS u32x4*)(lds + r * PB + s0 * 2) = o; }
    }
    __syncthreads();
    {
        const int r = tid >> 2, q = tid & 3; const bf16_t* src = PROJ + (size_t)(grow0 + r) * NPROJ + C_V + g * 128 + q * 32;
        const float mu = smu[r], rs = srs[r];
        const float* lg = PIN(I_LNG) + (size_t)l * 512 + g * 128 + q * 32; const float* lb = PIN(I_LNB) + (size_t)l * 512 + g * 128 + q * 32;
        float* vout = (P.out + launder_z()) + O_VP + ((size_t)(l * 8 + b) * 128 + r) * 512 + g * 128 + q * 32;
#pragma unroll
        for (int i = 0; i < 4; ++i) { const u32x4 v = *(const u32x4*)(src + i * 8);
            const float f[8] = {bf_lo(v.x), bf_hi(v.x), bf_lo(v.y), bf_hi(v.y), bf_lo(v.z), bf_hi(v.z), bf_lo(v.w), bf_hi(v.w)}; float vn[8];
#pragma unroll
            for (int j = 0; j < 8; ++j) { vn[j] = (f[j] - mu) * rs * lg[i * 8 + j] + lb[i * 8 + j];
                *(LAS bf16_t*)(lds + 34816 + (q * 32 + i * 8 + j) * PB + r * 2) = (bf16_t)(cvt_pk_bf16(vn[j], 0.f) & 0xffffu); }
            if (c == 15) { *(f32x4*)(vout + i * 8) = (f32x4){vn[0], vn[1], vn[2], vn[3]}; *(f32x4*)(vout + i * 8 + 4) = (f32x4){vn[4], vn[5], vn[6], vn[7]}; } }
    }
    __syncthreads();
    {
        f32x4 acc[8];
#pragma unroll
        for (int i = 0; i < 8; ++i) acc[i] = (f32x4){0.f, 0.f, 0.f, 0.f};
        wmma<8, 4>(lds + w * 16 * PB, lds + 34816, PB, acc, fr, fq);
        const int t = 16 * w + fr, row = grow0 + t; const float bs = PIN(I_BSP)[(size_t)(l * 4 + g) * 128 + t];
#pragma unroll
        for (int ni = 0; ni < 8; ++ni) { const int d0 = ni * 16 + 4 * fq; const u32x2 uu = *(const u32x2*)(PROJ + (size_t)row * NPROJ + C_U + g * 128 + d0);
            u32x2 o; o.x = cvt_pk_bf16(bf_lo(uu.x) * (acc[ni][0] + bs), bf_hi(uu.x) * (acc[ni][1] + bs)); o.y = cvt_pk_bf16(bf_lo(uu.y) * (acc[ni][2] + bs), bf_hi(uu.y) * (acc[ni][3] + bs));
            *(u32x2*)(Y + (size_t)row * 2048 + 1024 + g * 128 + d0) = o; }
    }
}

__device__ __forceinline__ void sgu_sample(LAS uchar* lds, const Params& P, int l, int b) {
    const int tid = TIDX, lane = tid & 63, w = tid >> 6, ch = tid, g = ch >> 7;
    const bf16_t* PROJ = (const bf16_t*)((P.ws + launder_z()) + WS_PROJ); bf16_t* Y = (bf16_t*)((P.ws + launder_z()) + WS_Y);
    LAS float* red = (LAS float*)lds;
    const int row0 = MPR + b * 8;
    float v[8], u[8];
#pragma unroll
    for (int s = 0; s < 8; ++s) { v[s] = bf1(PROJ[(size_t)(row0 + s) * NPROJ + C_V + ch]); u[s] = bf1(PROJ[(size_t)(row0 + s) * NPROJ + C_U + ch]); }
    __syncthreads();
#pragma unroll
    for (int s = 0; s < 8; ++s) { float a = v[s], a2 = v[s] * v[s];
#pragma unroll
        for (int m = 1; m < 64; m <<= 1) { a += shx(a, m); a2 += shx(a2, m); }
        if (lane == 0) { red[w * 16 + s] = a; red[w * 16 + 8 + s] = a2; } }
    __syncthreads();
    const float lg = PIN(I_LNG)[(size_t)l * 512 + ch], lb = PIN(I_LNB)[(size_t)l * 512 + ch];
    float vn[8];
#pragma unroll
    for (int s = 0; s < 8; ++s) { float a = 0.f, a2 = 0.f;
#pragma unroll
        for (int ww = 0; ww < 8; ++ww) { a += red[ww * 16 + s]; a2 += red[ww * 16 + 8 + s]; }
        const float mu = a * (1.0f / 512.0f), var = fmaxf(a2 * (1.0f / 512.0f) - mu * mu, 0.f);
        vn[s] = (v[s] - mu) * rsqrtf(var + EPS) * lg + lb;
        (P.out + launder_z())[O_VS + ((size_t)(l * 128 + b) * 8 + s) * 512 + ch] = vn[s]; }
    const float* W = PIN(I_WSP) + (size_t)(l * 4 + g) * 128 * 128; const float* bsp = PIN(I_BSP) + (size_t)(l * 4 + g) * 128;
#pragma unroll
    for (int t = 0; t < 8; ++t) { float o = bsp[t];
#pragma unroll
        for (int s = 0; s <= t; ++s) o += W[t * 128 + s] * vn[s];
        Y[(size_t)(row0 + t) * 2048 + 1024 + ch] = (bf16_t)(cvt_pk_bf16(u[t] * o, 0.f) & 0xffffu); }
}

__device__ __forceinline__ void pool_prompt(const Params& P, int tile) {
    const int tid = TIDX, cgp = tid & 63, rsg = tid >> 6, ch0 = cgp * 8, wdw = 2 << (cgp >> 4);
    const bf16_t* PROJ = (const bf16_t*)((P.ws + launder_z()) + WS_PROJ); bf16_t* Y = (bf16_t*)((P.ws + launder_z()) + WS_Y);
    const int b = tile >> 4, pos0 = (tile & 15) * 128 + rsg * 16; const size_t rbase = (size_t)b * 2048;
    float S[8];
#pragma unroll
    for (int j = 0; j < 8; ++j) S[j] = 0.f;
    for (int k = 1; k < wdw; ++k) { const int pos = pos0 - k; if (pos >= 0) { const u32x4 v = *(const u32x4*)(PROJ + (rbase + pos) * NPROJ + C_POOL + ch0);
        S[0] += bf_lo(v.x); S[1] += bf_hi(v.x); S[2] += bf_lo(v.y); S[3] += bf_hi(v.y); S[4] += bf_lo(v.z); S[5] += bf_hi(v.z); S[6] += bf_lo(v.w); S[7] += bf_hi(v.w); } }
#pragma unroll 1
    for (int t = 0; t < 16; ++t) { const int pos = pos0 + t;
        const u32x4 v = *(const u32x4*)(PROJ + (rbase + pos) * NPROJ + C_POOL + ch0);
        const float x[8] = {bf_lo(v.x), bf_hi(v.x), bf_lo(v.y), bf_hi(v.y), bf_lo(v.z), bf_hi(v.z), bf_lo(v.w), bf_hi(v.w)};
        const float ic = 1.0f / (float)min(pos + 1, wdw); float d[8];
#pragma unroll
        for (int j = 0; j < 8; ++j) { S[j] += x[j]; d[j] = S[j] * ic - x[j]; }
        u32x4 o; o.x = cvt_pk_bf16(d[0], d[1]); o.y = cvt_pk_bf16(d[2], d[3]); o.z = cvt_pk_bf16(d[4], d[5]); o.w = cvt_pk_bf16(d[6], d[7]);
        *(u32x4*)(Y + (rbase + pos) * 2048 + 1536 + ch0) = o;
        const int po = pos - wdw + 1;
        if (po >= 0) { const u32x4 q = *(const u32x4*)(PROJ + (rbase + po) * NPROJ + C_POOL + ch0);
            S[0] -= bf_lo(q.x); S[1] -= bf_hi(q.x); S[2] -= bf_lo(q.y); S[3] -= bf_hi(q.y); S[4] -= bf_lo(q.z); S[5] -= bf_hi(q.z); S[6] -= bf_lo(q.w); S[7] -= bf_hi(q.w); } }
}
__device__ __forceinline__ void pool_sample(const Params& P, int l, int si) {
    const int tid = TIDX, cgp = tid & 63, ch0 = cgp * 8, wdw = 2 << (cgp >> 4), b = si * 8 + (tid >> 6);
    const bf16_t* PROJ = (const bf16_t*)((P.ws + launder_z()) + WS_PROJ); bf16_t* Y = (bf16_t*)((P.ws + launder_z()) + WS_Y);
    const float* buf = PIN(I_SPOOL) + (size_t)(l * 128 + b) * 15 * 512 + ch0;
    const size_t rbase = (size_t)MPR + b * 8;
    float S[8];
#pragma unroll
    for (int j = 0; j < 8; ++j) S[j] = 0.f;
    for (int k = 1; k < wdw; ++k) { const f32x4 a = *(const f32x4*)(buf + (size_t)(15 - k) * 512), c = *(const f32x4*)(buf + (size_t)(15 - k) * 512 + 4);
        S[0] += a[0]; S[1] += a[1]; S[2] += a[2]; S[3] += a[3]; S[4] += c[0]; S[5] += c[1]; S[6] += c[2]; S[7] += c[3]; }
    const float ic = 1.0f / (float)wdw;
#pragma unroll 1
    for (int t = 0; t < 8; ++t) {
        const u32x4 v = *(const u32x4*)(PROJ + (rbase + t) * NPROJ + C_POOL + ch0);
        const float x[8] = {bf_lo(v.x), bf_hi(v.x), bf_lo(v.y), bf_hi(v.y), bf_lo(v.z), bf_hi(v.z), bf_lo(v.w), bf_hi(v.w)}; float d[8];
#pragma unroll
        for (int j = 0; j < 8; ++j) { S[j] += x[j]; d[j] = S[j] * ic - x[j]; }
        u32x4 o; o.x = cvt_pk_bf16(d[0], d[1]); o.y = cvt_pk_bf16(d[2], d[3]); o.z = cvt_pk_bf16(d[4], d[5]); o.w = cvt_pk_bf16(d[6], d[7]);
        *(u32x4*)(Y + (rbase + t) * 2048 + 1536 + ch0) = o;
        const int po = t - wdw + 1;
        if (po >= 0) { const u32x4 q = *(const u32x4*)(PROJ + (rbase + po) * NPROJ + C_POOL + ch0);
            S[0] -= bf_lo(q.x); S[1] -= bf_hi(q.x); S[2] -= bf_lo(q.y); S[3] -= bf_hi(q.y); S[4] -= bf_lo(q.z); S[5] -= bf_hi(q.z); S[6] -= bf_lo(q.w); S[7] -= bf_hi(q.w); }
        else { const f32x4 a = *(const f32x4*)(buf + (size_t)(15 + po) * 512), c = *(const f32x4*)(buf + (size_t)(15 + po) * 512 + 4);
            S[0] -= a[0]; S[1] -= a[1]; S[2] -= a[2]; S[3] -= a[3]; S[4] -= c[0]; S[5] -= c[1]; S[6] -= c[2]; S[7] -= c[3]; } }
}
constexpr int NC_CP = 8 * 3 * 1536, NC_CS = 128 * 3 * 1536, NC_PP = 8 * 15 * 512, NC_PS = 128 * 15 * 512, NC_ALL = NC_CP + NC_CS + NC_PP + NC_PS;
__device__ __forceinline__ void state_copy(const Params& P, int l, int item) {
    const bf16_t* PROJ = (const bf16_t*)((P.ws + launder_z()) + WS_PROJ);
    for (int j = 0; j < 16; ++j) { int e = item * 8192 + j * NTHR + TIDX; if (e >= NC_ALL) return;
        if (e < NC_CP) { const int ch = e % 1536, k = (e / 1536) % 3, b = e / 4608; (P.out + launder_z())[O_CONVP + (size_t)l * NC_CP + e] = bf1(PROJ[(size_t)(b * 2048 + 2045 + k) * NPROJ + C_XBC + ch]); continue; } e -= NC_CP;
        if (e < NC_CS) { const int ch = e % 1536, k = (e / 1536) % 3, b = e / 4608; (P.out + launder_z())[O_CONVS + (size_t)l * NC_CS + e] = bf1(PROJ[(size_t)(MPR + b * 8 + 5 + k) * NPROJ + C_XBC + ch]); continue; } e -= NC_CS;
        if (e < NC_PP) { const int ch = e % 512, k = (e / 512) % 15, b = e / 7680; (P.out + launder_z())[O_POOLP + (size_t)l * NC_PP + e] = bf1(PROJ[(size_t)(b * 2048 + 2033 + k) * NPROJ + C_POOL + ch]); continue; } e -= NC_PP;
        { const int ch = e % 512, k = (e / 512) % 15, b = e / 7680;
          (P.out + launder_z())[O_POOLS + (size_t)l * NC_PS + e] = k < 7 ? PIN(I_SPOOL)[((size_t)(l * 128 + b) * 15 + 8 + k) * 512 + ch] : bf1(PROJ[(size_t)(MPR + b * 8 + (k - 7)) * NPROJ + C_POOL + ch]); }
    }
}

__device__ __forceinline__ void phase_mixer(LAS uchar* lds, const Params& P, int l) {
    const int G = GDIM, bid = BIDX;
    constexpr int N_B = 1024, N_C = 512, N_D = 128, N_E = 128, N_E2 = 16, N_F = (NC_ALL + 8191) / 8192;
    constexpr int N_REST = N_B + N_C + N_D + N_E + N_E2 + N_F;
    if (G > 128) { if (bid < 128) ssd_prompt(lds, P, l, bid >> 4, bid & 15); }
    else { for (int i = bid; i < 128; i += G) ssd_prompt(lds, P, l, i >> 4, i & 15); }
    unsigned* ctr = (unsigned*)((P.ws + launder_z()) + WS_BAR) + 3584 + 64 * l;
    volatile LAS unsigned* bc = (volatile LAS unsigned*)(lds + LDS_BYTES) + 2;
    for (;;) {
        __syncthreads();
        if (TIDX == 0) bc[0] = __hip_atomic_fetch_add(ctr, 1u, __ATOMIC_RELAXED, __HIP_MEMORY_SCOPE_AGENT);
        __syncthreads();
        int j = (int)bc[0];
        if (j >= N_REST) break;
        if (j < N_C) { sgu_prompt(lds, P, l, j >> 6, (j >> 2) & 15, j & 3); continue; } j -= N_C;
        if (j < N_B) { ssd_sample(lds, P, l, j >> 3, j & 7); continue; } j -= N_B;
        if (j < N_D) { sgu_sample(lds, P, l, j); continue; } j -= N_D;
        if (j < N_E) { pool_prompt(P, j); continue; } j -= N_E;
        if (j < N_E2) { pool_sample(P, l, j); continue; } j -= N_E2;
        state_copy(P, l, j);
    }
}


#define XB_TMO      128
#define XB_XCNT(j)  (256  + 64 * (j))
#define XB_XSUB(j)  (1280 + 64 * (j))
#define XB_XGEN(j)  (2304 + 64 * (j))
#define XB_TOP      3328
#define XB_TOPGEN   3392
#define XCD_BAR_WORDS 3456
#define XB_SPIN_CAP (1u << 20)
__device__ __forceinline__ unsigned xb_ld(unsigned* p)              { return __hip_atomic_load(p, __ATOMIC_RELAXED, __HIP_MEMORY_SCOPE_AGENT); }
__device__ __forceinline__ unsigned xb_add(unsigned* p, unsigned v) { return __hip_atomic_fetch_add(p, v, __ATOMIC_RELAXED, __HIP_MEMORY_SCOPE_AGENT); }
__device__ __forceinline__ unsigned xb_xcc_id() { return (unsigned)__builtin_amdgcn_s_getreg((3 << 11) | 20) & 0xFu; }
#define XB_SPIN(cond, bar) do { unsigned _sp = 0; while (cond) { __builtin_amdgcn_s_sleep(1); \
    if ((++_sp & 255u) == 0u) { if (xb_ld(&(bar)[XB_TMO])) break; if (_sp > XB_SPIN_CAP) { atomicAdd(&(bar)[XB_TMO], 1u); break; } } } } while (0)
struct XcdBarrier { unsigned* bar; unsigned x; volatile LAS unsigned* st; };
__device__ __forceinline__ XcdBarrier xcd_barrier_post(unsigned* bar, volatile LAS unsigned* st) {
    XcdBarrier b; b.bar = bar; b.x = xb_xcc_id(); b.st = st;
    if (threadIdx.x == 0) (void)xb_add(&bar[XB_XCNT(b.x)], 1u);
    return b;
}
__device__ __forceinline__ void xcd_barrier_complete(unsigned* bar, unsigned x, unsigned& nloc, unsigned& nx) {
    const unsigned G = gridDim.x * gridDim.y * gridDim.z;
    unsigned sum, cnt, mine, sp = 0u;
    for (;;) {
        sum = 0u; cnt = 0u; mine = 0u;
#pragma unroll
        for (unsigned j = 0; j < 16; ++j) { const unsigned c = xb_ld(&bar[XB_XCNT(j)]); sum += c; cnt += (c > 0u) ? 1u : 0u; mine = (j == x) ? c : mine; }
        if (sum == G) break;
        __builtin_amdgcn_s_sleep(1);
        if ((++sp & 255u) == 0u) { if (xb_ld(&bar[XB_TMO])) break; if (sp > XB_SPIN_CAP) { atomicAdd(&bar[XB_TMO], 1u); break; } }
    }
    nloc = mine > 0u ? mine : 1u; nx = cnt > 0u ? cnt : 1u;
}
__device__ __forceinline__ void xcd_barrier(const XcdBarrier& b) {
    asm volatile("s_waitcnt vmcnt(0)" ::: "memory");
    __syncthreads();
    if (threadIdx.x == 0) {
        unsigned* bar = b.bar + launder_z(); const unsigned bx = (unsigned)launder_s((int)b.x);
        __builtin_amdgcn_s_waitcnt(0);
        unsigned nloc = b.st[0], nx = b.st[1];
        if (nloc == 0u) { xcd_barrier_complete(bar, bx, nloc, nx); b.st[0] = nloc; b.st[1] = nx; }
        const unsigned old = xb_add(&bar[XB_XSUB(bx)], 1u);
        const unsigned gen = old / nloc;
        if (old + 1u == (gen + 1u) * nloc) {
            __builtin_amdgcn_fence(__ATOMIC_RELEASE, "agent");
            asm volatile("s_waitcnt vmcnt(0)" ::: "memory");
            const unsigned og = xb_add(&bar[XB_TOP], 1u);
            const unsigned tg = og / nx;
            if (og + 1u == (tg + 1u) * nx) xb_add(&bar[XB_TOPGEN], 1u);
            else XB_SPIN(xb_ld(&bar[XB_TOPGEN]) == tg, bar);
            __builtin_amdgcn_fence(__ATOMIC_ACQUIRE, "agent");
            xb_add(&bar[XB_XGEN(bx)], 1u);
            asm volatile("s_waitcnt vmcnt(0)" ::: "memory");
        } else {
            XB_SPIN(xb_ld(&bar[XB_XGEN(bx)]) == gen, bar);
            __builtin_amdgcn_fence(__ATOMIC_ACQUIRE, "agent");
            asm volatile("s_waitcnt vmcnt(0)" ::: "memory");
        }
    }
    __syncthreads();
}

__device__ __forceinline__ void run_phase(LAS uchar* lds, const Params& P, int ph) {
    uchar* ws = (P.ws + launder_z());
    float* RSS = (float*)(ws + WS_RSS);
    if (ph == 0) { phase_pre(lds, P); return; }
    if (ph == 30) {
        const int tid = TIDX, lane = tid & 63, wv = tid >> 6; const float* X = (const float*)(ws + WS_X); const float* fg = PIN(I_FN);
        for (int row = BIDX * 8 + wv; row < MT; row += GDIM * 8) { const float r = rownorm(RSS + (size_t)12 * MT * 16, row);
#pragma unroll
            for (int i = 0; i < 4; ++i) { const int col = i * 256 + lane * 4; const f32x4 v = *(const f32x4*)(X + (size_t)row * 1024 + col), gg = *(const f32x4*)(fg + col);
                *(f32x4*)((P.out + launder_z()) + O_Y + (size_t)row * 1024 + col) = (f32x4){v[0] * r * gg[0], v[1] * r * gg[1], v[2] * r * gg[2], v[3] * r * gg[3]}; } }
        return; }
    const int l = ph >= 2 ? (ph - 2) / 7 : 0, s = ph >= 2 ? (ph - 2) % 7 : -1;
    if (s == 1) { phase_mixer(lds, P, l); return; }
    bf16_t* xn_cur = (bf16_t*)(ws + ((l & 1) ? WS_XN2 : WS_XN)); bf16_t* xn_alt = (bf16_t*)(ws + ((l & 1) ? WS_XN : WS_XN2));
#define GINIT GPh g; g.G = GDIM; g.c = BIDX; g.nseg = 1; g.nlay = 1; g.a_lay = 0; g.b_lay = 0; g.nM = MT / 256; \
    g.rss = nullptr; g.rss_next = nullptr; g.gnext = nullptr; g.X = (float*)(ws + WS_X); g.XN = xn_alt; g.O = nullptr; g.DT = (float*)(ws + WS_DT); \
    g.PROJ = (const bf16_t*)(ws + WS_PROJ); g.SSQ = (const float*)(ws + WS_SSQ); g.UPB = nullptr; \
    g.A = xn_cur; g.lda = 1024; g.ldb = 1024; g.K = 1024; g.nN = 4;
    switch (s) {
    case -1: { GINIT g.A = (const bf16_t*)(ws + WS_PBF); g.Bt = (const bf16_t*)(ws + WS_WPU); g.lda = 256; g.ldb = 256; g.K = 256; g.nlay = 4; g.a_lay = (size_t)MT * 256; g.b_lay = (size_t)1024 * 256;
        g.O = (bf16_t*)(ws + WS_UP); gemm_phase<EPI_UP>(lds, g); } break;
    case 0: { GINIT g.Bt = (const bf16_t*)(ws + WS_WIN) + (size_t)l * NIN * 1024; g.nN = NIN / 256;
        g.rss = RSS + (size_t)(3 * l) * MT * 16; g.O = (bf16_t*)(ws + WS_PROJ); gemm_phase<EPI_P1>(lds, g); } break;
    case 2: { GINIT g.A = (const bf16_t*)(ws + WS_Y); g.Bt = (const bf16_t*)(ws + WS_WBR) + (size_t)l * 1024 * 2048; g.lda = 2048; g.ldb = 2048; g.K = 512; g.nseg = 4;
        g.O = (bf16_t*)(ws + WS_MRG); g.nM = 64; gemm_phase<EPI_P3>(lds, g); mini_gemm<EPI_P3>(lds, g); } break;
    case 3: { GINIT g.A = (const bf16_t*)(ws + WS_MRG); g.Bt = (const bf16_t*)(ws + WS_WOUT) + (size_t)l * 1024 * 1024;
        g.rss_next = RSS + (size_t)(3 * l + 1) * MT * 16; g.gnext = PIN(I_NFFN) + (size_t)l * 1024; g.nM = 64; gemm_phase<EPI_P4>(lds, g); mini_gemm<EPI_P4>(lds, g); } break;
    case 4: { GINIT g.A = xn_alt; g.Bt = (const bf16_t*)(ws + WS_WGU) + (size_t)l * 5632 * 1024; g.nN = 22;
        g.rss = RSS + (size_t)(3 * l + 1) * MT * 16; g.O = (bf16_t*)(ws + WS_ACT); gemm_phase<EPI_P5>(lds, g); } break;
    case 5: { GINIT g.A = (const bf16_t*)(ws + WS_ACT); g.Bt = (const bf16_t*)(ws + WS_WDN) + (size_t)l * 1024 * DFF; g.lda = DFF; g.ldb = DFF; g.K = DFF;
        g.XN = xn_cur; g.rss_next = RSS + (size_t)(3 * l + 2) * MT * 16; g.gnext = PIN(I_NPLE) + (size_t)l * 1024; g.nM = 64; gemm_phase<EPI_P6>(lds, g); mini_gemm<EPI_P6>(lds, g); } break;
    default: { GINIT g.Bt = (const bf16_t*)(ws + WS_WPG) + (size_t)l * 1024 * 1024;
        g.rss = RSS + (size_t)(3 * l + 2) * MT * 16; g.rss_next = RSS + (size_t)(3 * l + 3) * MT * 16; g.gnext = l < 3 ? PIN(I_NMIX) + (size_t)(l + 1) * 1024 : PIN(I_FN);
        g.UPB = (const bf16_t*)(ws + WS_UP) + (size_t)l * MT * 1024; g.nM = 64; gemm_phase<EPI_P7>(lds, g); mini_gemm<EPI_P7>(lds, g); } break;
    }
#undef GINIT
}

__global__ void __launch_bounds__(NTHR, 2) hybrid_fwd(Params P) {
    extern __shared__ __attribute__((aligned(16))) uchar smem[];
    LAS uchar* lds = (LAS uchar*)smem;
    cg::grid_group grid = cg::this_grid();
    volatile LAS unsigned* st = (volatile LAS unsigned*)(lds + LDS_BYTES);
    if (threadIdx.x < 4) st[threadIdx.x] = 0u;
    __syncthreads();
    const XcdBarrier xbar = xcd_barrier_post((unsigned*)(P.ws + WS_BAR), st);
    for (int ph = P.ph_lo; ph < P.ph_hi; ++ph) {
        int nrep_ = 1;
#ifdef PROBE_REP
        { const int s_ = ph >= 2 && ph < 30 ? (ph - 2) % 7 : (ph == 0 ? 7 : (ph == 1 ? 8 : 9)); if ((PROBE_REP >> s_) & 1) nrep_ = 2; }
#endif
#pragma unroll 1
        for (int r_ = 0; r_ < nrep_; ++r_) { run_phase(lds, P, ph); __syncthreads(); }
        if (ph + 1 < P.ph_hi) {
            if (ph == P.ph_lo) {
                asm volatile("s_waitcnt vmcnt(0)" ::: "memory");
                __syncthreads();
                if (threadIdx.x < 64) { __builtin_amdgcn_fence(__ATOMIC_RELEASE, "agent"); asm volatile("s_waitcnt vmcnt(0)" ::: "memory"); }
                __syncthreads();
                grid.sync();
                if (threadIdx.x < 64) { __builtin_amdgcn_fence(__ATOMIC_ACQUIRE, "agent"); asm volatile("s_waitcnt vmcnt(0)" ::: "memory"); }
                __syncthreads();
            } else xcd_barrier(xbar);
        }
    }
}

extern "C" void kernel_launch(void* const* d_in, const int* in_sizes, int n_in, void* d_out, int out_size, void* d_ws, size_t ws_size, hipStream_t stream) {
    static int grid = 0;
    if (grid == 0) {
        if (n_in != 32 || (size_t)out_size != O_END || ws_size < WS_END) { fprintf(stderr, "kernel_launch: shape mismatch n_in %d out %d (want %zu) ws %zu (want %zu)\n", n_in, out_size, (size_t)O_END, ws_size, (size_t)WS_END); grid = -1; return; }
        int dev = 0, cus = 0, per_cu = 0;
        hipGetDevice(&dev); hipDeviceGetAttribute(&cus, hipDeviceAttributeMultiprocessorCount, dev);
        if (hipFuncSetAttribute((const void*)hybrid_fwd, hipFuncAttributeMaxDynamicSharedMemorySize, LDS_BYTES + 16) != hipSuccess) { fprintf(stderr, "kernel_launch: hipFuncSetAttribute failed\n"); grid = -1; return; }
        hipOccupancyMaxActiveBlocksPerMultiprocessor(&per_cu, (const void*)hybrid_fwd, NTHR, LDS_BYTES + 16);
        if (per_cu < 1) { fprintf(stderr, "kernel_launch: occupancy query says %d blocks per CU\n", per_cu); per_cu = 1; }
        grid = cus * 1;
        fprintf(stderr, "kernel_launch: cus %d per_cu %d grid %d\n", cus, per_cu, grid);
    }
    if (grid < 0) return;
    hipMemsetAsync((char*)d_ws + WS_BAR, 0, 16384, stream);
    Params p{};
    for (int i = 0; i < 32; ++i) p.in[i] = (const float*)d_in[i];
    p.out = (float*)d_out; p.ws = (uchar*)d_ws;
#if MULTI_LAUNCH
    for (int ph = 0; ph < 31; ++ph) { p.ph_lo = ph; p.ph_hi = ph + 1; hipLaunchKernelGGL(hybrid_fwd, dim3(grid), dim3(NTHR), LDS_BYTES + 16, stream, p); }
#else
    p.ph_lo = 0; p.ph_hi = 31;
    void* args[] = {&p};
    hipError_t e = hipLaunchCooperativeKernel((const void*)hybrid_fwd, dim3(grid), dim3(NTHR), args, LDS_BYTES + 16, stream);
    if (e != hipSuccess) fprintf(stderr, "cooperative launch failed: %s (grid %d)\n", hipGetErrorString(e), grid);
#endif
}
```

```cpp
#include <hip/hip_runtime.h>
#include <hip/hip_cooperative_groups.h>
#include <cstdio>
namespace cg = cooperative_groups;

#define LAS __attribute__((address_space(3)))
typedef unsigned short bf16_t;
typedef unsigned char uchar;
typedef short bf16x8 __attribute__((ext_vector_type(8)));
typedef float f32x4 __attribute__((ext_vector_type(4)));
typedef unsigned u32x4 __attribute__((ext_vector_type(4)));
typedef unsigned u32x2 __attribute__((ext_vector_type(2)));

#ifndef MULTI_LAUNCH
#define MULTI_LAUNCH 0
#endif

constexpr int MT = 17408, MPR = 16384, DM = 1024, NPROJ = 7168, NIN = 7424, DFF = 2816;
constexpr float EPS = 1e-6f;
constexpr int NTHR = 512;
constexpr int LDS_BYTES = 143360;
constexpr int C_Z = 0, C_XBC = 1024, C_U = 2560, C_V = 3072, C_POOL = 3584, C_GA = 4096, C_GB = 5120, C_GC = 6144;
constexpr size_t al256(size_t x) { return (x + 255) & ~(size_t)255; }
constexpr size_t WS_WIN = 0;
constexpr size_t WS_WBR = WS_WIN + (size_t)4 * NIN * 1024 * 2;
constexpr size_t WS_WOUT = WS_WBR + (size_t)4 * 1024 * 2048 * 2;
constexpr size_t WS_WGU = WS_WOUT + (size_t)4 * 1024 * 1024 * 2;
constexpr size_t WS_WDN = WS_WGU + (size_t)4 * 5632 * 1024 * 2;
constexpr size_t WS_WPG = WS_WDN + (size_t)4 * 1024 * 2816 * 2;
constexpr size_t WS_WPU = WS_WPG + (size_t)4 * 1024 * 1024 * 2;
constexpr size_t WS_X = WS_WPU + (size_t)4 * 1024 * 256 * 2;
constexpr size_t WS_XN = WS_X + (size_t)MT * 1024 * 4;
constexpr size_t WS_RSS = WS_XN + (size_t)MT * 1024 * 2;
constexpr size_t WS_PROJ = al256(WS_RSS + (size_t)13 * MT * 16 * 4);
constexpr size_t WS_DT = WS_PROJ + (size_t)MT * NPROJ * 2;
constexpr size_t WS_Y = WS_DT + (size_t)MT * 16 * 4;
constexpr size_t WS_SSQ = WS_Y + (size_t)MT * 2048 * 2;
constexpr size_t WS_MRG = WS_SSQ + (size_t)MT * 16 * 4;
constexpr size_t WS_ACT = WS_MRG + (size_t)MT * 1024 * 2;
constexpr size_t WS_UP = WS_ACT + (size_t)MT * DFF * 2;
constexpr size_t WS_PBF = WS_UP + (size_t)4 * MT * 1024 * 2;
constexpr size_t WS_XN2 = WS_PBF + (size_t)4 * MT * 256 * 2;
constexpr size_t WS_BAR = WS_XN2 + (size_t)MT * 1024 * 2;
constexpr size_t WS_CBC = WS_BAR + 16384;
constexpr size_t WS_END = WS_CBC + (size_t)MPR * 512 * 2;
constexpr size_t O_Y = 0;
constexpr size_t O_CONVP = (size_t)MT * 1024;
constexpr size_t O_SSMP = O_CONVP + (size_t)4 * 8 * 3 * 1536;
constexpr size_t O_POOLP = O_SSMP + (size_t)4 * 8 * 16 * 64 * 128;
constexpr size_t O_VP = O_POOLP + (size_t)4 * 8 * 15 * 512;
constexpr size_t O_CONVS = O_VP + (size_t)4 * 8 * 128 * 512;
constexpr size_t O_SSMS = O_CONVS + (size_t)4 * 128 * 3 * 1536;
constexpr size_t O_POOLS = O_SSMS + (size_t)4 * 128 * 16 * 64 * 128;
constexpr size_t O_VS = O_POOLS + (size_t)4 * 128 * 15 * 512;
constexpr size_t O_END = O_VS + (size_t)4 * 128 * 8 * 512;

struct Params {
    const float* in[32];
    float* out;
    uchar* ws;
    int ph_lo, ph_hi;
};
enum { I_XP = 0, I_XS, I_SCONV, I_SSSM, I_SPOOL, I_PP, I_PS, I_NMIX, I_WIN, I_CONVW, I_CONVB, I_DTB, I_ALOG, I_DSKIP, I_SSDN, I_LNG, I_LNB, I_WSP, I_BSP,
       I_POOLW, I_POOLS, I_WBRA, I_WBRB, I_WBRC, I_WOUT, I_NFFN, I_WGU, I_WDN, I_NPLE, I_WPG, I_WPU, I_FN };


__device__ __forceinline__ int launder_s(int i) { asm volatile("" : "+s"(i)); return i; }
__device__ __forceinline__ int launder_v(int i) { asm volatile("" : "+v"(i)); return i; }
template <class T> __device__ __forceinline__ T* launder_p(T* p) { asm volatile("" : "+s"(p)); return p; }
__device__ __forceinline__ size_t launder_z() { size_t z = 0; asm volatile("" : "+s"(z)); return z; }
typedef const float __attribute__((address_space(1)))* gcf_t;
#define PIN(i) ((const float*)(gcf_t)(P.in[launder_s(i)]))
#define TIDX launder_v((int)threadIdx.x)
#define BIDX launder_s((int)blockIdx.x)
#define GDIM launder_s((int)gridDim.x)
__device__ __forceinline__ unsigned cvt_pk_bf16(float lo, float hi) { unsigned r; asm("v_cvt_pk_bf16_f32 %0, %1, %2" : "=v"(r) : "v"(lo), "v"(hi)); return r; }
__device__ __forceinline__ float bf_lo(unsigned w) { return __uint_as_float(w << 16); }
__device__ __forceinline__ float bf_hi(unsigned w) { return __uint_as_float(w & 0xffff0000u); }
__device__ __forceinline__ float bf1(bf16_t b) { return __uint_as_float(((unsigned)b) << 16); }
__device__ __forceinline__ float frcp(float x) { return __builtin_amdgcn_rcpf(x); }
__device__ __forceinline__ float sigmoidf_(float x) { return frcp(1.0f + __expf(-x)); }
__device__ __forceinline__ float siluf_(float x) { return x * sigmoidf_(x); }
__device__ __forceinline__ float gelu_tanh(float x) { const float u = 1.5957691216057308f * (x + 0.044715f * x * x * x); return x * sigmoidf_(u); }
__device__ __forceinline__ float softplusf_(float x) {
    const float e = __expf(-fabsf(x));
    const float l = e < 0.03f ? e * (1.0f - e * (0.5f - e * (0.33333334f - e * 0.25f))) : __logf(1.0f + e);
    return fmaxf(x, 0.f) + l;
}
__device__ __forceinline__ float shx(float v, int m) { return __shfl_xor(v, m, 64); }

__device__ __forceinline__ float rownorm(const float* rssp, int row) {
    const f32x4 a = *(const f32x4*)(rssp + (size_t)row * 16), b = *(const f32x4*)(rssp + (size_t)row * 16 + 4), c = *(const f32x4*)(rssp + (size_t)row * 16 + 8), d = *(const f32x4*)(rssp + (size_t)row * 16 + 12);
    const float s = ((a[0] + a[1]) + (a[2] + a[3])) + ((b[0] + b[1]) + (b[2] + b[3])) + ((c[0] + c[1]) + (c[2] + c[3])) + ((d[0] + d[1]) + (d[2] + d[3]));
    return rsqrtf(s * (1.0f / 1024.0f) + EPS);
}
constexpr int BM = 256, BK = 64, HALF = 128, HTB = HALF * BK * 2, NXCD = 8, WGM = 8;
__device__ __forceinline__ int lds_byte(int r, int c) { const int st = (r >> 4) * 2 + (c >> 5), rr = r & 15, cc = c & 31, ob = rr * 64 + cc * 2; return st * 1024 + (ob ^ (((ob >> 9) & 1) << 5)); }
__device__ __forceinline__ void stage_rc(int b, int& R, int& C) { const int st = b / 1024, sb = b % 1024, swz = sb ^ (((sb >> 9) & 1) << 5); R = (st >> 1) * 16 + swz / 64; C = (st & 1) * 32 + (swz % 64) / 2; }

struct Unit { int pm, pn, seg, lay; };
enum { EPI_UP = 0, EPI_P1, EPI_P3, EPI_P4, EPI_P5, EPI_P6, EPI_P7 };

struct GPh {
    const bf16_t* A; const bf16_t* Bt; int lda, ldb, K, nM, nN, nseg, nlay; size_t a_lay, b_lay;
    int G, c;
    const float* rss; float* rss_next; const float* gnext; float* X; bf16_t* XN; bf16_t* O; float* DT; const bf16_t* PROJ; const float* SSQ; const bf16_t* UPB;
    __device__ __forceinline__ bool next(int i, Unit& u) const {
        const int tiles = nM * nN; const long L = (long)(i / nseg) * G + c; if (L >= (long)tiles * nlay) return false;
        u.seg = i % nseg; u.lay = (int)(L / tiles); int wgid = (int)(L % tiles);
        { const int q = tiles / NXCD, r = tiles % NXCD, xcd = wgid % NXCD, off = wgid / NXCD; wgid = (xcd < r ? xcd * (q + 1) : r * (q + 1) + (xcd - r) * q) + off; }
        const int nig = WGM * nN, gid = wgid / nig, fm = gid * WGM, gsz = (nM - fm) < WGM ? (nM - fm) : WGM;
        u.pm = fm + ((wgid % nig) % gsz); u.pn = (wgid % nig) / gsz; return true;
    }
    __device__ __forceinline__ const char* pa(const Unit& u) const { return (const char*)(A + u.lay * a_lay + (size_t)u.pm * BM * lda + (size_t)u.seg * K); }
    __device__ __forceinline__ const char* pb(const Unit& u) const { return (const char*)(Bt + u.lay * b_lay + (size_t)u.pn * BM * ldb + (size_t)u.seg * K); }
};

__device__ __forceinline__ void p3_rowscale(const GPh& P, const int row, const int seg, float& rs0, float& rs1) {
    rs0 = 1.f; rs1 = 1.f;
    if (seg < 2) { const f32x4 a0 = *(const f32x4*)(P.SSQ + (size_t)row * 16), a1 = *(const f32x4*)(P.SSQ + (size_t)row * 16 + 4), b0 = *(const f32x4*)(P.SSQ + (size_t)row * 16 + 8), b1 = *(const f32x4*)(P.SSQ + (size_t)row * 16 + 12);
        rs0 = rsqrtf((a0[0] + a0[1] + a0[2] + a0[3] + a1[0] + a1[1] + a1[2] + a1[3]) * (1.0f / 512.0f) + EPS);
        rs1 = rsqrtf((b0[0] + b0[1] + b0[2] + b0[3] + b1[0] + b1[1] + b1[2] + b1[3]) * (1.0f / 512.0f) + EPS); }
}
__device__ __forceinline__ void p3_elem(const GPh& P, f32x4& v, const int row, const int col, const int seg, const float rs0, const float rs1) {
    const bf16_t* prow = P.PROJ + (size_t)row * NPROJ;
    if (seg == 0) { v = v * (rs0 * frcp(rs1)); }
    else if (seg == 1) { const u32x2 ga = *(const u32x2*)(prow + C_GA + col), gb = *(const u32x2*)(prow + C_GB + col);
        v[0] *= rs1 * bf_lo(ga.x) * frcp(bf_lo(gb.x)); v[1] *= rs1 * bf_hi(ga.x) * frcp(bf_hi(gb.x)); v[2] *= rs1 * bf_lo(ga.y) * frcp(bf_lo(gb.y)); v[3] *= rs1 * bf_hi(ga.y) * frcp(bf_hi(gb.y)); }
    else if (seg == 2) { const u32x2 ga = *(const u32x2*)(prow + C_GB + col), gb = *(const u32x2*)(prow + C_GC + col);
        v[0] *= bf_lo(ga.x) * frcp(bf_lo(gb.x)); v[1] *= bf_hi(ga.x) * frcp(bf_hi(gb.x)); v[2] *= bf_lo(ga.y) * frcp(bf_lo(gb.y)); v[3] *= bf_hi(ga.y) * frcp(bf_hi(gb.y)); }
    else { const u32x2 gc = *(const u32x2*)(prow + C_GC + col);
        u32x2 o; o.x = cvt_pk_bf16(v[0] * bf_lo(gc.x), v[1] * bf_hi(gc.x)); o.y = cvt_pk_bf16(v[2] * bf_lo(gc.y), v[3] * bf_hi(gc.y)); *(u32x2*)(P.O + (size_t)row * 1024 + col) = o; }
}
template <int EPI>
__device__ __forceinline__ void epi_row(const GPh& P, f32x4 (&a)[2][2], const int row, const int col0, const int pn, const int wc, const int fq, const int seg, const int lay) {
    if constexpr (EPI == EPI_UP) {
        bf16_t* O = P.O + (size_t)lay * MT * 1024;
#pragma unroll
        for (int bj = 0; bj < 2; ++bj)
#pragma unroll
            for (int n = 0; n < 2; ++n) { const int col = col0 + bj * HALF + n * 16; const f32x4 v = a[bj][n];
                u32x2 o; o.x = cvt_pk_bf16(v[0], v[1]); o.y = cvt_pk_bf16(v[2], v[3]); *(u32x2*)(O + (size_t)row * 1024 + col) = o; }
    } else if constexpr (EPI == EPI_P1) {
        const float r = rownorm(P.rss, row);
#pragma unroll
        for (int bj = 0; bj < 2; ++bj)
#pragma unroll
            for (int n = 0; n < 2; ++n) { const int col = col0 + bj * HALF + n * 16; f32x4 v = a[bj][n] * r;
                if (pn == 28) { if (col - NPROJ < 16) *(f32x4*)(P.DT + (size_t)row * 16 + (col - NPROJ)) = v; }
                else {
                    if (pn >= 10 && pn < 14) { v[0] = gelu_tanh(v[0]); v[1] = gelu_tanh(v[1]); v[2] = gelu_tanh(v[2]); v[3] = gelu_tanh(v[3]); }
                    else if (pn >= 16) { v[0] = sigmoidf_(v[0]); v[1] = sigmoidf_(v[1]); v[2] = sigmoidf_(v[2]); v[3] = sigmoidf_(v[3]); }
                    u32x2 o; o.x = cvt_pk_bf16(v[0], v[1]); o.y = cvt_pk_bf16(v[2], v[3]); *(u32x2*)(P.O + (size_t)row * NPROJ + col) = o; } }
    } else if constexpr (EPI == EPI_P3) {
        float rs0, rs1; p3_rowscale(P, row, seg, rs0, rs1);
#pragma unroll
        for (int bj = 0; bj < 2; ++bj)
#pragma unroll
            for (int n = 0; n < 2; ++n) p3_elem(P, a[bj][n], row, col0 + bj * HALF + n * 16, seg, rs0, rs1);
    } else if constexpr (EPI == EPI_P5) {
        const float r = rownorm(P.rss, row);
#pragma unroll
        for (int bj = 0; bj < 2; ++bj) { const f32x4 g = a[bj][0] * r, uu = a[bj][1] * r;
            const int ocol = 16 * (8 * pn + 4 * bj + wc) + 4 * fq;
            u32x2 o; o.x = cvt_pk_bf16(siluf_(g[0]) * uu[0], siluf_(g[1]) * uu[1]); o.y = cvt_pk_bf16(siluf_(g[2]) * uu[2], siluf_(g[3]) * uu[3]);
            *(u32x2*)(P.O + (size_t)row * DFF + ocol) = o; }
    } else {
        float ss = 0.f; float r7 = 0.f;
        if constexpr (EPI == EPI_P7) r7 = rownorm(P.rss, row);
#pragma unroll
        for (int bj = 0; bj < 2; ++bj)
#pragma unroll
            for (int n = 0; n < 2; ++n) { const int col = col0 + bj * HALF + n * 16; const f32x4 v = a[bj][n];
                f32x4 xv = *(const f32x4*)(P.X + (size_t)row * 1024 + col);
                if constexpr (EPI == EPI_P7) { const u32x2 up = *(const u32x2*)(P.UPB + (size_t)row * 1024 + col);
                    xv[0] += bf_lo(up.x) * sigmoidf_(v[0] * r7); xv[1] += bf_hi(up.x) * sigmoidf_(v[1] * r7); xv[2] += bf_lo(up.y) * sigmoidf_(v[2] * r7); xv[3] += bf_hi(up.y) * sigmoidf_(v[3] * r7); }
                else xv += v;
                *(f32x4*)(P.X + (size_t)row * 1024 + col) = xv;
                ss += xv[0] * xv[0] + xv[1] * xv[1] + xv[2] * xv[2] + xv[3] * xv[3];
                const f32x4 gn = *(const f32x4*)(P.gnext + col);
                u32x2 o; o.x = cvt_pk_bf16(xv[0] * gn[0], xv[1] * gn[1]); o.y = cvt_pk_bf16(xv[2] * gn[2], xv[3] * gn[3]); *(u32x2*)(P.XN + (size_t)row * 1024 + col) = o; }
        ss += shx(ss, 16); ss += shx(ss, 32);
        if (fq == 0) P.rss_next[(size_t)row * 16 + pn * 4 + wc] = ss;
    }
}
template <int EPI>
__device__ __forceinline__ void epilogue(const GPh& P, f32x4 (&acc)[2][2][4][2], const Unit& u, int, int, int, int) {
    const int tid_ = TIDX, wid_ = tid_ >> 6, wr = wid_ >> 2, wc = wid_ & 3, fr = tid_ & 15, fq = (tid_ >> 4) & 3;
    const int row0 = u.pm * BM + wr * 64 + fr, col0 = u.pn * BM + wc * 32 + 4 * fq;
#pragma unroll
    for (int ai = 0; ai < 2; ++ai)
#pragma unroll
        for (int m = 0; m < 4; ++m) {
            const int row = row0 + ai * HALF + m * 16;
            if constexpr (EPI == EPI_P3) {
                float rs0, rs1; p3_rowscale(P, row, u.seg, rs0, rs1);
#pragma unroll
                for (int bj = 0; bj < 2; ++bj)
#pragma unroll
                    for (int n = 0; n < 2; ++n) p3_elem(P, acc[ai][bj][m][n], row, col0 + bj * HALF + n * 16, u.seg, rs0, rs1);
            } else {
                f32x4 a[2][2] = {{acc[ai][0][m][0], acc[ai][0][m][1]}, {acc[ai][1][m][0], acc[ai][1][m][1]}};
                epi_row<EPI>(P, a, row, col0, u.pn, wc, fq, u.seg, u.lay);
            }
        }
}

template <int EPI>
__device__ __forceinline__ void mini_gemm(LAS uchar* lds, const GPh& P) {
    const int tid = TIDX, wid = tid >> 6, lane = tid & 63, kh = wid >> 2, wc = wid & 3, fr = lane & 15, fq = lane >> 4;
    const int nseg = P.nseg, K = P.K, Kh = K >> 1;
    for (int su = P.c; su < 256; su += P.G) {
        const int strip = su >> 2, pn = su & 3; const int row = MPR + strip * 16 + fr;
        const bf16_t* Ap = P.A + (size_t)row * P.lda + fq * 8;
        const bf16_t* Bp = P.Bt + (size_t)(pn * 256 + wc * 32 + fr) * P.ldb + fq * 8;
        f32x4 a[2][2];
#pragma unroll
        for (int bj = 0; bj < 2; ++bj)
#pragma unroll
            for (int n = 0; n < 2; ++n) a[bj][n] = (f32x4){0.f, 0.f, 0.f, 0.f};
        __syncthreads();
        for (int seg = 0; seg < nseg; ++seg) {
            const int kbeg = seg * K + kh * Kh;
#pragma unroll 1
            for (int k0 = kbeg; k0 < kbeg + Kh; k0 += 128) {
                bf16x8 af[4], bfr[4][2][2];
#pragma unroll
                for (int s = 0; s < 4; ++s) { af[s] = *(const bf16x8*)(Ap + k0 + s * 32);
#pragma unroll
                    for (int bj = 0; bj < 2; ++bj)
#pragma unroll
                        for (int n = 0; n < 2; ++n) bfr[s][bj][n] = *(const bf16x8*)(Bp + (size_t)(bj * HALF + n * 16) * P.ldb + k0 + s * 32); }
#pragma unroll
                for (int s = 0; s < 4; ++s)
#pragma unroll
                    for (int bj = 0; bj < 2; ++bj)
#pragma unroll
                        for (int n = 0; n < 2; ++n) a[bj][n] = __builtin_amdgcn_mfma_f32_16x16x32_bf16(bfr[s][bj][n], af[s], a[bj][n], 0, 0, 0);
            }
            if (EPI == EPI_P3 && seg < 3) epi_row<EPI>(P, a, row, pn * 256 + wc * 32 + 4 * fq, pn, wc, fq, seg, 0);
        }
        LAS f32x4* xch = (LAS f32x4*)lds;
        if (kh == 1) {
#pragma unroll
            for (int bj = 0; bj < 2; ++bj)
#pragma unroll
                for (int n = 0; n < 2; ++n) xch[((wc * 4 + bj * 2 + n) * 64) + lane] = a[bj][n];
        }
        __syncthreads();
        if (kh == 0) {
#pragma unroll
            for (int bj = 0; bj < 2; ++bj)
#pragma unroll
                for (int n = 0; n < 2; ++n) a[bj][n] += xch[((wc * 4 + bj * 2 + n) * 64) + lane];
            epi_row<EPI>(P, a, row, pn * 256 + wc * 32 + 4 * fq, pn, wc, fq, nseg - 1, 0);
        }
    }
}

template <int EPI>
__device__ __forceinline__ void gemm_phase(LAS uchar* lds, const GPh& P) {
    const int tid = TIDX, wid = __builtin_amdgcn_readfirstlane(tid >> 6), lane = tid & 63, wr = wid >> 2, wc = wid & 3, fr = lane & 15, fq = lane >> 4;
    const int K = P.K, nt = K / BK;
    unsigned voffA[2], voffB[2];
#pragma unroll
    for (int i = 0; i < 2; ++i) { int R, C; stage_rc(tid * 16 + i * 8192, R, C); voffA[i] = (unsigned)(R * P.lda + C) * 2u; voffB[i] = (unsigned)(R * P.ldb + C) * 2u; }
    const size_t kstep = (size_t)(BK * 2);
    const size_t hstepA = (size_t)HALF * P.lda * 2, hstepB = (size_t)HALF * P.ldb * 2;
    const unsigned ldsw = (unsigned)wid * 1024u;
    const int aoff = lds_byte(wr * 64 + fr, fq * 8), boff = lds_byte(wc * 32 + fr, fq * 8);
#define PG8_SA(b, h) (((b) * 2 + (h)) * HTB)
#define PG8_SB(b, h) ((4 + (b) * 2 + (h)) * HTB)
#define PG8_STAGE(bufoff, gbase, voff) do { _Pragma("unroll") for (int _i = 0; _i < 2; ++_i) \
        __builtin_amdgcn_global_load_lds((const unsigned*)((const char*)(gbase) + (voff)[_i]), (LAS unsigned*)(lds + (bufoff) + ldsw + _i * 8192), 16, 0, 0); } while (0)
#define PG8_LDA(dst, b, h) do { _Pragma("unroll") for (int m = 0; m < 4; ++m) _Pragma("unroll") for (int k = 0; k < 2; ++k) dst[m][k] = *(const LAS bf16x8*)(lds + PG8_SA(b, h) + aoff + m * 2048 + k * 1024); } while (0)
#define PG8_LDB(dst, b, h) do { _Pragma("unroll") for (int n = 0; n < 2; ++n) _Pragma("unroll") for (int k = 0; k < 2; ++k) dst[n][k] = *(const LAS bf16x8*)(lds + PG8_SB(b, h) + boff + n * 2048 + k * 1024); } while (0)
#define PG8_MMA(ai, bj, At, Bt) do { __builtin_amdgcn_s_setprio(1); _Pragma("unroll") for (int m = 0; m < 4; ++m) _Pragma("unroll") for (int n = 0; n < 2; ++n) _Pragma("unroll") for (int k = 0; k < 2; ++k) \
        acc[ai][bj][m][n] = __builtin_amdgcn_mfma_f32_16x16x32_bf16(Bt[n][k], At[m][k], acc[ai][bj][m][n], 0, 0, 0); __builtin_amdgcn_s_setprio(0); } while (0)
#define PG8_WAIT_V(n) asm volatile("s_waitcnt vmcnt(" #n ")" ::: "memory")
#define PG8_WAIT_L(n) asm volatile("s_waitcnt lgkmcnt(" #n ")" ::: "memory")
#define PG8_BAR __builtin_amdgcn_s_barrier()
#define PG8_SCHED __builtin_amdgcn_sched_barrier(0)
    Unit cur, nxt; int ui = 0;
    if (!P.next(0, cur)) return;
    f32x4 acc[2][2][4][2];
#pragma unroll
    for (int a = 0; a < 2; ++a)
#pragma unroll
        for (int b = 0; b < 2; ++b)
#pragma unroll
            for (int m = 0; m < 4; ++m)
#pragma unroll
                for (int n = 0; n < 2; ++n) acc[a][b][m][n] = (f32x4){0.f, 0.f, 0.f, 0.f};
    bf16x8 At[4][2], B0[2][2], B1[2][2];
    const char* cA = P.pa(cur); const char* cB = P.pb(cur);
    PG8_STAGE(PG8_SB(0, 0), cB, voffB); PG8_STAGE(PG8_SA(0, 0), cA, voffA); PG8_STAGE(PG8_SB(0, 1), cB + hstepB, voffB); PG8_STAGE(PG8_SA(0, 1), cA + hstepA, voffA);
    if (wr == 1) PG8_BAR;
    PG8_WAIT_V(4); PG8_BAR;
    PG8_STAGE(PG8_SB(1, 0), cB + kstep, voffB); PG8_STAGE(PG8_SA(1, 0), cA + kstep, voffA); PG8_STAGE(PG8_SB(1, 1), cB + hstepB + kstep, voffB);
    PG8_WAIT_V(6); PG8_BAR;
    for (;;) {
        const bool has_next = P.next(ui + 1, nxt);
        const char* nA = has_next ? P.pa(nxt) : cA; const char* nB = has_next ? P.pb(nxt) : cB;
        for (int t = 0; t < nt; t += 2) {
            const bool last = (t == nt - 2);
            const char* a1 = cA + (size_t)(t + 1) * kstep;
            const char* a2 = last ? nA : cA + (size_t)(t + 2) * kstep; const char* b2 = last ? nB : cB + (size_t)(t + 2) * kstep;
            const char* a3 = a2 + kstep; const char* b3 = b2 + kstep;
            PG8_LDB(B0, 0, 0); PG8_SCHED; PG8_LDA(At, 0, 0); PG8_STAGE(PG8_SA(1, 1), a1 + hstepA, voffA);
            PG8_WAIT_L(8); PG8_BAR; PG8_WAIT_L(0); PG8_MMA(0, 0, At, B0); PG8_BAR; PG8_SCHED;
            PG8_LDB(B1, 0, 1); PG8_STAGE(PG8_SB(0, 0), b2, voffB);
            PG8_BAR; PG8_WAIT_L(0); PG8_MMA(0, 1, At, B1); PG8_BAR;
            PG8_LDA(At, 0, 1); PG8_STAGE(PG8_SA(0, 0), a2, voffA);
            PG8_BAR; PG8_WAIT_L(0); PG8_MMA(1, 0, At, B0); PG8_BAR; PG8_SCHED;
            PG8_STAGE(PG8_SB(0, 1), b2 + hstepB, voffB);
            PG8_WAIT_V(6); PG8_BAR; PG8_MMA(1, 1, At, B1); PG8_BAR;
            PG8_LDB(B0, 1, 0); PG8_SCHED; PG8_LDA(At, 1, 0); PG8_STAGE(PG8_SA(0, 1), a2 + hstepA, voffA);
            PG8_WAIT_L(8); PG8_BAR; PG8_WAIT_L(0); PG8_MMA(0, 0, At, B0); PG8_BAR; PG8_SCHED;
            PG8_LDB(B1, 1, 1); PG8_STAGE(PG8_SB(1, 0), b3, voffB);
            PG8_BAR; PG8_WAIT_L(0); PG8_MMA(0, 1, At, B1); PG8_BAR;
            PG8_LDA(At, 1, 1); PG8_STAGE(PG8_SA(1, 0), a3, voffA);
            PG8_BAR; PG8_WAIT_L(0); PG8_MMA(1, 0, At, B0); PG8_BAR; PG8_SCHED;
            PG8_STAGE(PG8_SB(1, 1), b3 + hstepB, voffB);
            PG8_WAIT_V(6); PG8_BAR; PG8_MMA(1, 1, At, B1); PG8_BAR;
        }
        epilogue<EPI>(P, acc, cur, wr, wc, fr, fq);
        if (!has_next) break;
        if (EPI != EPI_P3 || cur.seg == 3) {
#pragma unroll
            for (int a = 0; a < 2; ++a)
#pragma unroll
                for (int b = 0; b < 2; ++b)
#pragma unroll
                    for (int m = 0; m < 4; ++m)
#pragma unroll
                        for (int n = 0; n < 2; ++n) acc[a][b][m][n] = (f32x4){0.f, 0.f, 0.f, 0.f};
        }
        cur = nxt; cA = nA; cB = nB; ++ui;
    }
    PG8_WAIT_V(0);
    if (wr == 0) PG8_BAR;
    PG8_BAR;
#undef PG8_SA
#undef PG8_SB
#undef PG8_STAGE
#undef PG8_LDA
#undef PG8_LDB
#undef PG8_MMA
#undef PG8_WAIT_V
#undef PG8_WAIT_L
#undef PG8_BAR
#undef PG8_SCHED
}

template <int NT, int KS>
__device__ __forceinline__ void wmma(const LAS uchar* A, const LAS uchar* B, int pitch, f32x4 (&acc)[NT], int fr, int fq) {
#pragma unroll 1
    for (int ks = 0; ks < KS; ++ks) {
        const bf16x8 a = *(const LAS bf16x8*)(A + fr * pitch + (ks * 32 + fq * 8) * 2);
#pragma unroll
        for (int ni = 0; ni < NT; ++ni) {
            const bf16x8 b = *(const LAS bf16x8*)(B + (ni * 16 + fr) * pitch + (ks * 32 + fq * 8) * 2);
            acc[ni] = __builtin_amdgcn_mfma_f32_16x16x32_bf16(b, a, acc[ni], 0, 0, 0);
        }
    }
}
constexpr int PB = 272;

__device__ __forceinline__ int map_row(int n, int map) {
    if (map == 1) return n < 2560 ? n : (n < 2576 ? 7168 + (n - 2560) : n - 16);
    if (map == 2) { const int up = n >= DFF, nn = up ? n - DFF : n; return 32 * (nn >> 4) + 16 * up + (nn & 15); }
    return n;
}
__device__ __forceinline__ void tr_tile(LAS float* T, const float* src, int N, bf16_t* dst, int ldd, int dcol0, int k0, int n0, int map) {
    const int tid = TIDX;
    __syncthreads();
#pragma unroll
    for (int ps = 0; ps < 2; ++ps) { const int r = ps * 32 + (tid >> 4), c4 = (tid & 15) * 4; const int n = n0 + c4;
        f32x4 v = (f32x4){0.f, 0.f, 0.f, 0.f}; if (n < N) v = *(const f32x4*)(src + (size_t)(k0 + r) * N + n);
        T[r * 65 + c4 + 0] = v[0]; T[r * 65 + c4 + 1] = v[1]; T[r * 65 + c4 + 2] = v[2]; T[r * 65 + c4 + 3] = v[3]; }
    __syncthreads();
    { const int n = tid >> 3, k8 = (tid & 7) * 8;
        if (n0 + n < N) { u32x4 o; float f[8];
#pragma unroll
            for (int j = 0; j < 8; ++j) f[j] = T[(k8 + j) * 65 + n];
            o.x = cvt_pk_bf16(f[0], f[1]); o.y = cvt_pk_bf16(f[2], f[3]); o.z = cvt_pk_bf16(f[4], f[5]); o.w = cvt_pk_bf16(f[6], f[7]);
            *(u32x4*)(dst + (size_t)map_row(n0 + n, map) * ldd + dcol0 + k0 + k8) = o; } }
}

__device__ __forceinline__ void phase_pre(LAS uchar* lds, const Params& P) {
    const int tid = TIDX, G = GDIM, bid = BIDX;
    uchar* ws = (P.ws + launder_z());
    LAS float* T = (LAS float*)lds;
    constexpr int T_IN = 16 * 113, T_BRA = 256, T_BRB = 128, T_OUT = 256, T_GU = 16 * 88, T_DN = 44 * 16, T_PG = 256, T_PU = 64;
    constexpr int T_L = T_IN + T_BRA + T_BRB + T_OUT + T_GU + T_DN + T_PG + T_PU;
    for (int job = bid; job < 4 * T_L; job += G) {
        const int l = job / T_L; int j = job % T_L;
        if (j < T_IN) { tr_tile(T, PIN(I_WIN) + (size_t)l * 1024 * 7184, 7184, (bf16_t*)(ws + WS_WIN) + (size_t)l * NIN * 1024, 1024, 0, (j / 113) * 64, (j % 113) * 64, 1); continue; } j -= T_IN;
        if (j < T_BRA) { tr_tile(T, PIN(I_WBRA) + (size_t)l * 1024 * 1024, 1024, (bf16_t*)(ws + WS_WBR) + (size_t)l * 1024 * 2048, 2048, 0, (j / 16) * 64, (j % 16) * 64, 0); continue; } j -= T_BRA;
        if (j < T_BRB) { tr_tile(T, PIN(I_WBRB) + (size_t)l * 512 * 1024, 1024, (bf16_t*)(ws + WS_WBR) + (size_t)l * 1024 * 2048, 2048, 1024, (j / 16) * 64, (j % 16) * 64, 0); continue; } j -= T_BRB;
        if (j < T_OUT) { tr_tile(T, PIN(I_WOUT) + (size_t)l * 1024 * 1024, 1024, (bf16_t*)(ws + WS_WOUT) + (size_t)l * 1024 * 1024, 1024, 0, (j / 16) * 64, (j % 16) * 64, 0); continue; } j -= T_OUT;
        if (j < T_GU) { tr_tile(T, PIN(I_WGU) + (size_t)l * 1024 * 5632, 5632, (bf16_t*)(ws + WS_WGU) + (size_t)l * 5632 * 1024, 1024, 0, (j / 88) * 64, (j % 88) * 64, 2); continue; } j -= T_GU;
        if (j < T_DN) { tr_tile(T, PIN(I_WDN) + (size_t)l * DFF * 1024, 1024, (bf16_t*)(ws + WS_WDN) + (size_t)l * 1024 * DFF, DFF, 0, (j / 16) * 64, (j % 16) * 64, 0); continue; } j -= T_DN;
        if (j < T_PG) { tr_tile(T, PIN(I_WPG) + (size_t)l * 1024 * 1024, 1024, (bf16_t*)(ws + WS_WPG) + (size_t)l * 1024 * 1024, 1024, 0, (j / 16) * 64, (j % 16) * 64, 0); continue; } j -= T_PG;
        tr_tile(T, PIN(I_WPU) + (size_t)l * 256 * 1024, 1024, (bf16_t*)(ws + WS_WPU) + (size_t)l * 1024 * 256, 256, 0, (j / 16) * 64, (j % 16) * 64, 0);
    }
    {
        LAS float* PW = (LAS float*)lds;
        LAS float* WC = (LAS float*)(lds + 128 * 129 * 4);
        for (int job = bid; job < 4 * 4 * 16; job += G) {
            const int l = job >> 6, g = (job >> 4) & 3, n0 = (job & 15) * 64;
            __syncthreads();
            for (int e = tid; e < 128 * 128; e += NTHR) { const int c = e >> 7, d = e & 127; PW[c * 129 + d] = PIN(I_POOLW)[((size_t)(l * 4 + g) * 128 + c) * 128 + d] * PIN(I_POOLS)[l * 512 + g * 128 + d]; }
            for (int e = tid; e < 128 * 64; e += NTHR) { const int d = e >> 6, n = e & 63; WC[d * 64 + n] = PIN(I_WBRC)[((size_t)l * 512 + g * 128 + d) * 1024 + n0 + n]; }
            __syncthreads();
            const int c = tid & 127, nq = (tid >> 7) * 16;
            float a[16];
#pragma unroll
            for (int i = 0; i < 16; ++i) a[i] = 0.f;
            for (int d = 0; d < 128; ++d) { const float pw = PW[c * 129 + d];
#pragma unroll
                for (int i = 0; i < 16; ++i) a[i] += pw * WC[d * 64 + nq + i]; }
            bf16_t* dst = (bf16_t*)(ws + WS_WBR) + (size_t)l * 1024 * 2048;
#pragma unroll
            for (int i = 0; i < 16; ++i) dst[(size_t)(n0 + nq + i) * 2048 + 1536 + g * 128 + c] = (bf16_t)(cvt_pk_bf16(a[i], 0.f) & 0xffffu);
        }
    }
    {
        const int lane = tid & 63, wv = tid >> 6;
        float* X = (float*)(ws + WS_X); bf16_t* XN = (bf16_t*)(ws + WS_XN); float* RSS = (float*)(ws + WS_RSS);
        const float* g0 = PIN(I_NMIX);
        for (int row = bid * 8 + wv; row < MT; row += G * 8) {
            const float* src = row < MPR ? PIN(I_XP) + (size_t)row * 1024 : PIN(I_XS) + (size_t)(row - MPR) * 1024;
            float ss = 0.f;
#pragma unroll
            for (int i = 0; i < 4; ++i) { const int col = i * 256 + lane * 4; const f32x4 v = *(const f32x4*)(src + col); const f32x4 gg = *(const f32x4*)(g0 + col);
                *(f32x4*)(X + (size_t)row * 1024 + col) = v; ss += v[0] * v[0] + v[1] * v[1] + v[2] * v[2] + v[3] * v[3];
                u32x2 o; o.x = cvt_pk_bf16(v[0] * gg[0], v[1] * gg[1]); o.y = cvt_pk_bf16(v[2] * gg[2], v[3] * gg[3]); *(u32x2*)(XN + (size_t)row * 1024 + col) = o; }
#pragma unroll
            for (int s = 1; s < 64; s <<= 1) ss += shx(ss, s);
            if (lane < 16) RSS[(size_t)row * 16 + lane] = lane == 0 ? ss : 0.f;
        }
    }
    {
        bf16_t* PBF = (bf16_t*)(ws + WS_PBF);
        const size_t n4 = (size_t)4 * MT * 256 / 4;
        for (size_t i = (size_t)bid * NTHR + tid; i < n4; i += (size_t)G * NTHR) {
            const size_t e = i * 4; const int l = (int)(e / ((size_t)MT * 256)); const size_t rem = e % ((size_t)MT * 256); const int row = (int)(rem >> 8), col = (int)(rem & 255);
            const float* src = row < MPR ? PIN(I_PP) + ((size_t)l * MPR + row) * 256 + col : PIN(I_PS) + ((size_t)l * 1024 + (row - MPR)) * 256 + col;
            const f32x4 v = *(const f32x4*)src; u32x2 o; o.x = cvt_pk_bf16(v[0], v[1]); o.y = cvt_pk_bf16(v[2], v[3]); *(u32x2*)(PBF + e) = o;
        }
    }
}

constexpr int L_CS = 0, L_BS = 34816, L_BDT = 69632, L_XT = 104448, L_SB = 121856, L_SC = 139264;
__device__ __forceinline__ int xbc_chan(int cc, int h, int g) { return cc < 64 ? h * 64 + cc : (cc < 192 ? 1024 + g * 128 + (cc - 64) : 1280 + g * 128 + (cc - 192)); }

__device__ __forceinline__ void ssd_prompt(LAS uchar* lds, const Params& P, int l, int b, int h) {
    const int tid = TIDX, lane = tid & 63, w = tid >> 6, fr = lane & 15, fq = lane >> 4, g = h >> 3;
    const bf16_t* PROJ = (const bf16_t*)((P.ws + launder_z()) + WS_PROJ); const float* DT = (const float*)((P.ws + launder_z()) + WS_DT);
    bf16_t* Y = (bf16_t*)((P.ws + launder_z()) + WS_Y); float* SSQ = (float*)((P.ws + launder_z()) + WS_SSQ);
    const float a_h = -__expf(PIN(I_ALOG)[l * 16 + h]), dtb = PIN(I_DTB)[l * 16 + h], Dh = PIN(I_DSKIP)[l * 16 + h];
    f32x4 S[4];
#pragma unroll
    for (int i = 0; i < 4; ++i) S[i] = (f32x4){0.f, 0.f, 0.f, 0.f};
    const int wu = __builtin_amdgcn_readfirstlane(w);
    const bf16_t* xsrc = PROJ + (size_t)(b * 2048) * NPROJ + C_XBC;
    const float* cwp = PIN(I_CONVW) + (size_t)l * 4 * 1536; const float* cbp = PIN(I_CONVB) + (size_t)l * 1536;
    const bf16_t* CBC = (const bf16_t*)((P.ws + launder_z()) + WS_CBC);
    float dN0 = 0.f, dN1 = 0.f;
#define SSD_LD1(cc, i, dst) do { if ((i) == 0) { const int ch_ = h * 64 + wu * 8; \
            _Pragma("unroll") for (int k = 0; k < 5; ++k) { const int pos = (cc) * 128 + 2 * lane - 3 + k; \
                dst[k] = (u32x4){0u, 0u, 0u, 0u}; if (pos >= 0) dst[k] = *(const u32x4*)(xsrc + (size_t)pos * NPROJ + ch_); } } \
        else { const int cgx_ = 8 * (i) + wu; const int col_ = cgx_ < 24 ? g * 128 + (cgx_ - 8) * 8 : 256 + g * 128 + (cgx_ - 24) * 8; \
            const bf16_t* cs_ = CBC + ((size_t)b * 2048 + (cc) * 128 + 2 * lane) * 512 + col_; dst[0] = *(const u32x4*)cs_; dst[1] = *(const u32x4*)(cs_ + 512); } } while (0)
#define SSD_DTLOAD(cc) do { if (w == 0) { dN0 = DT[(size_t)(b * 2048 + (cc) * 128 + 2 * lane) * 16 + h]; dN1 = DT[(size_t)(b * 2048 + (cc) * 128 + 2 * lane + 1) * 16 + h]; } } while (0)
#define SSD_SCAL(sb) do { if (w == 0) { LAS float* acs_ = (LAS float*)(lds + L_SC + (sb) * 2048); \
            const float d0 = softplusf_(dN0 + dtb), d1 = softplusf_(dN1 + dtb); const float a0 = d0 * a_h, a1 = d1 * a_h; float inc = a0 + a1; \
            _Pragma("unroll") for (int s = 1; s < 64; s <<= 1) { const float o = __shfl_up(inc, s, 64); if (lane >= s) inc += o; } \
            const float tot = __shfl(inc, 63, 64); const float c1 = inc, c0 = inc - a1; \
            acs_[2 * lane] = c0; acs_[2 * lane + 1] = c1; acs_[128 + 2 * lane] = d0; acs_[128 + 2 * lane + 1] = d1; \
            acs_[256 + 2 * lane] = __expf(c0); acs_[256 + 2 * lane + 1] = __expf(c1); acs_[384 + 2 * lane] = __expf(tot - c0) * d0; acs_[384 + 2 * lane + 1] = __expf(tot - c1) * d1; } } while (0)
#define SSD_CONV(sb, cc) do { const int lr = 2 * launder_v(lane); const LAS float* decdt_ = (const LAS float*)(lds + L_SC + (sb) * 2048) + 384; \
        u32x4 xr[2][5]; SSD_LD1(cc, 0, xr[0]); \
        _Pragma("unroll") for (int i = 0; i < 5; ++i) { const int cgx = 8 * i + wu; const int ch_ = xbc_chan(cgx * 8, h, g); \
            if (i < 4) SSD_LD1(cc, i + 1, xr[(i + 1) & 1]); \
            float xf[5][8]; \
            _Pragma("unroll") for (int k = 0; k < (i == 0 ? 5 : 2); ++k) { const u32x4 v = xr[i & 1][k]; \
                xf[k][0] = bf_lo(v.x); xf[k][1] = bf_hi(v.x); xf[k][2] = bf_lo(v.y); xf[k][3] = bf_hi(v.y); xf[k][4] = bf_lo(v.z); xf[k][5] = bf_hi(v.z); xf[k][6] = bf_lo(v.w); xf[k][7] = bf_hi(v.w); } \
            float o0[8], o1[8]; \
            if (i == 0) { _Pragma("unroll") for (int j = 0; j < 8; ++j) { \
                const float w0 = cwp[ch_ + j], w1 = cwp[1536 + ch_ + j], w2 = cwp[3072 + ch_ + j], w3 = cwp[4608 + ch_ + j]; \
                const float bb = cbp[ch_ + j]; \
                o0[j] = siluf_(bb + w0 * xf[0][j] + w1 * xf[1][j] + w2 * xf[2][j] + w3 * xf[3][j]); \
                o1[j] = siluf_(bb + w0 * xf[1][j] + w1 * xf[2][j] + w2 * xf[3][j] + w3 * xf[4][j]); } } \
            else { _Pragma("unroll") for (int j = 0; j < 8; ++j) { o0[j] = xf[0][j]; o1[j] = xf[1][j]; } } \
            if (cgx < 8) { _Pragma("unroll") for (int j = 0; j < 8; ++j) *(LAS unsigned*)(lds + L_XT + (cgx * 8 + j) * PB + lr * 2) = cvt_pk_bf16(o0[j], o1[j]); } \
            else if (cgx < 24) { const int n0 = (cgx - 8) * 8; const float s0 = decdt_[lr], s1 = decdt_[lr + 1]; \
                u32x4 q; q.x = cvt_pk_bf16(o0[0], o0[1]); q.y = cvt_pk_bf16(o0[2], o0[3]); q.z = cvt_pk_bf16(o0[4], o0[5]); q.w = cvt_pk_bf16(o0[6], o0[7]); *(LAS u32x4*)(lds + L_BS + lr * PB + n0 * 2) = q; \
                q.x = cvt_pk_bf16(o1[0], o1[1]); q.y = cvt_pk_bf16(o1[2], o1[3]); q.z = cvt_pk_bf16(o1[4], o1[5]); q.w = cvt_pk_bf16(o1[6], o1[7]); *(LAS u32x4*)(lds + L_BS + (lr + 1) * PB + n0 * 2) = q; \
                _Pragma("unroll") for (int j = 0; j < 8; ++j) *(LAS unsigned*)(lds + L_BDT + (n0 + j) * PB + lr * 2) = cvt_pk_bf16(o0[j] * s0, o1[j] * s1); } \
            else { const int n0 = (cgx - 24) * 8; \
                u32x4 q; q.x = cvt_pk_bf16(o0[0], o0[1]); q.y = cvt_pk_bf16(o0[2], o0[3]); q.z = cvt_pk_bf16(o0[4], o0[5]); q.w = cvt_pk_bf16(o0[6], o0[7]); *(LAS u32x4*)(lds + L_CS + lr * PB + n0 * 2) = q; \
                q.x = cvt_pk_bf16(o1[0], o1[1]); q.y = cvt_pk_bf16(o1[2], o1[3]); q.z = cvt_pk_bf16(o1[4], o1[5]); q.w = cvt_pk_bf16(o1[6], o1[7]); *(LAS u32x4*)(lds + L_CS + (lr + 1) * PB + n0 * 2) = q; } } } while (0)

    __syncthreads();
    SSD_DTLOAD(0);
    SSD_SCAL(0);
    __syncthreads();
    SSD_CONV(0, 0);
#pragma unroll 1
    for (int c = 0; c < 16; ++c) {
        const int grow0 = b * 2048 + c * 128, sb = c & 1;
        LAS float* acs = (LAS float*)(lds + L_SC + sb * 2048); LAS float* dtv = acs + 128; LAS float* eacs = acs + 256;
        __syncthreads();
        if (c < 15) SSD_DTLOAD(c + 1);
        const int lrow = 16 * w + fr, row = grow0 + lrow;
        u32x2 zz[4];
#pragma unroll
        for (int ni = 0; ni < 4; ++ni) zz[ni] = *(const u32x2*)(PROJ + (size_t)row * NPROJ + C_Z + h * 64 + ni * 16 + 4 * fq);
        if (c < 15) SSD_SCAL(sb ^ 1);
        {
            f32x4 cb[8];
#pragma unroll
            for (int i = 0; i < 8; ++i) cb[i] = (f32x4){0.f, 0.f, 0.f, 0.f};
            wmma<8, 4>(lds + L_CS + w * 16 * PB, lds + L_BS, PB, cb, fr, fq);
            __syncthreads();
            const float al = acs[lrow];
#pragma unroll
            for (int ni = 0; ni < 8; ++ni) { const int s0 = ni * 16 + 4 * fq; float mv[4];
#pragma unroll
                for (int e = 0; e < 4; ++e) { const int s = s0 + e; const float dd = fminf(al - acs[s], 0.f); mv[e] = (s <= lrow) ? cb[ni][e] * __expf(dd) * dtv[s] : 0.f; }
                u32x2 o; o.x = cvt_pk_bf16(mv[0], mv[1]); o.y = cvt_pk_bf16(mv[2], mv[3]); *(LAS u32x2*)(lds + L_BS + lrow * PB + s0 * 2) = o; }
        }
        __syncthreads();
        {
            f32x4 y[4];
#pragma unroll
            for (int i = 0; i < 4; ++i) y[i] = (f32x4){0.f, 0.f, 0.f, 0.f};
            if (c > 0) { wmma<4, 4>(lds + L_CS + w * 16 * PB, lds + L_SB, PB, y, fr, fq); const float ea = eacs[lrow];
#pragma unroll
                for (int i = 0; i < 4; ++i) y[i] = y[i] * ea; }
            wmma<4, 4>(lds + L_BS + w * 16 * PB, lds + L_XT, PB, y, fr, fq);
            float ssq = 0.f;
#pragma unroll
            for (int ni = 0; ni < 4; ++ni) { const int p0 = ni * 16 + 4 * fq;
                const f32x4 ng = *(const f32x4*)(PIN(I_SSDN) + (size_t)l * 1024 + h * 64 + p0);
                float zf[4] = {bf_lo(zz[ni].x), bf_hi(zz[ni].x), bf_lo(zz[ni].y), bf_hi(zz[ni].y)}; float ov[4];
#pragma unroll
                for (int e = 0; e < 4; ++e) { const float xs = bf1(*(const LAS bf16_t*)(lds + L_XT + (p0 + e) * PB + lrow * 2)); const float v = (y[ni][e] + Dh * xs) * siluf_(zf[e]); ssq += v * v; ov[e] = v * ng[e]; }
                u32x2 o; o.x = cvt_pk_bf16(ov[0], ov[1]); o.y = cvt_pk_bf16(ov[2], ov[3]); *(u32x2*)(Y + (size_t)row * 2048 + h * 64 + p0) = o; }
            ssq += shx(ssq, 16); ssq += shx(ssq, 32);
            if (fq == 0) SSQ[(size_t)row * 16 + h] = ssq;
        }
        __syncthreads();
        {
            const float et = eacs[127];
#pragma unroll
            for (int i = 0; i < 4; ++i) S[i] = S[i] * et;
            wmma<4, 4>(lds + L_XT + (w >> 1) * 16 * PB, lds + L_BDT + (w & 1) * 64 * PB, PB, S, fr, fq);
            const int p = (w >> 1) * 16 + fr;
#pragma unroll
            for (int ni = 0; ni < 4; ++ni) { const int n0 = (w & 1) * 64 + ni * 16 + 4 * fq; u32x2 o; o.x = cvt_pk_bf16(S[ni][0], S[ni][1]); o.y = cvt_pk_bf16(S[ni][2], S[ni][3]); *(LAS u32x2*)(lds + L_SB + p * PB + n0 * 2) = o; }
        }
        __syncthreads();
        if (c < 15) SSD_CONV(sb ^ 1, c + 1);
    }
#undef SSD_LD1
#undef SSD_DTLOAD
#undef SSD_SCAL
#undef SSD_CONV
    {
        float* dst = (P.out + launder_z()) + O_SSMP + ((size_t)((l * 8 + b) * 16 + h) * 64) * 128; const int p = (w >> 1) * 16 + fr;
#pragma unroll
        for (int ni = 0; ni < 4; ++ni) { const int n0 = (w & 1) * 64 + ni * 16 + 4 * fq; *(f32x4*)(dst + (size_t)p * 128 + n0) = S[ni]; }
    }
}

__device__ __forceinline__ void ssd_sample(LAS uchar* lds, const Params& P, int l, int b, int hp) {
    const int tid = TIDX, half = tid >> 8, t8 = tid & 255, h = hp * 2 + half, g = h >> 3;
    const bf16_t* PROJ = (const bf16_t*)((P.ws + launder_z()) + WS_PROJ); const float* DT = (const float*)((P.ws + launder_z()) + WS_DT);
    bf16_t* Y = (bf16_t*)((P.ws + launder_z()) + WS_Y); float* SSQ = (float*)((P.ws + launder_z()) + WS_SSQ);
    LAS float* xs = (LAS float*)(lds + half * 16384); LAS float* Bv = xs + 512; LAS float* Cv = xs + 1536; LAS float* sdt = xs + 2560; LAS float* sdec = xs + 2568; LAS float* yv = xs + 2576;
    const int row0 = MPR + b * 8;
    __syncthreads();
    for (int cc = t8; cc < 320; cc += 256) {
        const int ch = xbc_chan(cc, h, g);
        float xv[11];
#pragma unroll
        for (int k = 0; k < 3; ++k) xv[k] = PIN(I_SCONV)[((size_t)(l * 128 + b) * 3 + k) * 1536 + ch];
#pragma unroll
        for (int t = 0; t < 8; ++t) xv[3 + t] = bf1(PROJ[(size_t)(row0 + t) * NPROJ + C_XBC + ch]);
        const float w0 = PIN(I_CONVW)[(size_t)(l * 4 + 0) * 1536 + ch], w1 = PIN(I_CONVW)[(size_t)(l * 4 + 1) * 1536 + ch], w2 = PIN(I_CONVW)[(size_t)(l * 4 + 2) * 1536 + ch], w3 = PIN(I_CONVW)[(size_t)(l * 4 + 3) * 1536 + ch];
        const float cb = PIN(I_CONVB)[(size_t)l * 1536 + ch];
#pragma unroll
        for (int t = 0; t < 8; ++t) { const float o = siluf_(cb + w0 * xv[t] + w1 * xv[t + 1] + w2 * xv[t + 2] + w3 * xv[t + 3]);
            if (cc < 64) xs[t * 64 + cc]= o; else if (cc < 192) Bv[t * 128 + cc - 64] = o; else Cv[t * 128 + cc - 192] = o; }
    }
    if (t8 < 8) { const float d = softplusf_(DT[(size_t)(row0 + t8) * 16 + h] + PIN(I_DTB)[l * 16 + h]); sdt[t8] = d; sdec[t8] = __expf(-d * __expf(PIN(I_ALOG)[l * 16 + h])); }
    __syncthreads();
    const int l16 = t8 & 15, pr = t8 >> 4;
    const float* hin = PIN(I_SSSM) + ((size_t)((l * 128 + b) * 16 + h) * 64) * 128;
    float* hout = (P.out + launder_z()) + O_SSMS + ((size_t)((l * 128 + b) * 16 + h) * 64) * 128;
    f32x4 hs[4][2];
#pragma unroll
    for (int pi = 0; pi < 4; ++pi)
#pragma unroll
        for (int it = 0; it < 2; ++it) hs[pi][it] = *(const f32x4*)(hin + (size_t)(pi * 16 + pr) * 128 + it * 64 + l16 * 4);
#pragma unroll 1
    for (int t = 0; t < 8; ++t) {
        const float dec = sdec[t], dtt = sdt[t];
        const f32x4 B0 = *(const LAS f32x4*)(Bv + t * 128 + l16 * 4), B1 = *(const LAS f32x4*)(Bv + t * 128 + 64 + l16 * 4);
        const f32x4 C0 = *(const LAS f32x4*)(Cv + t * 128 + l16 * 4), C1 = *(const LAS f32x4*)(Cv + t * 128 + 64 + l16 * 4);
#pragma unroll
        for (int pi = 0; pi < 4; ++pi) { const float xd = xs[t * 64 + pi * 16 + pr] * dtt;
            hs[pi][0] = hs[pi][0] * dec + B0 * xd; hs[pi][1] = hs[pi][1] * dec + B1 * xd;
            const f32x4 q = hs[pi][0] * C0 + hs[pi][1] * C1; float yp = q[0] + q[1] + q[2] + q[3];
            yp += shx(yp, 1); yp += shx(yp, 2); yp += shx(yp, 4); yp += shx(yp, 8);
            if (l16 == 0) yv[t * 64 + pi * 16 + pr] = yp; }
    }
#pragma unroll
    for (int pi = 0; pi < 4; ++pi)
#pragma unroll
        for (int it = 0; it < 2; ++it) *(f32x4*)(hout + (size_t)(pi * 16 + pr) * 128 + it * 64 + l16 * 4) = hs[pi][it];
    __syncthreads();
    {
        const int t = t8 >> 5, p0 = (t8 & 31) * 2, row = row0 + t; const float Dh = PIN(I_DSKIP)[l * 16 + h];
        const unsigned zz = *(const unsigned*)(PROJ + (size_t)row * NPROJ + C_Z + h * 64 + p0);
        const float v0 = (yv[t * 64 + p0] + Dh * xs[t * 64 + p0]) * siluf_(bf_lo(zz)), v1 = (yv[t * 64 + p0 + 1] + Dh * xs[t * 64 + p0 + 1]) * siluf_(bf_hi(zz));
        float ssq = v0 * v0 + v1 * v1;
        ssq += shx(ssq, 1); ssq += shx(ssq, 2); ssq += shx(ssq, 4); ssq += shx(ssq, 8); ssq += shx(ssq, 16);
        *(unsigned*)(Y + (size_t)row * 2048 + h * 64 + p0) = cvt_pk_bf16(v0 * PIN(I_SSDN)[(size_t)l * 1024 + h * 64 + p0], v1 * PIN(I_SSDN)[(size_t)l * 1024 + h * 64 + p0 + 1]);
        if ((t8 & 31) == 0) SSQ[(size_t)row * 16 + h] = ssq;
    }
}

__device__ __forceinline__ void sgu_prompt(LAS uchar* lds, const Params& P, int l, int b, int c, int g) {
    const int tid = TIDX, lane = tid & 63, w = tid >> 6, fr = lane & 15, fq = lane >> 4;
    const bf16_t* PROJ = (const bf16_t*)((P.ws + launder_z()) + WS_PROJ); bf16_t* Y = (bf16_t*)((P.ws + launder_z()) + WS_Y);
    LAS float* smu = (LAS float*)(lds + 69632); LAS float* srs = smu + 128;
    const int grow0 = b * 2048 + c * 128;
    __syncthreads();
    {
        const int r = tid >> 2, q = tid & 3; const bf16_t* src = PROJ + (size_t)(grow0 + r) * NPROJ + C_V + q * 128;
        float s = 0.f, s2 = 0.f;
#pragma unroll
        for (int i = 0; i < 16; ++i) { const u32x4 v = *(const u32x4*)(src + i * 8);
            const float f[8] = {bf_lo(v.x), bf_hi(v.x), bf_lo(v.y), bf_hi(v.y), bf_lo(v.z), bf_hi(v.z), bf_lo(v.w), bf_hi(v.w)};
#pragma unroll
            for (int j = 0; j < 8; ++j) { s += f[j]; s2 += f[j] * f[j]; } }
        s += shx(s, 1); s += shx(s, 2); s2 += shx(s2, 1); s2 += shx(s2, 2);
        const float mu = s * (1.0f / 512.0f), var = fmaxf(s2 * (1.0f / 512.0f) - mu * mu, 0.f);
        if (q == 0) { smu[r] = mu; srs[r] = rsqrtf(var + EPS); }
        const float* wsrc = PIN(I_WSP) + ((size_t)(l * 4 + g) * 128 + r) * 128 + q * 32;
#pragma unroll
        for (int i = 0; i < 4; ++i) { const f32x4 a = *(const f32x4*)(wsrc + i * 8), bb = *(const f32x4*)(wsrc + i * 8 + 4); const int s0 = q * 32 + i * 8;
            u32x4 o; o.x = cvt_pk_bf16(s0 + 0 <= r ? a[0] : 0.f, s0 + 1 <= r ? a[1] : 0.f); o.y = cvt_pk_bf16(s0 + 2 <= r ? a[2] : 0.f, s0 + 3 <= r ? a[3] : 0.f);
            o.z = cvt_pk_bf16(s0 + 4 <= r ? bb[0] : 0.f, s0 + 5 <= r ? bb[1] : 0.f); o.w = cvt_pk_bf16(s0 + 6 <= r ? bb[2] : 0.f, s0 + 7 <= r ? bb[3] : 0.f);
            *(LAS u32x4*)(lds + r * PB + s0 * 2) = o; }
    }
    __syncthreads();
    {
        const int r = tid >> 2, q = tid & 3; const bf16_t* src = PROJ + (size_t)(grow0 + r) * NPROJ + C_V + g * 128 + q * 32;
        const float mu = smu[r], rs = srs[r];
        const float* lg = PIN(I_LNG) + (size_t)l * 512 + g * 128 + q * 32; const float* lb = PIN(I_LNB) + (size_t)l * 512 + g * 128 + q * 32;
        float* vout = (P.out + launder_z()) + O_VP + ((size_t)(l * 8 + b) * 128 + r) * 512 + g * 128 + q * 32;
#pragma unroll
        for (int i = 0; i < 4; ++i) { const u32x4 v = *(const u32x4*)(src + i * 8);
            const float f[8] = {bf_lo(v.x), bf_hi(v.x), bf_lo(v.y), bf_hi(v.y), bf_lo(v.z), bf_hi(v.z), bf_lo(v.w), bf_hi(v.w)}; float vn[8];
#pragma unroll
            for (int j = 0; j < 8; ++j) { vn[j] = (f[j] - mu) * rs * lg[i * 8 + j] + lb[i * 8 + j];
                *(LAS bf16_t*)(lds + 34816 + (q * 32 + i * 8 + j) * PB + r * 2) = (bf16_t)(cvt_pk_bf16(vn[j], 0.f) & 0xffffu); }
            if (c == 15) { *(f32x4*)(vout + i * 8) = (f32x4){vn[0], vn[1], vn[2], vn[3]}; *(f32x4*)(vout + i * 8 + 4) = (f32x4){vn[4], vn[5], vn[6], vn[7]}; } }
    }
    __syncthreads();
    {
        f32x4 acc[8];
#pragma unroll
        for (int i = 0; i < 8; ++i) acc[i] = (f32x4){0.f, 0.f, 0.f, 0.f};
        wmma<8, 4>(lds + w * 16 * PB, lds + 34816, PB, acc, fr, fq);
        const int t = 16 * w + fr, row = grow0 + t; const float bs = PIN(I_BSP)[(size_t)(l * 4 + g) * 128 + t];
#pragma unroll
        for (int ni = 0; ni < 8; ++ni) { const int d0 = ni * 16 + 4 * fq; const u32x2 uu = *(const u32x2*)(PROJ + (size_t)row * NPROJ + C_U + g * 128 + d0);
            u32x2 o; o.x = cvt_pk_bf16(bf_lo(uu.x) * (acc[ni][0] + bs), bf_hi(uu.x) * (acc[ni][1] + bs)); o.y = cvt_pk_bf16(bf_lo(uu.y) * (acc[ni][2] + bs), bf_hi(uu.y) * (acc[ni][3] + bs));
            *(u32x2*)(Y + (size_t)row * 2048 + 1024 + g * 128 + d0) = o; }
    }
}

__device__ __forceinline__ void sgu_sample(LAS uchar* lds, const Params& P, int l, int b) {
    const int tid = TIDX, lane = tid & 63, w = tid >> 6, ch = tid, g = ch >> 7;
    const bf16_t* PROJ = (const bf16_t*)((P.ws + launder_z()) + WS_PROJ); bf16_t* Y = (bf16_t*)((P.ws + launder_z()) + WS_Y);
    LAS float* red = (LAS float*)lds;
    const int row0 = MPR + b * 8;
    float v[8], u[8];
#pragma unroll
    for (int s = 0; s < 8; ++s) { v[s] = bf1(PROJ[(size_t)(row0 + s) * NPROJ + C_V + ch]); u[s] = bf1(PROJ[(size_t)(row0 + s) * NPROJ + C_U + ch]); }
    __syncthreads();
#pragma unroll
    for (int s = 0; s < 8; ++s) { float a = v[s], a2 = v[s] * v[s];
#pragma unroll
        for (int m = 1; m < 64; m <<= 1) { a += shx(a, m); a2 += shx(a2, m); }
        if (lane == 0) { red[w * 16 + s] = a; red[w * 16 + 8 + s] = a2; } }
    __syncthreads();
    const float lg = PIN(I_LNG)[(size_t)l * 512 + ch], lb = PIN(I_LNB)[(size_t)l * 512 + ch];
    float vn[8];
#pragma unroll
    for (int s = 0; s < 8; ++s) { float a = 0.f, a2 = 0.f;
#pragma unroll
        for (int ww = 0; ww < 8; ++ww) { a += red[ww * 16 + s]; a2 += red[ww * 16 + 8 + s]; }
        const float mu = a * (1.0f / 512.0f), var = fmaxf(a2 * (1.0f / 512.0f) - mu * mu, 0.f);
        vn[s] = (v[s] - mu) * rsqrtf(var + EPS) * lg + lb;
        (P.out + launder_z())[O_VS + ((size_t)(l * 128 + b) * 8 + s) * 512 + ch] = vn[s]; }
    const float* W = PIN(I_WSP) + (size_t)(l * 4 + g) * 128 * 128; const float* bsp = PIN(I_BSP) + (size_t)(l * 4 + g) * 128;
#pragma unroll
    for (int t = 0; t < 8; ++t) { float o = bsp[t];
#pragma unroll
        for (int s = 0; s <= t; ++s) o += W[t * 128 + s] * vn[s];
        Y[(size_t)(row0 + t) * 2048 + 1024 + ch] = (bf16_t)(cvt_pk_bf16(u[t] * o, 0.f) & 0xffffu); }
}

__device__ __forceinline__ void pool_prompt(const Params& P, int tile) {
    const int tid = TIDX, cgp = tid & 63, rsg = tid >> 6, ch0 = cgp * 8, wdw = 2 << (cgp >> 4);
    const bf16_t* PROJ = (const bf16_t*)((P.ws + launder_z()) + WS_PROJ); bf16_t* Y = (bf16_t*)((P.ws + launder_z()) + WS_Y);
    const int b = tile >> 4, pos0 = (tile & 15) * 128 + rsg * 16; const size_t rbase = (size_t)b * 2048;
    float S[8];
#pragma unroll
    for (int j = 0; j < 8; ++j) S[j] = 0.f;
    for (int k = 1; k < wdw; ++k) { const int pos = pos0 - k; if (pos >= 0) { const u32x4 v = *(const u32x4*)(PROJ + (rbase + pos) * NPROJ + C_POOL + ch0);
        S[0] += bf_lo(v.x); S[1] += bf_hi(v.x); S[2] += bf_lo(v.y); S[3] += bf_hi(v.y); S[4] += bf_lo(v.z); S[5] += bf_hi(v.z); S[6] += bf_lo(v.w); S[7] += bf_hi(v.w); } }
#pragma unroll 1
    for (int t = 0; t < 16; ++t) { const int pos = pos0 + t;
        const u32x4 v = *(const u32x4*)(PROJ + (rbase + pos) * NPROJ + C_POOL + ch0);
        const float x[8] = {bf_lo(v.x), bf_hi(v.x), bf_lo(v.y), bf_hi(v.y), bf_lo(v.z), bf_hi(v.z), bf_lo(v.w), bf_hi(v.w)};
        const float ic = 1.0f / (float)min(pos + 1, wdw); float d[8];
#pragma unroll
        for (int j = 0; j < 8; ++j) { S[j] += x[j]; d[j] = S[j] * ic - x[j]; }
        u32x4 o; o.x = cvt_pk_bf16(d[0], d[1]); o.y = cvt_pk_bf16(d[2], d[3]); o.z = cvt_pk_bf16(d[4], d[5]); o.w = cvt_pk_bf16(d[6], d[7]);
        *(u32x4*)(Y + (rbase + pos) * 2048 + 1536 + ch0) = o;
        const int po = pos - wdw + 1;
        if (po >= 0) { const u32x4 q = *(const u32x4*)(PROJ + (rbase + po) * NPROJ + C_POOL + ch0);
            S[0] -= bf_lo(q.x); S[1] -= bf_hi(q.x); S[2] -= bf_lo(q.y); S[3] -= bf_hi(q.y); S[4] -= bf_lo(q.z); S[5] -= bf_hi(q.z); S[6] -= bf_lo(q.w); S[7] -= bf_hi(q.w); } }
}
__device__ __forceinline__ void pool_sample(const Params& P, int l, int si) {
    const int tid = TIDX, cgp = tid & 63, ch0 = cgp * 8, wdw = 2 << (cgp >> 4), b = si * 8 + (tid >> 6);
    const bf16_t* PROJ = (const bf16_t*)((P.ws + launder_z()) + WS_PROJ); bf16_t* Y = (bf16_t*)((P.ws + launder_z()) + WS_Y);
    const float* buf = PIN(I_SPOOL) + (size_t)(l * 128 + b) * 15 * 512 + ch0;
    const size_t rbase = (size_t)MPR + b * 8;
    float S[8];
#pragma unroll
    for (int j = 0; j < 8; ++j) S[j] = 0.f;
    for (int k = 1; k < wdw; ++k) { const f32x4 a = *(const f32x4*)(buf + (size_t)(15 - k) * 512), c = *(const f32x4*)(buf + (size_t)(15 - k) * 512 + 4);
        S[0] += a[0]; S[1] += a[1]; S[2] += a[2]; S[3] += a[3]; S[4] += c[0]; S[5] += c[1]; S[6] += c[2]; S[7] += c[3]; }
    const float ic = 1.0f / (float)wdw;
#pragma unroll 1
    for (int t = 0; t < 8; ++t) {
        const u32x4 v = *(const u32x4*)(PROJ + (rbase + t) * NPROJ + C_POOL + ch0);
        const float x[8] = {bf_lo(v.x), bf_hi(v.x), bf_lo(v.y), bf_hi(v.y), bf_lo(v.z), bf_hi(v.z), bf_lo(v.w), bf_hi(v.w)}; float d[8];
#pragma unroll
        for (int j = 0; j < 8; ++j) { S[j] += x[j]; d[j] = S[j] * ic - x[j]; }
        u32x4 o; o.x = cvt_pk_bf16(d[0], d[1]); o.y = cvt_pk_bf16(d[2], d[3]); o.z = cvt_pk_bf16(d[4], d[5]); o.w = cvt_pk_bf16(d[6], d[7]);
        *(u32x4*)(Y + (rbase + t) * 2048 + 1536 + ch0) = o;
        const int po = t - wdw + 1;
        if (po >= 0) { const u32x4 q = *(const u32x4*)(PROJ + (rbase + po) * NPROJ + C_POOL + ch0);
            S[0] -= bf_lo(q.x); S[1] -= bf_hi(q.x); S[2] -= bf_lo(q.y); S[3] -= bf_hi(q.y); S[4] -= bf_lo(q.z); S[5] -= bf_hi(q.z); S[6] -= bf_lo(q.w); S[7] -= bf_hi(q.w); }
        else { const f32x4 a = *(const f32x4*)(buf + (size_t)(15 + po) * 512), c = *(const f32x4*)(buf + (size_t)(15 + po) * 512 + 4);
            S[0] -= a[0]; S[1] -= a[1]; S[2] -= a[2]; S[3] -= a[3]; S[4] -= c[0]; S[5] -= c[1]; S[6] -= c[2]; S[7] -= c[3]; } }
}
constexpr int NC_CP = 8 * 3 * 1536, NC_CS = 128 * 3 * 1536, NC_PP = 8 * 15 * 512, NC_PS = 128 * 15 * 512, NC_ALL = NC_CP + NC_CS + NC_PP + NC_PS;
__device__ __forceinline__ void state_copy(const Params& P, int l, int item) {
    const bf16_t* PROJ = (const bf16_t*)((P.ws + launder_z()) + WS_PROJ);
    for (int j = 0; j < 16; ++j) { int e = item * 8192 + j * NTHR + TIDX; if (e >= NC_ALL) return;
        if (e < NC_CP) { const int ch = e % 1536, k = (e / 1536) % 3, b = e / 4608; (P.out + launder_z())[O_CONVP + (size_t)l * NC_CP + e] = bf1(PROJ[(size_t)(b * 2048 + 2045 + k) * NPROJ + C_XBC + ch]); continue; } e -= NC_CP;
        if (e < NC_CS) { const int ch = e % 1536, k = (e / 1536) % 3, b = e / 4608; (P.out + launder_z())[O_CONVS + (size_t)l * NC_CS + e] = bf1(PROJ[(size_t)(MPR + b * 8 + 5 + k) * NPROJ + C_XBC + ch]); continue; } e -= NC_CS;
        if (e < NC_PP) { const int ch = e % 512, k = (e / 512) % 15, b = e / 7680; (P.out + launder_z())[O_POOLP + (size_t)l * NC_PP + e] = bf1(PROJ[(size_t)(b * 2048 + 2033 + k) * NPROJ + C_POOL + ch]); continue; } e -= NC_PP;
        { const int ch = e % 512, k = (e / 512) % 15, b = e / 7680;
          (P.out + launder_z())[O_POOLS + (size_t)l * NC_PS + e] = k < 7 ? PIN(I_SPOOL)[((size_t)(l * 128 + b) * 15 + 8 + k) * 512 + ch] : bf1(PROJ[(size_t)(MPR + b * 8 + (k - 7)) * NPROJ + C_POOL + ch]); }
    }
}

__device__ __forceinline__ void phase_convbc(const Params& P, int l) {
    const int tid = TIDX, lane = tid & 63, w = __builtin_amdgcn_readfirstlane(tid >> 6);
    const bf16_t* PROJ = (const bf16_t*)((P.ws + launder_z()) + WS_PROJ); bf16_t* CBC = (bf16_t*)((P.ws + launder_z()) + WS_CBC);
    const float* cwp = PIN(I_CONVW) + (size_t)l * 4 * 1536; const float* cbp = PIN(I_CONVB) + (size_t)l * 1536;
    for (int it = BIDX; it < 256; it += GDIM) {
        const int tile = it >> 1, half = it & 1, b = tile >> 4, c = tile & 15;
        const bf16_t* xsrc = PROJ + (size_t)(b * 2048) * NPROJ + C_XBC + 1024 + half * 256;
#pragma unroll 1
        for (int i = 0; i < 4; ++i) {
            const int cg = i * 8 + w, ch = 1024 + half * 256 + cg * 8;
            float xf[5][8];
#pragma unroll
            for (int k = 0; k < 5; ++k) { const int pos = c * 128 + 2 * lane - 3 + k; u32x4 v = (u32x4){0u, 0u, 0u, 0u}; if (pos >= 0) v = *(const u32x4*)(xsrc + (size_t)pos * NPROJ + cg * 8);
                xf[k][0] = bf_lo(v.x); xf[k][1] = bf_hi(v.x); xf[k][2] = bf_lo(v.y); xf[k][3] = bf_hi(v.y); xf[k][4] = bf_lo(v.z); xf[k][5] = bf_hi(v.z); xf[k][6] = bf_lo(v.w); xf[k][7] = bf_hi(v.w); }
            float o0[8], o1[8];
#pragma unroll
            for (int j = 0; j < 8; ++j) { const float w0 = cwp[ch + j], w1 = cwp[1536 + ch + j], w2 = cwp[3072 + ch + j], w3 = cwp[4608 + ch + j], bb = cbp[ch + j];
                o0[j] = siluf_(bb + w0 * xf[0][j] + w1 * xf[1][j] + w2 * xf[2][j] + w3 * xf[3][j]);
                o1[j] = siluf_(bb + w0 * xf[1][j] + w1 * xf[2][j] + w2 * xf[3][j] + w3 * xf[4][j]); }
            const size_t row = (size_t)b * 2048 + c * 128 + 2 * lane;
            u32x4 q; q.x = cvt_pk_bf16(o0[0], o0[1]); q.y = cvt_pk_bf16(o0[2], o0[3]); q.z = cvt_pk_bf16(o0[4], o0[5]); q.w = cvt_pk_bf16(o0[6], o0[7]); *(u32x4*)(CBC + row * 512 + half * 256 + cg * 8) = q;
            q.x = cvt_pk_bf16(o1[0], o1[1]); q.y = cvt_pk_bf16(o1[2], o1[3]); q.z = cvt_pk_bf16(o1[4], o1[5]); q.w = cvt_pk_bf16(o1[6], o1[7]); *(u32x4*)(CBC + (row + 1) * 512 + half * 256 + cg * 8) = q;
        }
    }
}

__device__ __forceinline__ void phase_mixer(LAS uchar* lds, const Params& P, int l) {
    const int G = GDIM, bid = BIDX;
    constexpr int N_B = 1024, N_C = 512, N_D = 128, N_E = 128, N_E2 = 16, N_F = (NC_ALL + 8191) / 8192;
    constexpr int N_REST = N_B + N_C + N_D + N_E + N_E2 + N_F;
    if (G > 128) { if (bid < 128) ssd_prompt(lds, P, l, bid >> 4, bid & 15); }
    else { for (int i = bid; i < 128; i += G) ssd_prompt(lds, P, l, i >> 4, i & 15); }
    unsigned* ctr = (unsigned*)((P.ws + launder_z()) + WS_BAR) + 3584 + 64 * l;
    volatile LAS unsigned* bc = (volatile LAS unsigned*)(lds + LDS_BYTES) + 2;
    for (;;) {
        __syncthreads();
        if (TIDX == 0) bc[0] = __hip_atomic_fetch_add(ctr, 1u, __ATOMIC_RELAXED, __HIP_MEMORY_SCOPE_AGENT);
        __syncthreads();
        int j = (int)bc[0];
        if (j >= N_REST) break;
        if (j < N_C) { sgu_prompt(lds, P, l, j >> 6, (j >> 2) & 15, j & 3); continue; } j -= N_C;
        if (j < N_B) { ssd_sample(lds, P, l, j >> 3, j & 7); continue; } j -= N_B;
        if (j < N_D) { sgu_sample(lds, P, l, j); continue; } j -= N_D;
        if (j < N_E) { pool_prompt(P, j); continue; } j -= N_E;
        if (j < N_E2) { pool_sample(P, l, j); continue; } j -= N_E2;
        state_copy(P, l, j);
    }
}


#define XB_TMO      128
#define XB_XCNT(j)  (256  + 64 * (j))
#define XB_XSUB(j)  (1280 + 64 * (j))
#define XB_XGEN(j)  (2304 + 64 * (j))
#define XB_TOP      3328
#define XB_TOPGEN   3392
#define XCD_BAR_WORDS 3456
#define XB_SPIN_CAP (1u << 20)
__device__ __forceinline__ unsigned xb_ld(unsigned* p)              { return __hip_atomic_load(p, __ATOMIC_RELAXED, __HIP_MEMORY_SCOPE_AGENT); }
__device__ __forceinline__ unsigned xb_add(unsigned* p, unsigned v) { return __hip_atomic_fetch_add(p, v, __ATOMIC_RELAXED, __HIP_MEMORY_SCOPE_AGENT); }
__device__ __forceinline__ unsigned xb_xcc_id() { return (unsigned)__builtin_amdgcn_s_getreg((3 << 11) | 20) & 0xFu; }
#define XB_SPIN(cond, bar) do { unsigned _sp = 0; while (cond) { __builtin_amdgcn_s_sleep(1); \
    if ((++_sp & 255u) == 0u) { if (xb_ld(&(bar)[XB_TMO])) break; if (_sp > XB_SPIN_CAP) { atomicAdd(&(bar)[XB_TMO], 1u); break; } } } } while (0)
struct XcdBarrier { unsigned* bar; unsigned x; volatile LAS unsigned* st; };
__device__ __forceinline__ XcdBarrier xcd_barrier_post(unsigned* bar, volatile LAS unsigned* st) {
    XcdBarrier b; b.bar = bar; b.x = xb_xcc_id(); b.st = st;
    if (threadIdx.x == 0) (void)xb_add(&bar[XB_XCNT(b.x)], 1u);
    return b;
}
__device__ __forceinline__ void xcd_barrier_complete(unsigned* bar, unsigned x, unsigned& nloc, unsigned& nx) {
    const unsigned G = gridDim.x * gridDim.y * gridDim.z;
    unsigned sum, cnt, mine, sp = 0u;
    for (;;) {
        sum = 0u; cnt = 0u; mine = 0u;
#pragma unroll
        for (unsigned j = 0; j < 16; ++j) { const unsigned c = xb_ld(&bar[XB_XCNT(j)]); sum += c; cnt += (c > 0u) ? 1u : 0u; mine = (j == x) ? c : mine; }
        if (sum == G) break;
        __builtin_amdgcn_s_sleep(1);
        if ((++sp & 255u) == 0u) { if (xb_ld(&bar[XB_TMO])) break; if (sp > XB_SPIN_CAP) { atomicAdd(&bar[XB_TMO], 1u); break; } }
    }
    nloc = mine > 0u ? mine : 1u; nx = cnt > 0u ? cnt : 1u;
}
__device__ __forceinline__ void xcd_barrier(const XcdBarrier& b) {
    asm volatile("s_waitcnt vmcnt(0)" ::: "memory");
    __syncthreads();
    if (threadIdx.x == 0) {
        unsigned* bar = b.bar + launder_z(); const unsigned bx = (unsigned)launder_s((int)b.x);
        __builtin_amdgcn_s_waitcnt(0);
        unsigned nloc = b.st[0], nx = b.st[1];
        if (nloc == 0u) { xcd_barrier_complete(bar, bx, nloc, nx); b.st[0] = nloc; b.st[1] = nx; }
        const unsigned old = xb_add(&bar[XB_XSUB(bx)], 1u);
        const unsigned gen = old / nloc;
        if (old + 1u == (gen + 1u) * nloc) {
            __builtin_amdgcn_fence(__ATOMIC_RELEASE, "agent");
            asm volatile("s_waitcnt vmcnt(0)" ::: "memory");
            const unsigned og = xb_add(&bar[XB_TOP], 1u);
            const unsigned tg = og / nx;
            if (og + 1u == (tg + 1u) * nx) xb_add(&bar[XB_TOPGEN], 1u);
            else XB_SPIN(xb_ld(&bar[XB_TOPGEN]) == tg, bar);
            __builtin_amdgcn_fence(__ATOMIC_ACQUIRE, "agent");
            xb_add(&bar[XB_XGEN(bx)], 1u);
            asm volatile("s_waitcnt vmcnt(0)" ::: "memory");
        } else {
            XB_SPIN(xb_ld(&bar[XB_XGEN(bx)]) == gen, bar);
            __builtin_amdgcn_fence(__ATOMIC_ACQUIRE, "agent");
            asm volatile("s_waitcnt vmcnt(0)" ::: "memory");
        }
    }
    __syncthreads();
}

__device__ __forceinline__ void run_phase(LAS uchar* lds, const Params& P, int ph) {
    uchar* ws = (P.ws + launder_z());
    float* RSS = (float*)(ws + WS_RSS);
    if (ph == 0) { phase_pre(lds, P); return; }
    if (ph == 30) {
        const int tid = TIDX, lane = tid & 63, wv = tid >> 6; const float* X = (const float*)(ws + WS_X); const float* fg = PIN(I_FN);
        for (int row = BIDX * 8 + wv; row < MT; row += GDIM * 8) { const float r = rownorm(RSS + (size_t)12 * MT * 16, row);
#pragma unroll
            for (int i = 0; i < 4; ++i) { const int col = i * 256 + lane * 4; const f32x4 v = *(const f32x4*)(X + (size_t)row * 1024 + col), gg = *(const f32x4*)(fg + col);
                *(f32x4*)((P.out + launder_z()) + O_Y + (size_t)row * 1024 + col) = (f32x4){v[0] * r * gg[0], v[1] * r * gg[1], v[2] * r * gg[2], v[3] * r * gg[3]}; } }
        return; }
    const int l = ph >= 2 ? (ph - 2) / 7 : 0, s = ph >= 2 ? (ph - 2) % 7 : -1;
    if (s == 1) { phase_convbc(P, l); { XcdBarrier xb; xb.bar = (unsigned*)(ws + WS_BAR); xb.x = xb_xcc_id(); xb.st = (volatile LAS unsigned*)(lds + LDS_BYTES); xcd_barrier(xb); } phase_mixer(lds, P, l); return; }
    bf16_t* xn_cur = (bf16_t*)(ws + ((l & 1) ? WS_XN2 : WS_XN)); bf16_t* xn_alt = (bf16_t*)(ws + ((l & 1) ? WS_XN : WS_XN2));
#define GINIT GPh g; g.G = GDIM; g.c = BIDX; g.nseg = 1; g.nlay = 1; g.a_lay = 0; g.b_lay = 0; g.nM = MT / 256; \
    g.rss = nullptr; g.rss_next = nullptr; g.gnext = nullptr; g.X = (float*)(ws + WS_X); g.XN = xn_alt; g.O = nullptr; g.DT = (float*)(ws + WS_DT); \
    g.PROJ = (const bf16_t*)(ws + WS_PROJ); g.SSQ = (const float*)(ws + WS_SSQ); g.UPB = nullptr; \
    g.A = xn_cur; g.lda = 1024; g.ldb = 1024; g.K = 1024; g.nN = 4;
    switch (s) {
    case -1: { GINIT g.A = (const bf16_t*)(ws + WS_PBF); g.Bt = (const bf16_t*)(ws + WS_WPU); g.lda = 256; g.ldb = 256; g.K = 256; g.nlay = 4; g.a_lay = (size_t)MT * 256; g.b_lay = (size_t)1024 * 256;
        g.O = (bf16_t*)(ws + WS_UP); gemm_phase<EPI_UP>(lds, g); } break;
    case 0: { GINIT g.Bt = (const bf16_t*)(ws + WS_WIN) + (size_t)l * NIN * 1024; g.nN = NIN / 256;
        g.rss = RSS + (size_t)(3 * l) * MT * 16; g.O = (bf16_t*)(ws + WS_PROJ); gemm_phase<EPI_P1>(lds, g); } break;
    case 2: { GINIT g.A = (const bf16_t*)(ws + WS_Y); g.Bt = (const bf16_t*)(ws + WS_WBR) + (size_t)l * 1024 * 2048; g.lda = 2048; g.ldb = 2048; g.K = 512; g.nseg = 4;
        g.O = (bf16_t*)(ws + WS_MRG); g.nM = 64; gemm_phase<EPI_P3>(lds, g); mini_gemm<EPI_P3>(lds, g); } break;
    case 3: { GINIT g.A = (const bf16_t*)(ws + WS_MRG); g.Bt = (const bf16_t*)(ws + WS_WOUT) + (size_t)l * 1024 * 1024;
        g.rss_next = RSS + (size_t)(3 * l + 1) * MT * 16; g.gnext = PIN(I_NFFN) + (size_t)l * 1024; g.nM = 64; gemm_phase<EPI_P4>(lds, g); mini_gemm<EPI_P4>(lds, g); } break;
    case 4: { GINIT g.A = xn_alt; g.Bt = (const bf16_t*)(ws + WS_WGU) + (size_t)l * 5632 * 1024; g.nN = 22;
        g.rss = RSS + (size_t)(3 * l + 1) * MT * 16; g.O = (bf16_t*)(ws + WS_ACT); gemm_phase<EPI_P5>(lds, g); } break;
    case 5: { GINIT g.A = (const bf16_t*)(ws + WS_ACT); g.Bt = (const bf16_t*)(ws + WS_WDN) + (size_t)l * 1024 * DFF; g.lda = DFF; g.ldb = DFF; g.K = DFF;
        g.XN = xn_cur; g.rss_next = RSS + (size_t)(3 * l + 2) * MT * 16; g.gnext = PIN(I_NPLE) + (size_t)l * 1024; g.nM = 64; gemm_phase<EPI_P6>(lds, g); mini_gemm<EPI_P6>(lds, g); } break;
    default: { GINIT g.Bt = (const bf16_t*)(ws + WS_WPG) + (size_t)l * 1024 * 1024;
        g.rss = RSS + (size_t)(3 * l + 2) * MT * 16; g.rss_next = RSS + (size_t)(3 * l + 3) * MT * 16; g.gnext = l < 3 ? PIN(I_NMIX) + (size_t)(l + 1) * 1024 : PIN(I_FN);
        g.UPB = (const bf16_t*)(ws + WS_UP) + (size_t)l * MT * 1024; g.nM = 64; gemm_phase<EPI_P7>(lds, g); mini_gemm<EPI_P7>(lds, g); } break;
    }
#undef GINIT
}

__global__ void __launch_bounds__(NTHR, 2) hybrid_fwd(Params P) {
    extern __shared__ __attribute__((aligned(16))) uchar smem[];
    LAS uchar* lds = (LAS uchar*)smem;
    cg::grid_group grid = cg::this_grid();
    volatile LAS unsigned* st = (volatile LAS unsigned*)(lds + LDS_BYTES);
    if (threadIdx.x < 4) st[threadIdx.x] = 0u;
    __syncthreads();
    const XcdBarrier xbar = xcd_barrier_post((unsigned*)(P.ws + WS_BAR), st);
    for (int ph = P.ph_lo; ph < P.ph_hi; ++ph) {
        int nrep_ = 1;
#ifdef PROBE_REP
        { const int s_ = ph >= 2 && ph < 30 ? (ph - 2) % 7 : (ph == 0 ? 7 : (ph == 1 ? 8 : 9)); if ((PROBE_REP >> s_) & 1) nrep_ = 2; }
#endif
#pragma unroll 1
        for (int r_ = 0; r_ < nrep_; ++r_) { run_phase(lds, P, ph); __syncthreads(); }
        if (ph + 1 < P.ph_hi) {
            if (ph == P.ph_lo) {
                asm volatile("s_waitcnt vmcnt(0)" ::: "memory");
                __syncthreads();
                if (threadIdx.x < 64) { __builtin_amdgcn_fence(__ATOMIC_RELEASE, "agent"); asm volatile("s_waitcnt vmcnt(0)" ::: "memory"); }
                __syncthreads();
                grid.sync();
                if (threadIdx.x < 64) { __builtin_amdgcn_fence(__ATOMIC_ACQUIRE, "agent"); asm volatile("s_waitcnt vmcnt(0)" ::: "memory"); }
                __syncthreads();
            } else xcd_barrier(xbar);
        }
    }
}

extern "C" void kernel_launch(void* const* d_in, const int* in_sizes, int n_in, void* d_out, int out_size, void* d_ws, size_t ws_size, hipStream_t stream) {
    static int grid = 0;
    if (grid == 0) {
        if (n_in != 32 || (size_t)out_size != O_END || ws_size < WS_END) { fprintf(stderr, "kernel_launch: shape mismatch n_in %d out %d (want %zu) ws %zu (want %zu)\n", n_in, out_size, (size_t)O_END, ws_size, (size_t)WS_END); grid = -1; return; }
        int dev = 0, cus = 0, per_cu = 0;
        hipGetDevice(&dev); hipDeviceGetAttribute(&cus, hipDeviceAttributeMultiprocessorCount, dev);
        if (hipFuncSetAttribute((const void*)hybrid_fwd, hipFuncAttributeMaxDynamicSharedMemorySize, LDS_BYTES + 16) != hipSuccess) { fprintf(stderr, "kernel_launch: hipFuncSetAttribute failed\n"); grid = -1; return; }
        hipOccupancyMaxActiveBlocksPerMultiprocessor(&per_cu, (const void*)hybrid_fwd, NTHR, LDS_BYTES + 16);
        if (per_cu < 1) { fprintf(stderr, "kernel_launch: occupancy query says %d blocks per CU\n", per_cu); per_cu = 1; }
        grid = cus * 1;
        fprintf(stderr, "kernel_launch: cus %d per_cu %d grid %d\n", cus, per_cu, grid);
    }
    if (grid < 0) return;
    hipMemsetAsync((char*)d_ws + WS_BAR, 0, 16384, stream);
    Params p{};
    for (int i = 0; i < 32; ++i) p.in[i] = (const float*)d_in[i];
    p.out = (float*)d_out; p.ws = (uchar*)d_ws;
#if MULTI_LAUNCH
    for (int ph = 0; ph < 31; ++ph) { p.ph_lo = ph; p.ph_hi = ph + 1; hipLaunchKernelGGL(hybrid_fwd, dim3(grid), dim3(NTHR), LDS_BYTES + 16, stream, p); }
#else
    p.ph_lo = 0; p.ph_hi = 31;
    void* args[] = {&p};
    hipError_t e = hipLaunchCooperativeKernel((const void*)hybrid_fwd, dim3(grid), dim3(NTHR), args, LDS_BYTES + 16, stream);
    if (e != hipSuccess) fprintf(stderr, "cooperative launch failed: %s (grid %d)\n", hipGetErrorString(e), grid);
#endif
}
```

```cpp
#include <hip/hip_runtime.h>
#include <hip/hip_cooperative_groups.h>
#include <cstdio>
namespace cg = cooperative_groups;

#define LAS __attribute__((address_space(3)))
typedef unsigned short bf16_t;
typedef unsigned char uchar;
typedef short bf16x8 __attribute__((ext_vector_type(8)));
typedef float f32x4 __attribute__((ext_vector_type(4)));
typedef unsigned u32x4 __attribute__((ext_vector_type(4)));
typedef unsigned u32x2 __attribute__((ext_vector_type(2)));

#ifndef MULTI_LAUNCH
#define MULTI_LAUNCH 0
#endif

constexpr int MT = 17408, MPR = 16384, DM = 1024, NPROJ = 7168, NIN = 7424, DFF = 2816;
constexpr float EPS = 1e-6f;
constexpr int NTHR = 512;
constexpr int LDS_BYTES = 143360;
constexpr int C_Z = 0, C_XBC = 1024, C_U = 2560, C_V = 3072, C_POOL = 3584, C_GA = 4096, C_GB = 5120, C_GC = 6144;
constexpr size_t al256(size_t x) { return (x + 255) & ~(size_t)255; }
constexpr size_t WS_WIN = 0;
constexpr size_t WS_WBR = WS_WIN + (size_t)4 * NIN * 1024 * 2;
constexpr size_t WS_WOUT = WS_WBR + (size_t)4 * 1024 * 2048 * 2;
constexpr size_t WS_WGU = WS_WOUT + (size_t)4 * 1024 * 1024 * 2;
constexpr size_t WS_WDN = WS_WGU + (size_t)4 * 5632 * 1024 * 2;
constexpr size_t WS_WPG = WS_WDN + (size_t)4 * 1024 * 2816 * 2;
constexpr size_t WS_WPU = WS_WPG + (size_t)4 * 1024 * 1024 * 2;
constexpr size_t WS_X = WS_WPU + (size_t)4 * 1024 * 256 * 2;
constexpr size_t WS_XN = WS_X + (size_t)MT * 1024 * 4;
constexpr size_t WS_RSS = WS_XN + (size_t)MT * 1024 * 2;
constexpr size_t WS_PROJ = al256(WS_RSS + (size_t)13 * MT * 16 * 4);
constexpr size_t WS_DT = WS_PROJ + (size_t)MT * NPROJ * 2;
constexpr size_t WS_Y = WS_DT + (size_t)MT * 16 * 4;
constexpr size_t WS_SSQ = WS_Y + (size_t)MT * 2048 * 2;
constexpr size_t WS_MRG = WS_SSQ + (size_t)MT * 16 * 4;
constexpr size_t WS_ACT = WS_MRG + (size_t)MT * 1024 * 2;
constexpr size_t WS_UP = WS_ACT + (size_t)MT * DFF * 2;
constexpr size_t WS_PBF = WS_UP + (size_t)4 * MT * 1024 * 2;
constexpr size_t WS_XN2 = WS_PBF + (size_t)4 * MT * 256 * 2;
constexpr size_t WS_BAR = WS_XN2 + (size_t)MT * 1024 * 2;
constexpr size_t WS_CBC = WS_BAR + 16384;
constexpr size_t WS_END = WS_CBC + (size_t)MPR * 512 * 2;
constexpr size_t O_Y = 0;
constexpr size_t O_CONVP = (size_t)MT * 1024;
constexpr size_t O_SSMP = O_CONVP + (size_t)4 * 8 * 3 * 1536;
constexpr size_t O_POOLP = O_SSMP + (size_t)4 * 8 * 16 * 64 * 128;
constexpr size_t O_VP = O_POOLP + (size_t)4 * 8 * 15 * 512;
constexpr size_t O_CONVS = O_VP + (size_t)4 * 8 * 128 * 512;
constexpr size_t O_SSMS = O_CONVS + (size_t)4 * 128 * 3 * 1536;
constexpr size_t O_POOLS = O_SSMS + (size_t)4 * 128 * 16 * 64 * 128;
constexpr size_t O_VS = O_POOLS + (size_t)4 * 128 * 15 * 512;
constexpr size_t O_END = O_VS + (size_t)4 * 128 * 8 * 512;

struct Params {
    const float* in[32];
    float* out;
    uchar* ws;
    int ph_lo, ph_hi;
};
enum { I_XP = 0, I_XS, I_SCONV, I_SSSM, I_SPOOL, I_PP, I_PS, I_NMIX, I_WIN, I_CONVW, I_CONVB, I_DTB, I_ALOG, I_DSKIP, I_SSDN, I_LNG, I_LNB, I_WSP, I_BSP,
       I_POOLW, I_POOLS, I_WBRA, I_WBRB, I_WBRC, I_WOUT, I_NFFN, I_WGU, I_WDN, I_NPLE, I_WPG, I_WPU, I_FN };


__device__ __forceinline__ int launder_s(int i) { asm volatile("" : "+s"(i)); return i; }
__device__ __forceinline__ int launder_v(int i) { asm volatile("" : "+v"(i)); return i; }
template <class T> __device__ __forceinline__ T* launder_p(T* p) { asm volatile("" : "+s"(p)); return p; }
__device__ __forceinline__ size_t launder_z() { size_t z = 0; asm volatile("" : "+s"(z)); return z; }
typedef const float __attribute__((address_space(1)))* gcf_t;
#define PIN(i) ((const float*)(gcf_t)(P.in[launder_s(i)]))
#define TIDX launder_v((int)threadIdx.x)
#define BIDX launder_s((int)blockIdx.x)
#define GDIM launder_s((int)gridDim.x)
__device__ __forceinline__ unsigned cvt_pk_bf16(float lo, float hi) { unsigned r; asm("v_cvt_pk_bf16_f32 %0, %1, %2" : "=v"(r) : "v"(lo), "v"(hi)); return r; }
__device__ __forceinline__ float bf_lo(unsigned w) { return __uint_as_float(w << 16); }
__device__ __forceinline__ float bf_hi(unsigned w) { return __uint_as_float(w & 0xffff0000u); }
__device__ __forceinline__ float bf1(bf16_t b) { return __uint_as_float(((unsigned)b) << 16); }
__device__ __forceinline__ float frcp(float x) { return __builtin_amdgcn_rcpf(x); }
__device__ __forceinline__ float sigmoidf_(float x) { return frcp(1.0f + __expf(-x)); }
__device__ __forceinline__ float siluf_(float x) { return x * sigmoidf_(x); }
__device__ __forceinline__ float gelu_tanh(float x) { const float u = 1.5957691216057308f * (x + 0.044715f * x * x * x); return x * sigmoidf_(u); }
__device__ __forceinline__ float softplusf_(float x) {
    const float e = __expf(-fabsf(x));
    const float l = e < 0.03f ? e * (1.0f - e * (0.5f - e * (0.33333334f - e * 0.25f))) : __logf(1.0f + e);
    return fmaxf(x, 0.f) + l;
}
__device__ __forceinline__ float shx(float v, int m) { return __shfl_xor(v, m, 64); }

__device__ __forceinline__ float rownorm(const float* rssp, int row) {
    const f32x4 a = *(const f32x4*)(rssp + (size_t)row * 16), b = *(const f32x4*)(rssp + (size_t)row * 16 + 4), c = *(const f32x4*)(rssp + (size_t)row * 16 + 8), d = *(const f32x4*)(rssp + (size_t)row * 16 + 12);
    const float s = ((a[0] + a[1]) + (a[2] + a[3])) + ((b[0] + b[1]) + (b[2] + b[3])) + ((c[0] + c[1]) + (c[2] + c[3])) + ((d[0] + d[1]) + (d[2] + d[3]));
    return rsqrtf(s * (1.0f / 1024.0f) + EPS);
}
constexpr int BM = 256, BK = 64, HALF = 128, HTB = HALF * BK * 2, NXCD = 8, WGM = 8;
__device__ __forceinline__ int lds_byte(int r, int c) { const int st = (r >> 4) * 2 + (c >> 5), rr = r & 15, cc = c & 31, ob = rr * 64 + cc * 2; return st * 1024 + (ob ^ (((ob >> 9) & 1) << 5)); }
__device__ __forceinline__ void stage_rc(int b, int& R, int& C) { const int st = b / 1024, sb = b % 1024, swz = sb ^ (((sb >> 9) & 1) << 5); R = (st >> 1) * 16 + swz / 64; C = (st & 1) * 32 + (swz % 64) / 2; }

struct Unit { int pm, pn, seg, lay; };
enum { EPI_UP = 0, EPI_P1, EPI_P3, EPI_P4, EPI_P5, EPI_P6, EPI_P7 };

struct GPh {
    const bf16_t* A; const bf16_t* Bt; int lda, ldb, K, nM, nN, nseg, nlay; size_t a_lay, b_lay;
    int G, c;
    const float* rss; float* rss_next; const bf16_t* XS; bf16_t* XD; bf16_t* O; float* DT; const bf16_t* PROJ; const float* SSQ; const bf16_t* UPB;
    __device__ __forceinline__ bool next(int i, Unit& u) const {
        const int tiles = nM * nN; const long L = (long)(i / nseg) * G + c; if (L >= (long)tiles * nlay) return false;
        u.seg = i % nseg; u.lay = (int)(L / tiles); int wgid = (int)(L % tiles);
        { const int q = tiles / NXCD, r = tiles % NXCD, xcd = wgid % NXCD, off = wgid / NXCD; wgid = (xcd < r ? xcd * (q + 1) : r * (q + 1) + (xcd - r) * q) + off; }
        const int nig = WGM * nN, gid = wgid / nig, fm = gid * WGM, gsz = (nM - fm) < WGM ? (nM - fm) : WGM;
        u.pm = fm + ((wgid % nig) % gsz); u.pn = (wgid % nig) / gsz; return true;
    }
    __device__ __forceinline__ const char* pa(const Unit& u) const { return (const char*)(A + u.lay * a_lay + (size_t)u.pm * BM * lda + (size_t)u.seg * K); }
    __device__ __forceinline__ const char* pb(const Unit& u) const { return (const char*)(Bt + u.lay * b_lay + (size_t)u.pn * BM * ldb + (size_t)u.seg * K); }
};

__device__ __forceinline__ void p3_rowscale(const GPh& P, const int row, const int seg, float& rs0, float& rs1) {
    rs0 = 1.f; rs1 = 1.f;
    if (seg < 2) { const f32x4 a0 = *(const f32x4*)(P.SSQ + (size_t)row * 16), a1 = *(const f32x4*)(P.SSQ + (size_t)row * 16 + 4), b0 = *(const f32x4*)(P.SSQ + (size_t)row * 16 + 8), b1 = *(const f32x4*)(P.SSQ + (size_t)row * 16 + 12);
        rs0 = rsqrtf((a0[0] + a0[1] + a0[2] + a0[3] + a1[0] + a1[1] + a1[2] + a1[3]) * (1.0f / 512.0f) + EPS);
        rs1 = rsqrtf((b0[0] + b0[1] + b0[2] + b0[3] + b1[0] + b1[1] + b1[2] + b1[3]) * (1.0f / 512.0f) + EPS); }
}
__device__ __forceinline__ void p3_elem(const GPh& P, f32x4& v, const int row, const int col, const int seg, const float rs0, const float rs1) {
    const bf16_t* prow = P.PROJ + (size_t)row * NPROJ;
    if (seg == 0) { v = v * (rs0 * frcp(rs1)); }
    else if (seg == 1) { const u32x2 ga = *(const u32x2*)(prow + C_GA + col), gb = *(const u32x2*)(prow + C_GB + col);
        v[0] *= rs1 * bf_lo(ga.x) * frcp(bf_lo(gb.x)); v[1] *= rs1 * bf_hi(ga.x) * frcp(bf_hi(gb.x)); v[2] *= rs1 * bf_lo(ga.y) * frcp(bf_lo(gb.y)); v[3] *= rs1 * bf_hi(ga.y) * frcp(bf_hi(gb.y)); }
    else if (seg == 2) { const u32x2 ga = *(const u32x2*)(prow + C_GB + col), gb = *(const u32x2*)(prow + C_GC + col);
        v[0] *= bf_lo(ga.x) * frcp(bf_lo(gb.x)); v[1] *= bf_hi(ga.x) * frcp(bf_hi(gb.x)); v[2] *= bf_lo(ga.y) * frcp(bf_lo(gb.y)); v[3] *= bf_hi(ga.y) * frcp(bf_hi(gb.y)); }
    else { const u32x2 gc = *(const u32x2*)(prow + C_GC + col);
        u32x2 o; o.x = cvt_pk_bf16(v[0] * bf_lo(gc.x), v[1] * bf_hi(gc.x)); o.y = cvt_pk_bf16(v[2] * bf_lo(gc.y), v[3] * bf_hi(gc.y)); *(u32x2*)(P.O + (size_t)row * 1024 + col) = o; }
}
template <int EPI>
__device__ __forceinline__ void epi_row(const GPh& P, f32x4 (&a)[2][2], const int row, const int col0, const int pn, const int wc, const int fq, const int seg, const int lay) {
    if constexpr (EPI == EPI_UP) {
        bf16_t* O = P.O + (size_t)lay * MT * 1024;
#pragma unroll
        for (int bj = 0; bj < 2; ++bj)
#pragma unroll
            for (int n = 0; n < 2; ++n) { const int col = col0 + bj * HALF + n * 16; const f32x4 v = a[bj][n];
                u32x2 o; o.x = cvt_pk_bf16(v[0], v[1]); o.y = cvt_pk_bf16(v[2], v[3]); *(u32x2*)(O + (size_t)row * 1024 + col) = o; }
    } else if constexpr (EPI == EPI_P1) {
        const float r = rownorm(P.rss, row);
#pragma unroll
        for (int bj = 0; bj < 2; ++bj)
#pragma unroll
            for (int n = 0; n < 2; ++n) { const int col = col0 + bj * HALF + n * 16; f32x4 v = a[bj][n] * r;
                if (pn == 28) { if (col - NPROJ < 16) *(f32x4*)(P.DT + (size_t)row * 16 + (col - NPROJ)) = v; }
                else {
                    if (pn >= 10 && pn < 14) { v[0] = gelu_tanh(v[0]); v[1] = gelu_tanh(v[1]); v[2] = gelu_tanh(v[2]); v[3] = gelu_tanh(v[3]); }
                    else if (pn >= 16) { v[0] = sigmoidf_(v[0]); v[1] = sigmoidf_(v[1]); v[2] = sigmoidf_(v[2]); v[3] = sigmoidf_(v[3]); }
                    u32x2 o; o.x = cvt_pk_bf16(v[0], v[1]); o.y = cvt_pk_bf16(v[2], v[3]); *(u32x2*)(P.O + (size_t)row * NPROJ + col) = o; } }
    } else if constexpr (EPI == EPI_P3) {
        float rs0, rs1; p3_rowscale(P, row, seg, rs0, rs1);
#pragma unroll
        for (int bj = 0; bj < 2; ++bj)
#pragma unroll
            for (int n = 0; n < 2; ++n) p3_elem(P, a[bj][n], row, col0 + bj * HALF + n * 16, seg, rs0, rs1);
    } else if constexpr (EPI == EPI_P5) {
        const float r = rownorm(P.rss, row);
#pragma unroll
        for (int bj = 0; bj < 2; ++bj) { const f32x4 g = a[bj][0] * r, uu = a[bj][1] * r;
            const int ocol = 16 * (8 * pn + 4 * bj + wc) + 4 * fq;
            u32x2 o; o.x = cvt_pk_bf16(siluf_(g[0]) * uu[0], siluf_(g[1]) * uu[1]); o.y = cvt_pk_bf16(siluf_(g[2]) * uu[2], siluf_(g[3]) * uu[3]);
            *(u32x2*)(P.O + (size_t)row * DFF + ocol) = o; }
    } else {
        float ss = 0.f; float r7 = 0.f;
        if constexpr (EPI == EPI_P7) r7 = rownorm(P.rss, row);
#pragma unroll
        for (int bj = 0; bj < 2; ++bj)
#pragma unroll
            for (int n = 0; n < 2; ++n) { const int col = col0 + bj * HALF + n * 16; const f32x4 v = a[bj][n];
                const u32x2 xo = *(const u32x2*)(P.XS + (size_t)row * 1024 + col);
                f32x4 xv = (f32x4){bf_lo(xo.x), bf_hi(xo.x), bf_lo(xo.y), bf_hi(xo.y)};
                if constexpr (EPI == EPI_P7) { const u32x2 up = *(const u32x2*)(P.UPB + (size_t)row * 1024 + col);
                    xv[0] += bf_lo(up.x) * sigmoidf_(v[0] * r7); xv[1] += bf_hi(up.x) * sigmoidf_(v[1] * r7); xv[2] += bf_lo(up.y) * sigmoidf_(v[2] * r7); xv[3] += bf_hi(up.y) * sigmoidf_(v[3] * r7); }
                else xv += v;
                u32x2 o; o.x = cvt_pk_bf16(xv[0], xv[1]); o.y = cvt_pk_bf16(xv[2], xv[3]); *(u32x2*)(P.XD + (size_t)row * 1024 + col) = o;
                const float q0 = bf_lo(o.x), q1 = bf_hi(o.x), q2 = bf_lo(o.y), q3 = bf_hi(o.y);
                ss += q0 * q0 + q1 * q1 + q2 * q2 + q3 * q3; }
        ss += shx(ss, 16); ss += shx(ss, 32);
        if (fq == 0) P.rss_next[(size_t)row * 16 + pn * 4 + wc] = ss;
    }
}
template <int EPI>
__device__ __forceinline__ void epilogue(const GPh& P, f32x4 (&acc)[2][2][4][2], const Unit& u, int, int, int, int) {
    const int tid_ = TIDX, wid_ = tid_ >> 6, wr = wid_ >> 2, wc = wid_ & 3, fr = tid_ & 15, fq = (tid_ >> 4) & 3;
    const int row0 = u.pm * BM + wr * 64 + fr, col0 = u.pn * BM + wc * 32 + 4 * fq;
#pragma unroll
    for (int ai = 0; ai < 2; ++ai)
#pragma unroll
        for (int m = 0; m < 4; ++m) {
            const int row = row0 + ai * HALF + m * 16;
            if constexpr (EPI == EPI_P3) {
                float rs0, rs1; p3_rowscale(P, row, u.seg, rs0, rs1);
#pragma unroll
                for (int bj = 0; bj < 2; ++bj)
#pragma unroll
                    for (int n = 0; n < 2; ++n) p3_elem(P, acc[ai][bj][m][n], row, col0 + bj * HALF + n * 16, u.seg, rs0, rs1);
            } else {
                f32x4 a[2][2] = {{acc[ai][0][m][0], acc[ai][0][m][1]}, {acc[ai][1][m][0], acc[ai][1][m][1]}};
                epi_row<EPI>(P, a, row, col0, u.pn, wc, fq, u.seg, u.lay);
            }
        }
}

template <int EPI>
__device__ __forceinline__ void mini_gemm(LAS uchar* lds, const GPh& P) {
    const int tid = TIDX, wid = tid >> 6, lane = tid & 63, kh = wid >> 2, wc = wid & 3, fr = lane & 15, fq = lane >> 4;
    const int nseg = P.nseg, K = P.K, Kh = K >> 1;
    for (int su = P.c; su < 256; su += P.G) {
        const int strip = su >> 2, pn = su & 3; const int row = MPR + strip * 16 + fr;
        const bf16_t* Ap = P.A + (size_t)row * P.lda + fq * 8;
        const bf16_t* Bp = P.Bt + (size_t)(pn * 256 + wc * 32 + fr) * P.ldb + fq * 8;
        f32x4 a[2][2];
#pragma unroll
        for (int bj = 0; bj < 2; ++bj)
#pragma unroll
            for (int n = 0; n < 2; ++n) a[bj][n] = (f32x4){0.f, 0.f, 0.f, 0.f};
        __syncthreads();
        for (int seg = 0; seg < nseg; ++seg) {
            const int kbeg = seg * K + kh * Kh;
#pragma unroll 1
            for (int k0 = kbeg; k0 < kbeg + Kh; k0 += 128) {
                bf16x8 af[4], bfr[4][2][2];
#pragma unroll
                for (int s = 0; s < 4; ++s) { af[s] = *(const bf16x8*)(Ap + k0 + s * 32);
#pragma unroll
                    for (int bj = 0; bj < 2; ++bj)
#pragma unroll
                        for (int n = 0; n < 2; ++n) bfr[s][bj][n] = *(const bf16x8*)(Bp + (size_t)(bj * HALF + n * 16) * P.ldb + k0 + s * 32); }
#pragma unroll
                for (int s = 0; s < 4; ++s)
#pragma unroll
                    for (int bj = 0; bj < 2; ++bj)
#pragma unroll
                        for (int n = 0; n < 2; ++n) a[bj][n] = __builtin_amdgcn_mfma_f32_16x16x32_bf16(bfr[s][bj][n], af[s], a[bj][n], 0, 0, 0);
            }
            if (EPI == EPI_P3 && seg < 3) epi_row<EPI>(P, a, row, pn * 256 + wc * 32 + 4 * fq, pn, wc, fq, seg, 0);
        }
        LAS f32x4* xch = (LAS f32x4*)lds;
        if (kh == 1) {
#pragma unroll
            for (int bj = 0; bj < 2; ++bj)
#pragma unroll
                for (int n = 0; n < 2; ++n) xch[((wc * 4 + bj * 2 + n) * 64) + lane] = a[bj][n];
        }
        __syncthreads();
        if (kh == 0) {
#pragma unroll
            for (int bj = 0; bj < 2; ++bj)
#pragma unroll
                for (int n = 0; n < 2; ++n) a[bj][n] += xch[((wc * 4 + bj * 2 + n) * 64) + lane];
            epi_row<EPI>(P, a, row, pn * 256 + wc * 32 + 4 * fq, pn, wc, fq, nseg - 1, 0);
        }
    }
}

template <int EPI>
__device__ __forceinline__ void gemm_phase(LAS uchar* lds, const GPh& P) {
    const int tid = TIDX, wid = __builtin_amdgcn_readfirstlane(tid >> 6), lane = tid & 63, wr = wid >> 2, wc = wid & 3, fr = lane & 15, fq = lane >> 4;
    const int K = P.K, nt = K / BK;
    unsigned voffA[2], voffB[2];
#pragma unroll
    for (int i = 0; i < 2; ++i) { int R, C; stage_rc(tid * 16 + i * 8192, R, C); voffA[i] = (unsigned)(R * P.lda + C) * 2u; voffB[i] = (unsigned)(R * P.ldb + C) * 2u; }
    const size_t kstep = (size_t)(BK * 2);
    const size_t hstepA = (size_t)HALF * P.lda * 2, hstepB = (size_t)HALF * P.ldb * 2;
    const unsigned ldsw = (unsigned)wid * 1024u;
    const int aoff = lds_byte(wr * 64 + fr, fq * 8), boff = lds_byte(wc * 32 + fr, fq * 8);
#define PG8_SA(b, h) (((b) * 2 + (h)) * HTB)
#define PG8_SB(b, h) ((4 + (b) * 2 + (h)) * HTB)
#define PG8_STAGE(bufoff, gbase, voff) do { _Pragma("unroll") for (int _i = 0; _i < 2; ++_i) \
        __builtin_amdgcn_global_load_lds((const unsigned*)((const char*)(gbase) + (voff)[_i]), (LAS unsigned*)(lds + (bufoff) + ldsw + _i * 8192), 16, 0, 0); } while (0)
#define PG8_LDA(dst, b, h) do { _Pragma("unroll") for (int m = 0; m < 4; ++m) _Pragma("unroll") for (int k = 0; k < 2; ++k) dst[m][k] = *(const LAS bf16x8*)(lds + PG8_SA(b, h) + aoff + m * 2048 + k * 1024); } while (0)
#define PG8_LDB(dst, b, h) do { _Pragma("unroll") for (int n = 0; n < 2; ++n) _Pragma("unroll") for (int k = 0; k < 2; ++k) dst[n][k] = *(const LAS bf16x8*)(lds + PG8_SB(b, h) + boff + n * 2048 + k * 1024); } while (0)
#define PG8_MMA(ai, bj, At, Bt) do { __builtin_amdgcn_s_setprio(1); _Pragma("unroll") for (int m = 0; m < 4; ++m) _Pragma("unroll") for (int n = 0; n < 2; ++n) _Pragma("unroll") for (int k = 0; k < 2; ++k) \
        acc[ai][bj][m][n] = __builtin_amdgcn_mfma_f32_16x16x32_bf16(Bt[n][k], At[m][k], acc[ai][bj][m][n], 0, 0, 0); __builtin_amdgcn_s_setprio(0); } while (0)
#define PG8_WAIT_V(n) asm volatile("s_waitcnt vmcnt(" #n ")" ::: "memory")
#define PG8_WAIT_L(n) asm volatile("s_waitcnt lgkmcnt(" #n ")" ::: "memory")
#define PG8_BAR __builtin_amdgcn_s_barrier()
#define PG8_SCHED __builtin_amdgcn_sched_barrier(0)
    Unit cur, nxt; int ui = 0;
    if (!P.next(0, cur)) return;
    f32x4 acc[2][2][4][2];
#pragma unroll
    for (int a = 0; a < 2; ++a)
#pragma unroll
        for (int b = 0; b < 2; ++b)
#pragma unroll
            for (int m = 0; m < 4; ++m)
#pragma unroll
                for (int n = 0; n < 2; ++n) acc[a][b][m][n] = (f32x4){0.f, 0.f, 0.f, 0.f};
    bf16x8 At[4][2], B0[2][2], B1[2][2];
    const char* cA = P.pa(cur); const char* cB = P.pb(cur);
    PG8_STAGE(PG8_SB(0, 0), cB, voffB); PG8_STAGE(PG8_SA(0, 0), cA, voffA); PG8_STAGE(PG8_SB(0, 1), cB + hstepB, voffB); PG8_STAGE(PG8_SA(0, 1), cA + hstepA, voffA);
    if (wr == 1) PG8_BAR;
    PG8_WAIT_V(4); PG8_BAR;
    PG8_STAGE(PG8_SB(1, 0), cB + kstep, voffB); PG8_STAGE(PG8_SA(1, 0), cA + kstep, voffA); PG8_STAGE(PG8_SB(1, 1), cB + hstepB + kstep, voffB);
    PG8_WAIT_V(6); PG8_BAR;
    for (;;) {
        const bool has_next = P.next(ui + 1, nxt);
        const char* nA = has_next ? P.pa(nxt) : cA; const char* nB = has_next ? P.pb(nxt) : cB;
        for (int t = 0; t < nt; t += 2) {
            const bool last = (t == nt - 2);
            const char* a1 = cA + (size_t)(t + 1) * kstep;
            const char* a2 = last ? nA : cA + (size_t)(t + 2) * kstep; const char* b2 = last ? nB : cB + (size_t)(t + 2) * kstep;
            const char* a3 = a2 + kstep; const char* b3 = b2 + kstep;
            PG8_LDB(B0, 0, 0); PG8_SCHED; PG8_LDA(At, 0, 0); PG8_STAGE(PG8_SA(1, 1), a1 + hstepA, voffA);
            PG8_WAIT_L(8); PG8_BAR; PG8_WAIT_L(0); PG8_MMA(0, 0, At, B0); PG8_BAR; PG8_SCHED;
            PG8_LDB(B1, 0, 1); PG8_STAGE(PG8_SB(0, 0), b2, voffB);
            PG8_BAR; PG8_WAIT_L(0); PG8_MMA(0, 1, At, B1); PG8_BAR;
            PG8_LDA(At, 0, 1); PG8_STAGE(PG8_SA(0, 0), a2, voffA);
            PG8_BAR; PG8_WAIT_L(0); PG8_MMA(1, 0, At, B0); PG8_BAR; PG8_SCHED;
            PG8_STAGE(PG8_SB(0, 1), b2 + hstepB, voffB);
            PG8_WAIT_V(6); PG8_BAR; PG8_MMA(1, 1, At, B1); PG8_BAR;
            PG8_LDB(B0, 1, 0); PG8_SCHED; PG8_LDA(At, 1, 0); PG8_STAGE(PG8_SA(0, 1), a2 + hstepA, voffA);
            PG8_WAIT_L(8); PG8_BAR; PG8_WAIT_L(0); PG8_MMA(0, 0, At, B0); PG8_BAR; PG8_SCHED;
            PG8_LDB(B1, 1, 1); PG8_STAGE(PG8_SB(1, 0), b3, voffB);
            PG8_BAR; PG8_WAIT_L(0); PG8_MMA(0, 1, At, B1); PG8_BAR;
            PG8_LDA(At, 1, 1); PG8_STAGE(PG8_SA(1, 0), a3, voffA);
            PG8_BAR; PG8_WAIT_L(0); PG8_MMA(1, 0, At, B0); PG8_BAR; PG8_SCHED;
            PG8_STAGE(PG8_SB(1, 1), b3 + hstepB, voffB);
            PG8_WAIT_V(6); PG8_BAR; PG8_MMA(1, 1, At, B1); PG8_BAR;
        }
        epilogue<EPI>(P, acc, cur, wr, wc, fr, fq);
        if (!has_next) break;
        if (EPI != EPI_P3 || cur.seg == 3) {
#pragma unroll
            for (int a = 0; a < 2; ++a)
#pragma unroll
                for (int b = 0; b < 2; ++b)
#pragma unroll
                    for (int m = 0; m < 4; ++m)
#pragma unroll
                        for (int n = 0; n < 2; ++n) acc[a][b][m][n] = (f32x4){0.f, 0.f, 0.f, 0.f};
        }
        cur = nxt; cA = nA; cB = nB; ++ui;
    }
    PG8_WAIT_V(0);
    if (wr == 0) PG8_BAR;
    PG8_BAR;
#undef PG8_SA
#undef PG8_SB
#undef PG8_STAGE
#undef PG8_LDA
#undef PG8_LDB
#undef PG8_MMA
#undef PG8_WAIT_V
#undef PG8_WAIT_L
#undef PG8_BAR
#undef PG8_SCHED
}

template <int NT, int KS>
__device__ __forceinline__ void wmma(const LAS uchar* A, const LAS uchar* B, int pitch, f32x4 (&acc)[NT], int fr, int fq) {
#pragma unroll 1
    for (int ks = 0; ks < KS; ++ks) {
        const bf16x8 a = *(const LAS bf16x8*)(A + fr * pitch + (ks * 32 + fq * 8) * 2);
#pragma unroll
        for (int ni = 0; ni < NT; ++ni) {
            const bf16x8 b = *(const LAS bf16x8*)(B + (ni * 16 + fr) * pitch + (ks * 32 + fq * 8) * 2);
            acc[ni] = __builtin_amdgcn_mfma_f32_16x16x32_bf16(b, a, acc[ni], 0, 0, 0);
        }
    }
}
constexpr int PB = 272;

__device__ __forceinline__ int map_row(int n, int map) {
    if (map == 1) return n < 2560 ? n : (n < 2576 ? 7168 + (n - 2560) : n - 16);
    if (map == 2) { const int up = n >= DFF, nn = up ? n - DFF : n; return 32 * (nn >> 4) + 16 * up + (nn & 15); }
    return n;
}
__device__ __forceinline__ void tr_tile(LAS float* T, const float* src, int N, bf16_t* dst, int ldd, int dcol0, int k0, int n0, int map, const float* gk = nullptr) {
    const int tid = TIDX;
    __syncthreads();
#pragma unroll
    for (int ps = 0; ps < 2; ++ps) { const int r = ps * 32 + (tid >> 4), c4 = (tid & 15) * 4; const int n = n0 + c4;
        f32x4 v = (f32x4){0.f, 0.f, 0.f, 0.f}; if (n < N) v = *(const f32x4*)(src + (size_t)(k0 + r) * N + n);
        if (gk) v = v * gk[k0 + r];
        T[r * 65 + c4 + 0] = v[0]; T[r * 65 + c4 + 1] = v[1]; T[r * 65 + c4 + 2] = v[2]; T[r * 65 + c4 + 3] = v[3]; }
    __syncthreads();
    { const int n = tid >> 3, k8 = (tid & 7) * 8;
        if (n0 + n < N) { u32x4 o; float f[8];
#pragma unroll
            for (int j = 0; j < 8; ++j) f[j] = T[(k8 + j) * 65 + n];
            o.x = cvt_pk_bf16(f[0], f[1]); o.y = cvt_pk_bf16(f[2], f[3]); o.z = cvt_pk_bf16(f[4], f[5]); o.w = cvt_pk_bf16(f[6], f[7]);
            *(u32x4*)(dst + (size_t)map_row(n0 + n, map) * ldd + dcol0 + k0 + k8) = o; } }
}

__device__ __forceinline__ void phase_pre(LAS uchar* lds, const Params& P) {
    const int tid = TIDX, G = GDIM, bid = BIDX;
    uchar* ws = (P.ws + launder_z());
    LAS float* T = (LAS float*)lds;
    constexpr int T_IN = 16 * 113, T_BRA = 256, T_BRB = 128, T_OUT = 256, T_GU = 16 * 88, T_DN = 44 * 16, T_PG = 256, T_PU = 64;
    constexpr int T_L = T_IN + T_BRA + T_BRB + T_OUT + T_GU + T_DN + T_PG + T_PU;
    for (int job = bid; job < 4 * T_L; job += G) {
        const int l = job / T_L; int j = job % T_L;
        if (j < T_IN) { tr_tile(T, PIN(I_WIN) + (size_t)l * 1024 * 7184, 7184, (bf16_t*)(ws + WS_WIN) + (size_t)l * NIN * 1024, 1024, 0, (j / 113) * 64, (j % 113) * 64, 1, PIN(I_NMIX) + (size_t)l * 1024); continue; } j -= T_IN;
        if (j < T_BRA) { tr_tile(T, PIN(I_WBRA) + (size_t)l * 1024 * 1024, 1024, (bf16_t*)(ws + WS_WBR) + (size_t)l * 1024 * 2048, 2048, 0, (j / 16) * 64, (j % 16) * 64, 0); continue; } j -= T_BRA;
        if (j < T_BRB) { tr_tile(T, PIN(I_WBRB) + (size_t)l * 512 * 1024, 1024, (bf16_t*)(ws + WS_WBR) + (size_t)l * 1024 * 2048, 2048, 1024, (j / 16) * 64, (j % 16) * 64, 0); continue; } j -= T_BRB;
        if (j < T_OUT) { tr_tile(T, PIN(I_WOUT) + (size_t)l * 1024 * 1024, 1024, (bf16_t*)(ws + WS_WOUT) + (size_t)l * 1024 * 1024, 1024, 0, (j / 16) * 64, (j % 16) * 64, 0); continue; } j -= T_OUT;
        if (j < T_GU) { tr_tile(T, PIN(I_WGU) + (size_t)l * 1024 * 5632, 5632, (bf16_t*)(ws + WS_WGU) + (size_t)l * 5632 * 1024, 1024, 0, (j / 88) * 64, (j % 88) * 64, 2, PIN(I_NFFN) + (size_t)l * 1024); continue; } j -= T_GU;
        if (j < T_DN) { tr_tile(T, PIN(I_WDN) + (size_t)l * DFF * 1024, 1024, (bf16_t*)(ws + WS_WDN) + (size_t)l * 1024 * DFF, DFF, 0, (j / 16) * 64, (j % 16) * 64, 0); continue; } j -= T_DN;
        if (j < T_PG) { tr_tile(T, PIN(I_WPG) + (size_t)l * 1024 * 1024, 1024, (bf16_t*)(ws + WS_WPG) + (size_t)l * 1024 * 1024, 1024, 0, (j / 16) * 64, (j % 16) * 64, 0, PIN(I_NPLE) + (size_t)l * 1024); continue; } j -= T_PG;
        tr_tile(T, PIN(I_WPU) + (size_t)l * 256 * 1024, 1024, (bf16_t*)(ws + WS_WPU) + (size_t)l * 1024 * 256, 256, 0, (j / 16) * 64, (j % 16) * 64, 0);
    }
    {
        LAS float* PW = (LAS float*)lds;
        LAS float* WC = (LAS float*)(lds + 128 * 129 * 4);
        for (int job = bid; job < 4 * 4 * 16; job += G) {
            const int l = job >> 6, g = (job >> 4) & 3, n0 = (job & 15) * 64;
            __syncthreads();
            for (int e = tid; e < 128 * 128; e += NTHR) { const int c = e >> 7, d = e & 127; PW[c * 129 + d] = PIN(I_POOLW)[((size_t)(l * 4 + g) * 128 + c) * 128 + d] * PIN(I_POOLS)[l * 512 + g * 128 + d]; }
            for (int e = tid; e < 128 * 64; e += NTHR) { const int d = e >> 6, n = e & 63; WC[d * 64 + n] = PIN(I_WBRC)[((size_t)l * 512 + g * 128 + d) * 1024 + n0 + n]; }
            __syncthreads();
            const int c = tid & 127, nq = (tid >> 7) * 16;
            float a[16];
#pragma unroll
            for (int i = 0; i < 16; ++i) a[i] = 0.f;
            for (int d = 0; d < 128; ++d) { const float pw = PW[c * 129 + d];
#pragma unroll
                for (int i = 0; i < 16; ++i) a[i] += pw * WC[d * 64 + nq + i]; }
            bf16_t* dst = (bf16_t*)(ws + WS_WBR) + (size_t)l * 1024 * 2048;
#pragma unroll
            for (int i = 0; i < 16; ++i) dst[(size_t)(n0 + nq + i) * 2048 + 1536 + g * 128 + c] = (bf16_t)(cvt_pk_bf16(a[i], 0.f) & 0xffffu);
        }
    }
    {
        const int lane = tid & 63, wv = tid >> 6;
        bf16_t* XB = (bf16_t*)(ws + WS_XN); float* RSS = (float*)(ws + WS_RSS);
        for (int row = bid * 8 + wv; row < MT; row += G * 8) {
            const float* src = row < MPR ? PIN(I_XP) + (size_t)row * 1024 : PIN(I_XS) + (size_t)(row - MPR) * 1024;
            float ss = 0.f;
#pragma unroll
            for (int i = 0; i < 4; ++i) { const int col = i * 256 + lane * 4; const f32x4 v = *(const f32x4*)(src + col);
                u32x2 o; o.x = cvt_pk_bf16(v[0], v[1]); o.y = cvt_pk_bf16(v[2], v[3]); *(u32x2*)(XB + (size_t)row * 1024 + col) = o;
                const float q0 = bf_lo(o.x), q1 = bf_hi(o.x), q2 = bf_lo(o.y), q3 = bf_hi(o.y); ss += q0 * q0 + q1 * q1 + q2 * q2 + q3 * q3; }
#pragma unroll
            for (int s = 1; s < 64; s <<= 1) ss += shx(ss, s);
            if (lane < 16) RSS[(size_t)row * 16 + lane] = lane == 0 ? ss : 0.f;
        }
    }
    {
        bf16_t* PBF = (bf16_t*)(ws + WS_PBF);
        const size_t n4 = (size_t)4 * MT * 256 / 4;
        for (size_t i = (size_t)bid * NTHR + tid; i < n4; i += (size_t)G * NTHR) {
            const size_t e = i * 4; const int l = (int)(e / ((size_t)MT * 256)); const size_t rem = e % ((size_t)MT * 256); const int row = (int)(rem >> 8), col = (int)(rem & 255);
            const float* src = row < MPR ? PIN(I_PP) + ((size_t)l * MPR + row) * 256 + col : PIN(I_PS) + ((size_t)l * 1024 + (row - MPR)) * 256 + col;
            const f32x4 v = *(const f32x4*)src; u32x2 o; o.x = cvt_pk_bf16(v[0], v[1]); o.y = cvt_pk_bf16(v[2], v[3]); *(u32x2*)(PBF + e) = o;
        }
    }
}

constexpr int L_CS = 0, L_BS = 34816, L_BDT = 69632, L_XT = 104448, L_SB = 121856, L_SC = 139264;
__device__ __forceinline__ int xbc_chan(int cc, int h, int g) { return cc < 64 ? h * 64 + cc : (cc < 192 ? 1024 + g * 128 + (cc - 64) : 1280 + g * 128 + (cc - 192)); }

__device__ __forceinline__ void ssd_prompt(LAS uchar* lds, const Params& P, int l, int b, int h) {
    const int tid = TIDX, lane = tid & 63, w = tid >> 6, fr = lane & 15, fq = lane >> 4, g = h >> 3;
    const bf16_t* PROJ = (const bf16_t*)((P.ws + launder_z()) + WS_PROJ); const float* DT = (const float*)((P.ws + launder_z()) + WS_DT);
    bf16_t* Y = (bf16_t*)((P.ws + launder_z()) + WS_Y); float* SSQ = (float*)((P.ws + launder_z()) + WS_SSQ);
    const float a_h = -__expf(PIN(I_ALOG)[l * 16 + h]), dtb = PIN(I_DTB)[l * 16 + h], Dh = PIN(I_DSKIP)[l * 16 + h];
    f32x4 S[4];
#pragma unroll
    for (int i = 0; i < 4; ++i) S[i] = (f32x4){0.f, 0.f, 0.f, 0.f};
    const int wu = __builtin_amdgcn_readfirstlane(w);
    const bf16_t* xsrc = PROJ + (size_t)(b * 2048) * NPROJ + C_XBC;
    const float* cwp = PIN(I_CONVW) + (size_t)l * 4 * 1536; const float* cbp = PIN(I_CONVB) + (size_t)l * 1536;
    const bf16_t* CBC = (const bf16_t*)((P.ws + launder_z()) + WS_CBC);
    float dN0 = 0.f, dN1 = 0.f;
#define SSD_LD1(cc, i, dst) do { if ((i) == 0) { const int ch_ = h * 64 + wu * 8; \
            _Pragma("unroll") for (int k = 0; k < 5; ++k) { const int pos = (cc) * 128 + 2 * lane - 3 + k; \
                dst[k] = (u32x4){0u, 0u, 0u, 0u}; if (pos >= 0) dst[k] = *(const u32x4*)(xsrc + (size_t)pos * NPROJ + ch_); } } \
        else { const int cgx_ = 8 * (i) + wu; const int col_ = cgx_ < 24 ? g * 128 + (cgx_ - 8) * 8 : 256 + g * 128 + (cgx_ - 24) * 8; \
            const bf16_t* cs_ = CBC + ((size_t)b * 2048 + (cc) * 128 + 2 * lane) * 512 + col_; dst[0] = *(const u32x4*)cs_; dst[1] = *(const u32x4*)(cs_ + 512); } } while (0)
#define SSD_DTLOAD(cc) do { if (w == 0) { dN0 = DT[(size_t)(b * 2048 + (cc) * 128 + 2 * lane) * 16 + h]; dN1 = DT[(size_t)(b * 2048 + (cc) * 128 + 2 * lane + 1) * 16 + h]; } } while (0)
#define SSD_SCAL(sb) do { if (w == 0) { LAS float* acs_ = (LAS float*)(lds + L_SC + (sb) * 2048); \
            const float d0 = softplusf_(dN0 + dtb), d1 = softplusf_(dN1 + dtb); const float a0 = d0 * a_h, a1 = d1 * a_h; float inc = a0 + a1; \
            _Pragma("unroll") for (int s = 1; s < 64; s <<= 1) { const float o = __shfl_up(inc, s, 64); if (lane >= s) inc += o; } \
            const float tot = __shfl(inc, 63, 64); const float c1 = inc, c0 = inc - a1; \
            acs_[2 * lane] = c0; acs_[2 * lane + 1] = c1; acs_[128 + 2 * lane] = d0; acs_[128 + 2 * lane + 1] = d1; \
            acs_[256 + 2 * lane] = __expf(c0); acs_[256 + 2 * lane + 1] = __expf(c1); acs_[384 + 2 * lane] = __expf(tot - c0) * d0; acs_[384 + 2 * lane + 1] = __expf(tot - c1) * d1; } } while (0)
#define SSD_CONV(sb, cc) do { const int lr = 2 * launder_v(lane); const LAS float* decdt_ = (const LAS float*)(lds + L_SC + (sb) * 2048) + 384; \
        u32x4 xr[2][5]; SSD_LD1(cc, 0, xr[0]); \
        _Pragma("unroll") for (int i = 0; i < 5; ++i) { const int cgx = 8 * i + wu; const int ch_ = xbc_chan(cgx * 8, h, g); \
            if (i < 4) SSD_LD1(cc, i + 1, xr[(i + 1) & 1]); \
            float xf[5][8]; \
            _Pragma("unroll") for (int k = 0; k < (i == 0 ? 5 : 2); ++k) { const u32x4 v = xr[i & 1][k]; \
                xf[k][0] = bf_lo(v.x); xf[k][1] = bf_hi(v.x); xf[k][2] = bf_lo(v.y); xf[k][3] = bf_hi(v.y); xf[k][4] = bf_lo(v.z); xf[k][5] = bf_hi(v.z); xf[k][6] = bf_lo(v.w); xf[k][7] = bf_hi(v.w); } \
            float o0[8], o1[8]; \
            if (i == 0) { _Pragma("unroll") for (int j = 0; j < 8; ++j) { \
                const float w0 = cwp[ch_ + j], w1 = cwp[1536 + ch_ + j], w2 = cwp[3072 + ch_ + j], w3 = cwp[4608 + ch_ + j]; \
                const float bb = cbp[ch_ + j]; \
                o0[j] = siluf_(bb + w0 * xf[0][j] + w1 * xf[1][j] + w2 * xf[2][j] + w3 * xf[3][j]); \
                o1[j] = siluf_(bb + w0 * xf[1][j] + w1 * xf[2][j] + w2 * xf[3][j] + w3 * xf[4][j]); } } \
            else { _Pragma("unroll") for (int j = 0; j < 8; ++j) { o0[j] = xf[0][j]; o1[j] = xf[1][j]; } } \
            if (cgx < 8) { _Pragma("unroll") for (int j = 0; j < 8; ++j) *(LAS unsigned*)(lds + L_XT + (cgx * 8 + j) * PB + lr * 2) = cvt_pk_bf16(o0[j], o1[j]); } \
            else if (cgx < 24) { const int n0 = (cgx - 8) * 8; const float s0 = decdt_[lr], s1 = decdt_[lr + 1]; \
                u32x4 q; q.x = cvt_pk_bf16(o0[0], o0[1]); q.y = cvt_pk_bf16(o0[2], o0[3]); q.z = cvt_pk_bf16(o0[4], o0[5]); q.w = cvt_pk_bf16(o0[6], o0[7]); *(LAS u32x4*)(lds + L_BS + lr * PB + n0 * 2) = q; \
                q.x = cvt_pk_bf16(o1[0], o1[1]); q.y = cvt_pk_bf16(o1[2], o1[3]); q.z = cvt_pk_bf16(o1[4], o1[5]); q.w = cvt_pk_bf16(o1[6], o1[7]); *(LAS u32x4*)(lds + L_BS + (lr + 1) * PB + n0 * 2) = q; \
                _Pragma("unroll") for (int j = 0; j < 8; ++j) *(LAS unsigned*)(lds + L_BDT + (n0 + j) * PB + lr * 2) = cvt_pk_bf16(o0[j] * s0, o1[j] * s1); } \
            else { const int n0 = (cgx - 24) * 8; \
                u32x4 q; q.x = cvt_pk_bf16(o0[0], o0[1]); q.y = cvt_pk_bf16(o0[2], o0[3]); q.z = cvt_pk_bf16(o0[4], o0[5]); q.w = cvt_pk_bf16(o0[6], o0[7]); *(LAS u32x4*)(lds + L_CS + lr * PB + n0 * 2) = q; \
                q.x = cvt_pk_bf16(o1[0], o1[1]); q.y = cvt_pk_bf16(o1[2], o1[3]); q.z = cvt_pk_bf16(o1[4], o1[5]); q.w = cvt_pk_bf16(o1[6], o1[7]); *(LAS u32x4*)(lds + L_CS + (lr + 1) * PB + n0 * 2) = q; } } } while (0)

    __syncthreads();
    SSD_DTLOAD(0);
    SSD_SCAL(0);
    __syncthreads();
    SSD_CONV(0, 0);
#pragma unroll 1
    for (int c = 0; c < 16; ++c) {
        const int grow0 = b * 2048 + c * 128, sb = c & 1;
        LAS float* acs = (LAS float*)(lds + L_SC + sb * 2048); LAS float* dtv = acs + 128; LAS float* eacs = acs + 256;
        __syncthreads();
        if (c < 15) SSD_DTLOAD(c + 1);
        const int lrow = 16 * w + fr, row = grow0 + lrow;
        u32x2 zz[4];
#pragma unroll
        for (int ni = 0; ni < 4; ++ni) zz[ni] = *(const u32x2*)(PROJ + (size_t)row * NPROJ + C_Z + h * 64 + ni * 16 + 4 * fq);
        if (c < 15) SSD_SCAL(sb ^ 1);
        {
            f32x4 cb[8];
#pragma unroll
            for (int i = 0; i < 8; ++i) cb[i] = (f32x4){0.f, 0.f, 0.f, 0.f};
            wmma<8, 4>(lds + L_CS + w * 16 * PB, lds + L_BS, PB, cb, fr, fq);
            __syncthreads();
            const float al = acs[lrow];
#pragma unroll
            for (int ni = 0; ni < 8; ++ni) { const int s0 = ni * 16 + 4 * fq; float mv[4];
#pragma unroll
                for (int e = 0; e < 4; ++e) { const int s = s0 + e; const float dd = fminf(al - acs[s], 0.f); mv[e] = (s <= lrow) ? cb[ni][e] * __expf(dd) * dtv[s] : 0.f; }
                u32x2 o; o.x = cvt_pk_bf16(mv[0], mv[1]); o.y = cvt_pk_bf16(mv[2], mv[3]); *(LAS u32x2*)(lds + L_BS + lrow * PB + s0 * 2) = o; }
        }
        __syncthreads();
        {
            f32x4 y[4];
#pragma unroll
            for (int i = 0; i < 4; ++i) y[i] = (f32x4){0.f, 0.f, 0.f, 0.f};
            if (c > 0) { wmma<4, 4>(lds + L_CS + w * 16 * PB, lds + L_SB, PB, y, fr, fq); const float ea = eacs[lrow];
#pragma unroll
                for (int i = 0; i < 4; ++i) y[i] = y[i] * ea; }
            wmma<4, 4>(lds + L_BS + w * 16 * PB, lds + L_XT, PB, y, fr, fq);
            float ssq = 0.f;
#pragma unroll
            for (int ni = 0; ni < 4; ++ni) { const int p0 = ni * 16 + 4 * fq;
                const f32x4 ng = *(const f32x4*)(PIN(I_SSDN) + (size_t)l * 1024 + h * 64 + p0);
                float zf[4] = {bf_lo(zz[ni].x), bf_hi(zz[ni].x), bf_lo(zz[ni].y), bf_hi(zz[ni].y)}; float ov[4];
#pragma unroll
                for (int e = 0; e < 4; ++e) { const float xs = bf1(*(const LAS bf16_t*)(lds + L_XT + (p0 + e) * PB + lrow * 2)); const float v = (y[ni][e] + Dh * xs) * siluf_(zf[e]); ssq += v * v; ov[e] = v * ng[e]; }
                u32x2 o; o.x = cvt_pk_bf16(ov[0], ov[1]); o.y = cvt_pk_bf16(ov[2], ov[3]); *(u32x2*)(Y + (size_t)row * 2048 + h * 64 + p0) = o; }
            ssq += shx(ssq, 16); ssq += shx(ssq, 32);
            if (fq == 0) SSQ[(size_t)row * 16 + h] = ssq;
        }
        __syncthreads();
        {
            const float et = eacs[127];
#pragma unroll
            for (int i = 0; i < 4; ++i) S[i] = S[i] * et;
            wmma<4, 4>(lds + L_XT + (w >> 1) * 16 * PB, lds + L_BDT + (w & 1) * 64 * PB, PB, S, fr, fq);
            const int p = (w >> 1) * 16 + fr;
#pragma unroll
            for (int ni = 0; ni < 4; ++ni) { const int n0 = (w & 1) * 64 + ni * 16 + 4 * fq; u32x2 o; o.x = cvt_pk_bf16(S[ni][0], S[ni][1]); o.y = cvt_pk_bf16(S[ni][2], S[ni][3]); *(LAS u32x2*)(lds + L_SB + p * PB + n0 * 2) = o; }
        }
        __syncthreads();
        if (c < 15) SSD_CONV(sb ^ 1, c + 1);
    }
#undef SSD_LD1
#undef SSD_DTLOAD
#undef SSD_SCAL
#undef SSD_CONV
    {
        float* dst = (P.out + launder_z()) + O_SSMP + ((size_t)((l * 8 + b) * 16 + h) * 64) * 128; const int p = (w >> 1) * 16 + fr;
#pragma unroll
        for (int ni = 0; ni < 4; ++ni) { const int n0 = (w & 1) * 64 + ni * 16 + 4 * fq; *(f32x4*)(dst + (size_t)p * 128 + n0) = S[ni]; }
    }
}

__device__ __forceinline__ void ssd_sample(LAS uchar* lds, const Params& P, int l, int b, int hp) {
    const int tid = TIDX, half = tid >> 8, t8 = tid & 255, h = hp * 2 + half, g = h >> 3;
    const bf16_t* PROJ = (const bf16_t*)((P.ws + launder_z()) + WS_PROJ); const float* DT = (const float*)((P.ws + launder_z()) + WS_DT);
    bf16_t* Y = (bf16_t*)((P.ws + launder_z()) + WS_Y); float* SSQ = (float*)((P.ws + launder_z()) + WS_SSQ);
    LAS float* xs = (LAS float*)(lds + half * 16384); LAS float* Bv = xs + 512; LAS float* Cv = xs + 1536; LAS float* sdt = xs + 2560; LAS float* sdec = xs + 2568; LAS float* yv = xs + 2576;
    const int row0 = MPR + b * 8;
    __syncthreads();
    for (int cc = t8; cc < 320; cc += 256) {
        const int ch = xbc_chan(cc, h, g);
        float xv[11];
#pragma unroll
        for (int k = 0; k < 3; ++k) xv[k] = PIN(I_SCONV)[((size_t)(l * 128 + b) * 3 + k) * 1536 + ch];
#pragma unroll
        for (int t = 0; t < 8; ++t) xv[3 + t] = bf1(PROJ[(size_t)(row0 + t) * NPROJ + C_XBC + ch]);
        const float w0 = PIN(I_CONVW)[(size_t)(l * 4 + 0) * 1536 + ch], w1 = PIN(I_CONVW)[(size_t)(l * 4 + 1) * 1536 + ch], w2 = PIN(I_CONVW)[(size_t)(l * 4 + 2) * 1536 + ch], w3 = PIN(I_CONVW)[(size_t)(l * 4 + 3) * 1536 + ch];
        const float cb = PIN(I_CONVB)[(size_t)l * 1536 + ch];
#pragma unroll
        for (int t = 0; t < 8; ++t) { const float o = siluf_(cb + w0 * xv[t] + w1 * xv[t + 1] + w2 * xv[t + 2] + w3 * xv[t + 3]);
            if (cc < 64) xs[t * 64 + cc]= o; else if (cc < 192) Bv[t * 128 + cc - 64] = o; else Cv[t * 128 + cc - 192] = o; }
    }
    if (t8 < 8) { const float d = softplusf_(DT[(size_t)(row0 + t8) * 16 + h] + PIN(I_DTB)[l * 16 + h]); sdt[t8] = d; sdec[t8] = __expf(-d * __expf(PIN(I_ALOG)[l * 16 + h])); }
    __syncthreads();
    const int l16 = t8 & 15, pr = t8 >> 4;
    const float* hin = PIN(I_SSSM) + ((size_t)((l * 128 + b) * 16 + h) * 64) * 128;
    float* hout = (P.out + launder_z()) + O_SSMS + ((size_t)((l * 128 + b) * 16 + h) * 64) * 128;
    f32x4 hs[4][2];
#pragma unroll
    for (int pi = 0; pi < 4; ++pi)
#pragma unroll
        for (int it = 0; it < 2; ++it) hs[pi][it] = *(const f32x4*)(hin + (size_t)(pi * 16 + pr) * 128 + it * 64 + l16 * 4);
#pragma unroll 1
    for (int t = 0; t < 8; ++t) {
        const float dec = sdec[t], dtt = sdt[t];
        const f32x4 B0 = *(const LAS f32x4*)(Bv + t * 128 + l16 * 4), B1 = *(const LAS f32x4*)(Bv + t * 128 + 64 + l16 * 4);
        const f32x4 C0 = *(const LAS f32x4*)(Cv + t * 128 + l16 * 4), C1 = *(const LAS f32x4*)(Cv + t * 128 + 64 + l16 * 4);
#pragma unroll
        for (int pi = 0; pi < 4; ++pi) { const float xd = xs[t * 64 + pi * 16 + pr] * dtt;
            hs[pi][0] = hs[pi][0] * dec + B0 * xd; hs[pi][1] = hs[pi][1] * dec + B1 * xd;
            const f32x4 q = hs[pi][0] * C0 + hs[pi][1] * C1; float yp = q[0] + q[1] + q[2] + q[3];
            yp += shx(yp, 1); yp += shx(yp, 2); yp += shx(yp, 4); yp += shx(yp, 8);
            if (l16 == 0) yv[t * 64 + pi * 16 + pr] = yp; }
    }
#pragma unroll
    for (int pi = 0; pi < 4; ++pi)
#pragma unroll
        for (int it = 0; it < 2; ++it) *(f32x4*)(hout + (size_t)(pi * 16 + pr) * 128 + it * 64 + l16 * 4) = hs[pi][it];
    __syncthreads();
    {
        const int t = t8 >> 5, p0 = (t8 & 31) * 2, row = row0 + t; const float Dh = PIN(I_DSKIP)[l * 16 + h];
        const unsigned zz = *(const unsigned*)(PROJ + (size_t)row * NPROJ + C_Z + h * 64 + p0);
        const float v0 = (yv[t * 64 + p0] + Dh * xs[t * 64 + p0]) * siluf_(bf_lo(zz)), v1 = (yv[t * 64 + p0 + 1] + Dh * xs[t * 64 + p0 + 1]) * siluf_(bf_hi(zz));
        float ssq = v0 * v0 + v1 * v1;
        ssq += shx(ssq, 1); ssq += shx(ssq, 2); ssq += shx(ssq, 4); ssq += shx(ssq, 8); ssq += shx(ssq, 16);
        *(unsigned*)(Y + (size_t)row * 2048 + h * 64 + p0) = cvt_pk_bf16(v0 * PIN(I_SSDN)[(size_t)l * 1024 + h * 64 + p0], v1 * PIN(I_SSDN)[(size_t)l * 1024 + h * 64 + p0 + 1]);
        if ((t8 & 31) == 0) SSQ[(size_t)row * 16 + h] = ssq;
    }
}

__device__ __forceinline__ void sgu_prompt(LAS uchar* lds, const Params& P, int l, int b, int c, int g) {
    const int tid = TIDX, lane = tid & 63, w = tid >> 6, fr = lane & 15, fq = lane >> 4;
    const bf16_t* PROJ = (const bf16_t*)((P.ws + launder_z()) + WS_PROJ); bf16_t* Y = (bf16_t*)((P.ws + launder_z()) + WS_Y);
    LAS float* smu = (LAS float*)(lds + 69632); LAS float* srs = smu + 128;
    const int grow0 = b * 2048 + c * 128;
    __syncthreads();
    {
        const int r = tid >> 2, q = tid & 3; const bf16_t* src = PROJ + (size_t)(grow0 + r) * NPROJ + C_V + q * 128;
        float s = 0.f, s2 = 0.f;
#pragma unroll
        for (int i = 0; i < 16; ++i) { const u32x4 v = *(const u32x4*)(src + i * 8);
            const float f[8] = {bf_lo(v.x), bf_hi(v.x), bf_lo(v.y), bf_hi(v.y), bf_lo(v.z), bf_hi(v.z), bf_lo(v.w), bf_hi(v.w)};
#pragma unroll
            for (int j = 0; j < 8; ++j) { s += f[j]; s2 += f[j] * f[j]; } }
        s += shx(s, 1); s += shx(s, 2); s2 += shx(s2, 1); s2 += shx(s2, 2);
        const float mu = s * (1.0f / 512.0f), var = fmaxf(s2 * (1.0f / 512.0f) - mu * mu, 0.f);
        if (q == 0) { smu[r] = mu; srs[r] = rsqrtf(var + EPS); }
        const float* wsrc = PIN(I_WSP) + ((size_t)(l * 4 + g) * 128 + r) * 128 + q * 32;
#pragma unroll
        for (int i = 0; i < 4; ++i) { const f32x4 a = *(const f32x4*)(wsrc + i * 8), bb = *(const f32x4*)(wsrc + i * 8 + 4); const int s0 = q * 32 + i * 8;
            u32x4 o; o.x = cvt_pk_bf16(s0 + 0 <= r ? a[0] : 0.f, s0 + 1 <= r ? a[1] : 0.f); o.y = cvt_pk_bf16(s0 + 2 <= r ? a[2] : 0.f, s0 + 3 <= r ? a[3] : 0.f);
            o.z = cvt_pk_bf16(s0 + 4 <= r ? bb[0] : 0.f, s0 + 5 <= r ? bb[1] : 0.f); o.w = cvt_pk_bf16(s0 + 6 <= r ? bb[2] : 0.f, s0 + 7 <= r ? bb[3] : 0.f);
            *(LAS u32x4*)(lds + r * PB + s0 * 2) = o; }
    }
    __syncthreads();
    {
        const int r = tid >> 2, q = tid & 3; const bf16_t* src = PROJ + (size_t)(grow0 + r) * NPROJ + C_V + g * 128 + q * 32;
        const float mu = smu[r], rs = srs[r];
        const float* lg = PIN(I_LNG) + (size_t)l * 512 + g * 128 + q * 32; const float* lb = PIN(I_LNB) + (size_t)l * 512 + g * 128 + q * 32;
        float* vout = (P.out + launder_z()) + O_VP + ((size_t)(l * 8 + b) * 128 + r) * 512 + g * 128 + q * 32;
#pragma unroll
        for (int i = 0; i < 4; ++i) { const u32x4 v = *(const u32x4*)(src + i * 8);
            const float f[8] = {bf_lo(v.x), bf_hi(v.x), bf_lo(v.y), bf_hi(v.y), bf_lo(v.z), bf_hi(v.z), bf_lo(v.w), bf_hi(v.w)}; float vn[8];
#pragma unroll
            for (int j = 0; j < 8; ++j) { vn[j] = (f[j] - mu) * rs * lg[i * 8 + j] + lb[i * 8 + j];
                *(LAS bf16_t*)(lds + 34816 + (q * 32 + i * 8 + j) * PB + r * 2) = (bf16_t)(cvt_pk_bf16(vn[j], 0.f) & 0xffffu); }
            if (c == 15) { *(f32x4*)(vout + i * 8) = (f32x4){vn[0], vn[1], vn[2], vn[3]}; *(f32x4*)(vout + i * 8 + 4) = (f32x4){vn[4], vn[5], vn[6], vn[7]}; } }
    }
    __syncthreads();
    {
        f32x4 acc[8];
#pragma unroll
        for (int i = 0; i < 8; ++i) acc[i] = (f32x4){0.f, 0.f, 0.f, 0.f};
        wmma<8, 4>(lds + w * 16 * PB, lds + 34816, PB, acc, fr, fq);
        const int t = 16 * w + fr, row = grow0 + t; const float bs = PIN(I_BSP)[(size_t)(l * 4 + g) * 128 + t];
#pragma unroll
        for (int ni = 0; ni < 8; ++ni) { const int d0 = ni * 16 + 4 * fq; const u32x2 uu = *(const u32x2*)(PROJ + (size_t)row * NPROJ + C_U + g * 128 + d0);
            u32x2 o; o.x = cvt_pk_bf16(bf_lo(uu.x) * (acc[ni][0] + bs), bf_hi(uu.x) * (acc[ni][1] + bs)); o.y = cvt_pk_bf16(bf_lo(uu.y) * (acc[ni][2] + bs), bf_hi(uu.y) * (acc[ni][3] + bs));
            *(u32x2*)(Y + (size_t)row * 2048 + 1024 + g * 128 + d0) = o; }
    }
}

__device__ __forceinline__ void sgu_sample(LAS uchar* lds, const Params& P, int l, int b) {
    const int tid = TIDX, lane = tid & 63, w = tid >> 6, ch = tid, g = ch >> 7;
    const bf16_t* PROJ = (const bf16_t*)((P.ws + launder_z()) + WS_PROJ); bf16_t* Y = (bf16_t*)((P.ws + launder_z()) + WS_Y);
    LAS float* red = (LAS float*)lds;
    const int row0 = MPR + b * 8;
    float v[8], u[8];
#pragma unroll
    for (int s = 0; s < 8; ++s) { v[s] = bf1(PROJ[(size_t)(row0 + s) * NPROJ + C_V + ch]); u[s] = bf1(PROJ[(size_t)(row0 + s) * NPROJ + C_U + ch]); }
    __syncthreads();
#pragma unroll
    for (int s = 0; s < 8; ++s) { float a = v[s], a2 = v[s] * v[s];
#pragma unroll
        for (int m = 1; m < 64; m <<= 1) { a += shx(a, m); a2 += shx(a2, m); }
        if (lane == 0) { red[w * 16 + s] = a; red[w * 16 + 8 + s] = a2; } }
    __syncthreads();
    const float lg = PIN(I_LNG)[(size_t)l * 512 + ch], lb = PIN(I_LNB)[(size_t)l * 512 + ch];
    float vn[8];
#pragma unroll
    for (int s = 0; s < 8; ++s) { float a = 0.f, a2 = 0.f;
#pragma unroll
        for (int ww = 0; ww < 8; ++ww) { a += red[ww * 16 + s]; a2 += red[ww * 16 + 8 + s]; }
        const float mu = a * (1.0f / 512.0f), var = fmaxf(a2 * (1.0f / 512.0f) - mu * mu, 0.f);
        vn[s] = (v[s] - mu) * rsqrtf(var + EPS) * lg + lb;
        (P.out + launder_z())[O_VS + ((size_t)(l * 128 + b) * 8 + s) * 512 + ch] = vn[s]; }
    const float* W = PIN(I_WSP) + (size_t)(l * 4 + g) * 128 * 128; const float* bsp = PIN(I_BSP) + (size_t)(l * 4 + g) * 128;
#pragma unroll
    for (int t = 0; t < 8; ++t) { float o = bsp[t];
#pragma unroll
        for (int s = 0; s <= t; ++s) o += W[t * 128 + s] * vn[s];
        Y[(size_t)(row0 + t) * 2048 + 1024 + ch] = (bf16_t)(cvt_pk_bf16(u[t] * o, 0.f) & 0xffffu); }
}

__device__ __forceinline__ void pool_prompt(const Params& P, int tile) {
    const int tid = TIDX, cgp = tid & 63, rsg = tid >> 6, ch0 = cgp * 8, wdw = 2 << (cgp >> 4);
    const bf16_t* PROJ = (const bf16_t*)((P.ws + launder_z()) + WS_PROJ); bf16_t* Y = (bf16_t*)((P.ws + launder_z()) + WS_Y);
    const int b = tile >> 4, pos0 = (tile & 15) * 128 + rsg * 16; const size_t rbase = (size_t)b * 2048;
    float S[8];
#pragma unroll
    for (int j = 0; j < 8; ++j) S[j] = 0.f;
    for (int k = 1; k < wdw; ++k) { const int pos = pos0 - k; if (pos >= 0) { const u32x4 v = *(const u32x4*)(PROJ + (rbase + pos) * NPROJ + C_POOL + ch0);
        S[0] += bf_lo(v.x); S[1] += bf_hi(v.x); S[2] += bf_lo(v.y); S[3] += bf_hi(v.y); S[4] += bf_lo(v.z); S[5] += bf_hi(v.z); S[6] += bf_lo(v.w); S[7] += bf_hi(v.w); } }
#pragma unroll 1
    for (int t = 0; t < 16; ++t) { const int pos = pos0 + t;
        const u32x4 v = *(const u32x4*)(PROJ + (rbase + pos) * NPROJ + C_POOL + ch0);
        const float x[8] = {bf_lo(v.x), bf_hi(v.x), bf_lo(v.y), bf_hi(v.y), bf_lo(v.z), bf_hi(v.z), bf_lo(v.w), bf_hi(v.w)};
        const float ic = 1.0f / (float)min(pos + 1, wdw); float d[8];
#pragma unroll
        for (int j = 0; j < 8; ++j) { S[j] += x[j]; d[j] = S[j] * ic - x[j]; }
        u32x4 o; o.x = cvt_pk_bf16(d[0], d[1]); o.y = cvt_pk_bf16(d[2], d[3]); o.z = cvt_pk_bf16(d[4], d[5]); o.w = cvt_pk_bf16(d[6], d[7]);
        *(u32x4*)(Y + (rbase + pos) * 2048 + 1536 + ch0) = o;
        const int po = pos - wdw + 1;
        if (po >= 0) { const u32x4 q = *(const u32x4*)(PROJ + (rbase + po) * NPROJ + C_POOL + ch0);
            S[0] -= bf_lo(q.x); S[1] -= bf_hi(q.x); S[2] -= bf_lo(q.y); S[3] -= bf_hi(q.y); S[4] -= bf_lo(q.z); S[5] -= bf_hi(q.z); S[6] -= bf_lo(q.w); S[7] -= bf_hi(q.w); } }
}
__device__ __forceinline__ void pool_sample(const Params& P, int l, int si) {
    const int tid = TIDX, cgp = tid & 63, ch0 = cgp * 8, wdw = 2 << (cgp >> 4), b = si * 8 + (tid >> 6);
    const bf16_t* PROJ = (const bf16_t*)((P.ws + launder_z()) + WS_PROJ); bf16_t* Y = (bf16_t*)((P.ws + launder_z()) + WS_Y);
    const float* buf = PIN(I_SPOOL) + (size_t)(l * 128 + b) * 15 * 512 + ch0;
    const size_t rbase = (size_t)MPR + b * 8;
    float S[8];
#pragma unroll
    for (int j = 0; j < 8; ++j) S[j] = 0.f;
    for (int k = 1; k < wdw; ++k) { const f32x4 a = *(const f32x4*)(buf + (size_t)(15 - k) * 512), c = *(const f32x4*)(buf + (size_t)(15 - k) * 512 + 4);
        S[0] += a[0]; S[1] += a[1]; S[2] += a[2]; S[3] += a[3]; S[4] += c[0]; S[5] += c[1]; S[6] += c[2]; S[7] += c[3]; }
    const float ic = 1.0f / (float)wdw;
#pragma unroll 1
    for (int t = 0; t < 8; ++t) {
        const u32x4 v = *(const u32x4*)(PROJ + (rbase + t) * NPROJ + C_POOL + ch0);
        const float x[8] = {bf_lo(v.x), bf_hi(v.x), bf_lo(v.y), bf_hi(v.y), bf_lo(v.z), bf_hi(v.z), bf_lo(v.w), bf_hi(v.w)}; float d[8];
#pragma unroll
        for (int j = 0; j < 8; ++j) { S[j] += x[j]; d[j] = S[j] * ic - x[j]; }
        u32x4 o; o.x = cvt_pk_bf16(d[0], d[1]); o.y = cvt_pk_bf16(d[2], d[3]); o.z = cvt_pk_bf16(d[4], d[5]); o.w = cvt_pk_bf16(d[6], d[7]);
        *(u32x4*)(Y + (rbase + t) * 2048 + 1536 + ch0) = o;
        const int po = t - wdw + 1;
        if (po >= 0) { const u32x4 q = *(const u32x4*)(PROJ + (rbase + po) * NPROJ + C_POOL + ch0);
            S[0] -= bf_lo(q.x); S[1] -= bf_hi(q.x); S[2] -= bf_lo(q.y); S[3] -= bf_hi(q.y); S[4] -= bf_lo(q.z); S[5] -= bf_hi(q.z); S[6] -= bf_lo(q.w); S[7] -= bf_hi(q.w); }
        else { const f32x4 a = *(const f32x4*)(buf + (size_t)(15 + po) * 512), c = *(const f32x4*)(buf + (size_t)(15 + po) * 512 + 4);
            S[0] -= a[0]; S[1] -= a[1]; S[2] -= a[2]; S[3] -= a[3]; S[4] -= c[0]; S[5] -= c[1]; S[6] -= c[2]; S[7] -= c[3]; } }
}
constexpr int NC_CP = 8 * 3 * 1536, NC_CS = 128 * 3 * 1536, NC_PP = 8 * 15 * 512, NC_PS = 128 * 15 * 512, NC_ALL = NC_CP + NC_CS + NC_PP + NC_PS;
__device__ __forceinline__ void state_copy(const Params& P, int l, int item) {
    const bf16_t* PROJ = (const bf16_t*)((P.ws + launder_z()) + WS_PROJ);
    for (int j = 0; j < 16; ++j) { int e = item * 8192 + j * NTHR + TIDX; if (e >= NC_ALL) return;
        if (e < NC_CP) { const int ch = e % 1536, k = (e / 1536) % 3, b = e / 4608; (P.out + launder_z())[O_CONVP + (size_t)l * NC_CP + e] = bf1(PROJ[(size_t)(b * 2048 + 2045 + k) * NPROJ + C_XBC + ch]); continue; } e -= NC_CP;
        if (e < NC_CS) { const int ch = e % 1536, k = (e / 1536) % 3, b = e / 4608; (P.out + launder_z())[O_CONVS + (size_t)l * NC_CS + e] = bf1(PROJ[(size_t)(MPR + b * 8 + 5 + k) * NPROJ + C_XBC + ch]); continue; } e -= NC_CS;
        if (e < NC_PP) { const int ch = e % 512, k = (e / 512) % 15, b = e / 7680; (P.out + launder_z())[O_POOLP + (size_t)l * NC_PP + e] = bf1(PROJ[(size_t)(b * 2048 + 2033 + k) * NPROJ + C_POOL + ch]); continue; } e -= NC_PP;
        { const int ch = e % 512, k = (e / 512) % 15, b = e / 7680;
          (P.out + launder_z())[O_POOLS + (size_t)l * NC_PS + e] = k < 7 ? PIN(I_SPOOL)[((size_t)(l * 128 + b) * 15 + 8 + k) * 512 + ch] : bf1(PROJ[(size_t)(MPR + b * 8 + (k - 7)) * NPROJ + C_POOL + ch]); }
    }
}

__device__ __forceinline__ void phase_convbc(const Params& P, int l) {
    const int tid = TIDX, lane = tid & 63, w = __builtin_amdgcn_readfirstlane(tid >> 6);
    const bf16_t* PROJ = (const bf16_t*)((P.ws + launder_z()) + WS_PROJ); bf16_t* CBC = (bf16_t*)((P.ws + launder_z()) + WS_CBC);
    const float* cwp = PIN(I_CONVW) + (size_t)l * 4 * 1536; const float* cbp = PIN(I_CONVB) + (size_t)l * 1536;
    for (int it = BIDX; it < 256; it += GDIM) {
        const int tile = it >> 1, half = it & 1, b = tile >> 4, c = tile & 15;
        const bf16_t* xsrc = PROJ + (size_t)(b * 2048) * NPROJ + C_XBC + 1024 + half * 256;
#pragma unroll 1
        for (int i = 0; i < 4; ++i) {
            const int cg = i * 8 + w, ch = 1024 + half * 256 + cg * 8;
            float xf[5][8];
#pragma unroll
            for (int k = 0; k < 5; ++k) { const int pos = c * 128 + 2 * lane - 3 + k; u32x4 v = (u32x4){0u, 0u, 0u, 0u}; if (pos >= 0) v = *(const u32x4*)(xsrc + (size_t)pos * NPROJ + cg * 8);
                xf[k][0] = bf_lo(v.x); xf[k][1] = bf_hi(v.x); xf[k][2] = bf_lo(v.y); xf[k][3] = bf_hi(v.y); xf[k][4] = bf_lo(v.z); xf[k][5] = bf_hi(v.z); xf[k][6] = bf_lo(v.w); xf[k][7] = bf_hi(v.w); }
            float o0[8], o1[8];
#pragma unroll
            for (int j = 0; j < 8; ++j) { const float w0 = cwp[ch + j], w1 = cwp[1536 + ch + j], w2 = cwp[3072 + ch + j], w3 = cwp[4608 + ch + j], bb = cbp[ch + j];
                o0[j] = siluf_(bb + w0 * xf[0][j] + w1 * xf[1][j] + w2 * xf[2][j] + w3 * xf[3][j]);
                o1[j] = siluf_(bb + w0 * xf[1][j] + w1 * xf[2][j] + w2 * xf[3][j] + w3 * xf[4][j]); }
            const size_t row = (size_t)b * 2048 + c * 128 + 2 * lane;
            u32x4 q; q.x = cvt_pk_bf16(o0[0], o0[1]); q.y = cvt_pk_bf16(o0[2], o0[3]); q.z = cvt_pk_bf16(o0[4], o0[5]); q.w = cvt_pk_bf16(o0[6], o0[7]); *(u32x4*)(CBC + row * 512 + half * 256 + cg * 8) = q;
            q.x = cvt_pk_bf16(o1[0], o1[1]); q.y = cvt_pk_bf16(o1[2], o1[3]); q.z = cvt_pk_bf16(o1[4], o1[5]); q.w = cvt_pk_bf16(o1[6], o1[7]); *(u32x4*)(CBC + (row + 1) * 512 + half * 256 + cg * 8) = q;
        }
    }
}

__device__ __forceinline__ void phase_mixer(LAS uchar* lds, const Params& P, int l) {
    const int G = GDIM, bid = BIDX;
    constexpr int N_B = 1024, N_C = 512, N_D = 128, N_E = 128, N_E2 = 16, N_F = (NC_ALL + 8191) / 8192;
    constexpr int N_REST = N_B + N_C + N_D + N_E + N_E2 + N_F;
    if (G > 128) { if (bid < 128) ssd_prompt(lds, P, l, bid >> 4, bid & 15); }
    else { for (int i = bid; i < 128; i += G) ssd_prompt(lds, P, l, i >> 4, i & 15); }
    unsigned* ctr = (unsigned*)((P.ws + launder_z()) + WS_BAR) + 3584 + 64 * l;
    volatile LAS unsigned* bc = (volatile LAS unsigned*)(lds + LDS_BYTES) + 2;
    for (;;) {
        __syncthreads();
        if (TIDX == 0) bc[0] = __hip_atomic_fetch_add(ctr, 1u, __ATOMIC_RELAXED, __HIP_MEMORY_SCOPE_AGENT);
        __syncthreads();
        int j = (int)bc[0];
        if (j >= N_REST) break;
        if (j < N_C) { sgu_prompt(lds, P, l, j >> 6, (j >> 2) & 15, j & 3); continue; } j -= N_C;
        if (j < N_B) { ssd_sample(lds, P, l, j >> 3, j & 7); continue; } j -= N_B;
        if (j < N_D) { sgu_sample(lds, P, l, j); continue; } j -= N_D;
        if (j < N_E) { pool_prompt(P, j); continue; } j -= N_E;
        if (j < N_E2) { pool_sample(P, l, j); continue; } j -= N_E2;
        state_copy(P, l, j);
    }
}


#define XB_TMO      128
#define XB_XCNT(j)  (256  + 64 * (j))
#define XB_XSUB(j)  (1280 + 64 * (j))
#define XB_XGEN(j)  (2304 + 64 * (j))
#define XB_TOP      3328
#define XB_TOPGEN   3392
#define XCD_BAR_WORDS 3456
#define XB_SPIN_CAP (1u << 20)
__device__ __forceinline__ unsigned xb_ld(unsigned* p)              { return __hip_atomic_load(p, __ATOMIC_RELAXED, __HIP_MEMORY_SCOPE_AGENT); }
__device__ __forceinline__ unsigned xb_add(unsigned* p, unsigned v) { return __hip_atomic_fetch_add(p, v, __ATOMIC_RELAXED, __HIP_MEMORY_SCOPE_AGENT); }
__device__ __forceinline__ unsigned xb_xcc_id() { return (unsigned)__builtin_amdgcn_s_getreg((3 << 11) | 20) & 0xFu; }
#define XB_SPIN(cond, bar) do { unsigned _sp = 0; while (cond) { __builtin_amdgcn_s_sleep(1); \
    if ((++_sp & 255u) == 0u) { if (xb_ld(&(bar)[XB_TMO])) break; if (_sp > XB_SPIN_CAP) { atomicAdd(&(bar)[XB_TMO], 1u); break; } } } } while (0)
struct XcdBarrier { unsigned* bar; unsigned x; volatile LAS unsigned* st; };
__device__ __forceinline__ XcdBarrier xcd_barrier_post(unsigned* bar, volatile LAS unsigned* st) {
    XcdBarrier b; b.bar = bar; b.x = xb_xcc_id(); b.st = st;
    if (threadIdx.x == 0) (void)xb_add(&bar[XB_XCNT(b.x)], 1u);
    return b;
}
__device__ __forceinline__ void xcd_barrier_complete(unsigned* bar, unsigned x, unsigned& nloc, unsigned& nx) {
    const unsigned G = gridDim.x * gridDim.y * gridDim.z;
    unsigned sum, cnt, mine, sp = 0u;
    for (;;) {
        sum = 0u; cnt = 0u; mine = 0u;
#pragma unroll
        for (unsigned j = 0; j < 16; ++j) { const unsigned c = xb_ld(&bar[XB_XCNT(j)]); sum += c; cnt += (c > 0u) ? 1u : 0u; mine = (j == x) ? c : mine; }
        if (sum == G) break;
        __builtin_amdgcn_s_sleep(1);
        if ((++sp & 255u) == 0u) { if (xb_ld(&bar[XB_TMO])) break; if (sp > XB_SPIN_CAP) { atomicAdd(&bar[XB_TMO], 1u); break; } }
    }
    nloc = mine > 0u ? mine : 1u; nx = cnt > 0u ? cnt : 1u;
}
__device__ __forceinline__ void xcd_barrier(const XcdBarrier& b) {
    asm volatile("s_waitcnt vmcnt(0)" ::: "memory");
    __syncthreads();
    if (threadIdx.x == 0) {
        unsigned* bar = b.bar + launder_z(); const unsigned bx = (unsigned)launder_s((int)b.x);
        __builtin_amdgcn_s_waitcnt(0);
        unsigned nloc = b.st[0], nx = b.st[1];
        if (nloc == 0u) { xcd_barrier_complete(bar, bx, nloc, nx); b.st[0] = nloc; b.st[1] = nx; }
        const unsigned old = xb_add(&bar[XB_XSUB(bx)], 1u);
        const unsigned gen = old / nloc;
        if (old + 1u == (gen + 1u) * nloc) {
            __builtin_amdgcn_fence(__ATOMIC_RELEASE, "agent");
            asm volatile("s_waitcnt vmcnt(0)" ::: "memory");
            const unsigned og = xb_add(&bar[XB_TOP], 1u);
            const unsigned tg = og / nx;
            if (og + 1u == (tg + 1u) * nx) xb_add(&bar[XB_TOPGEN], 1u);
            else XB_SPIN(xb_ld(&bar[XB_TOPGEN]) == tg, bar);
            __builtin_amdgcn_fence(__ATOMIC_ACQUIRE, "agent");
            xb_add(&bar[XB_XGEN(bx)], 1u);
            asm volatile("s_waitcnt vmcnt(0)" ::: "memory");
        } else {
            XB_SPIN(xb_ld(&bar[XB_XGEN(bx)]) == gen, bar);
            __builtin_amdgcn_fence(__ATOMIC_ACQUIRE, "agent");
            asm volatile("s_waitcnt vmcnt(0)" ::: "memory");
        }
    }
    __syncthreads();
}

__device__ __forceinline__ void run_phase(LAS uchar* lds, const Params& P, int ph) {
    uchar* ws = (P.ws + launder_z());
    float* RSS = (float*)(ws + WS_RSS);
    if (ph == 0) { phase_pre(lds, P); return; }
    if (ph == 30) {
        const int tid = TIDX, lane = tid & 63, wv = tid >> 6; const bf16_t* XB = (const bf16_t*)(ws + WS_XN); const float* fg = PIN(I_FN);
        for (int row = BIDX * 8 + wv; row < MT; row += GDIM * 8) { const float r = rownorm(RSS + (size_t)12 * MT * 16, row);
#pragma unroll
            for (int i = 0; i < 4; ++i) { const int col = i * 256 + lane * 4; const u32x2 xo = *(const u32x2*)(XB + (size_t)row * 1024 + col); const f32x4 gg = *(const f32x4*)(fg + col);
                *(f32x4*)((P.out + launder_z()) + O_Y + (size_t)row * 1024 + col) = (f32x4){bf_lo(xo.x) * r * gg[0], bf_hi(xo.x) * r * gg[1], bf_lo(xo.y) * r * gg[2], bf_hi(xo.y) * r * gg[3]}; } }
        return; }
    const int l = ph >= 2 ? (ph - 2) / 7 : 0, s = ph >= 2 ? (ph - 2) % 7 : -1;
    if (s == 1) { phase_convbc(P, l); { XcdBarrier xb; xb.bar = (unsigned*)(ws + WS_BAR); xb.x = xb_xcc_id(); xb.st = (volatile LAS unsigned*)(lds + LDS_BYTES); xcd_barrier(xb); } phase_mixer(lds, P, l); return; }
    bf16_t* xn_cur = (bf16_t*)(ws + ((l & 1) ? WS_XN2 : WS_XN)); bf16_t* xn_alt = (bf16_t*)(ws + ((l & 1) ? WS_XN : WS_XN2));
#define GINIT GPh g; g.G = GDIM; g.c = BIDX; g.nseg = 1; g.nlay = 1; g.a_lay = 0; g.b_lay = 0; g.nM = MT / 256; \
    g.rss = nullptr; g.rss_next = nullptr; g.XS = xn_cur; g.XD = xn_cur; g.O = nullptr; g.DT = (float*)(ws + WS_DT); \
    g.PROJ = (const bf16_t*)(ws + WS_PROJ); g.SSQ = (const float*)(ws + WS_SSQ); g.UPB = nullptr; \
    g.A = xn_cur; g.lda = 1024; g.ldb = 1024; g.K = 1024; g.nN = 4;
    switch (s) {
    case -1: { GINIT g.A = (const bf16_t*)(ws + WS_PBF); g.Bt = (const bf16_t*)(ws + WS_WPU); g.lda = 256; g.ldb = 256; g.K = 256; g.nlay = 4; g.a_lay = (size_t)MT * 256; g.b_lay = (size_t)1024 * 256;
        g.O = (bf16_t*)(ws + WS_UP); gemm_phase<EPI_UP>(lds, g); } break;
    case 0: { GINIT g.Bt = (const bf16_t*)(ws + WS_WIN) + (size_t)l * NIN * 1024; g.nN = NIN / 256;
        g.rss = RSS + (size_t)(3 * l) * MT * 16; g.O = (bf16_t*)(ws + WS_PROJ); gemm_phase<EPI_P1>(lds, g); } break;
    case 2: { GINIT g.A = (const bf16_t*)(ws + WS_Y); g.Bt = (const bf16_t*)(ws + WS_WBR) + (size_t)l * 1024 * 2048; g.lda = 2048; g.ldb = 2048; g.K = 512; g.nseg = 4;
        g.O = (bf16_t*)(ws + WS_MRG); g.nM = 64; gemm_phase<EPI_P3>(lds, g); mini_gemm<EPI_P3>(lds, g); } break;
    case 3: { GINIT g.A = (const bf16_t*)(ws + WS_MRG); g.Bt = (const bf16_t*)(ws + WS_WOUT) + (size_t)l * 1024 * 1024;
        g.rss_next = RSS + (size_t)(3 * l + 1) * MT * 16; g.nM = 64; gemm_phase<EPI_P4>(lds, g); mini_gemm<EPI_P4>(lds, g); } break;
    case 4: { GINIT g.Bt = (const bf16_t*)(ws + WS_WGU) + (size_t)l * 5632 * 1024; g.nN = 22;
        g.rss = RSS + (size_t)(3 * l + 1) * MT * 16; g.O = (bf16_t*)(ws + WS_ACT); gemm_phase<EPI_P5>(lds, g); } break;
    case 5: { GINIT g.A = (const bf16_t*)(ws + WS_ACT); g.Bt = (const bf16_t*)(ws + WS_WDN) + (size_t)l * 1024 * DFF; g.lda = DFF; g.ldb = DFF; g.K = DFF;
        g.rss_next = RSS + (size_t)(3 * l + 2) * MT * 16; g.nM = 64; gemm_phase<EPI_P6>(lds, g); mini_gemm<EPI_P6>(lds, g); } break;
    default: { GINIT g.Bt = (const bf16_t*)(ws + WS_WPG) + (size_t)l * 1024 * 1024;
        g.rss = RSS + (size_t)(3 * l + 2) * MT * 16; g.rss_next = RSS + (size_t)(3 * l + 3) * MT * 16; g.XD = xn_alt;
        g.UPB = (const bf16_t*)(ws + WS_UP) + (size_t)l * MT * 1024; g.nM = 64; gemm_phase<EPI_P7>(lds, g); mini_gemm<EPI_P7>(lds, g); } break;
    }
#undef GINIT
}

__global__ void __launch_bounds__(NTHR, 2) hybrid_fwd(Params P) {
    extern __shared__ __attribute__((aligned(16))) uchar smem[];
    LAS uchar* lds = (LAS uchar*)smem;
    cg::grid_group grid = cg::this_grid();
    volatile LAS unsigned* st = (volatile LAS unsigned*)(lds + LDS_BYTES);
    if (threadIdx.x < 4) st[threadIdx.x] = 0u;
    __syncthreads();
    const XcdBarrier xbar = xcd_barrier_post((unsigned*)(P.ws + WS_BAR), st);
    for (int ph = P.ph_lo; ph < P.ph_hi; ++ph) {
        int nrep_ = 1;
#ifdef PROBE_REP
        { const int s_ = ph >= 2 && ph < 30 ? (ph - 2) % 7 : (ph == 0 ? 7 : (ph == 1 ? 8 : 9)); if ((PROBE_REP >> s_) & 1) nrep_ = 2; }
#endif
#pragma unroll 1
        for (int r_ = 0; r_ < nrep_; ++r_) { run_phase(lds, P, ph); __syncthreads(); }
        if (ph + 1 < P.ph_hi) {
            if (ph == P.ph_lo) {
                asm volatile("s_waitcnt vmcnt(0)" ::: "memory");
                __syncthreads();
                if (threadIdx.x < 64) { __builtin_amdgcn_fence(__ATOMIC_RELEASE, "agent"); asm volatile("s_waitcnt vmcnt(0)" ::: "memory"); }
                __syncthreads();
                grid.sync();
                if (threadIdx.x < 64) { __builtin_amdgcn_fence(__ATOMIC_ACQUIRE, "agent"); asm volatile("s_waitcnt vmcnt(0)" ::: "memory"); }
                __syncthreads();
            } else xcd_barrier(xbar);
        }
    }
}

extern "C" void kernel_launch(void* const* d_in, const int* in_sizes, int n_in, void* d_out, int out_size, void* d_ws, size_t ws_size, hipStream_t stream) {
    static int grid = 0;
    if (grid == 0) {
        if (n_in != 32 || (size_t)out_size != O_END || ws_size < WS_END) { fprintf(stderr, "kernel_launch: shape mismatch n_in %d out %d (want %zu) ws %zu (want %zu)\n", n_in, out_size, (size_t)O_END, ws_size, (size_t)WS_END); grid = -1; return; }
        int dev = 0, cus = 0, per_cu = 0;
        hipGetDevice(&dev); hipDeviceGetAttribute(&cus, hipDeviceAttributeMultiprocessorCount, dev);
        if (hipFuncSetAttribute((const void*)hybrid_fwd, hipFuncAttributeMaxDynamicSharedMemorySize, LDS_BYTES + 16) != hipSuccess) { fprintf(stderr, "kernel_launch: hipFuncSetAttribute failed\n"); grid = -1; return; }
        hipOccupancyMaxActiveBlocksPerMultiprocessor(&per_cu, (const void*)hybrid_fwd, NTHR, LDS_BYTES + 16);
        if (per_cu < 1) { fprintf(stderr, "kernel_launch: occupancy query says %d blocks per CU\n", per_cu); per_cu = 1; }
        grid = cus * 1;
        fprintf(stderr, "kernel_launch: cus %d per_cu %d grid %d\n", cus, per_cu, grid);
    }
    if (grid < 0) return;
    hipMemsetAsync((char*)d_ws + WS_BAR, 0, 16384, stream);
    Params p{};
    for (int i = 0; i < 32; ++i) p.in[i] = (const float*)d_in[i];
    p.out = (float*)d_out; p.ws = (uchar*)d_ws;
#if MULTI_LAUNCH
    for (int ph = 0; ph < 31; ++ph) { p.ph_lo = ph; p.ph_hi = ph + 1; hipLaunchKernelGGL(hybrid_fwd, dim3(grid), dim3(NTHR), LDS_BYTES + 16, stream, p); }
#else
    p.ph_lo = 0; p.ph_hi = 31;
    void* args[] = {&p};
    hipError_t e = hipLaunchCooperativeKernel((const void*)hybrid_fwd, dim3(grid), dim3(NTHR), args, LDS_BYTES + 16, stream);
    if (e != hipSuccess) fprintf(stderr, "cooperative launch failed: %s (grid %d)\n", hipGetErrorString(e), grid);
#endif
}
```

```cpp
#include <hip/hip_runtime.h>
#include <hip/hip_cooperative_groups.h>
#include <cstdio>
namespace cg = cooperative_groups;

#define LAS __attribute__((address_space(3)))
typedef unsigned short bf16_t;
typedef unsigned char uchar;
typedef short bf16x8 __attribute__((ext_vector_type(8)));
typedef float f32x4 __attribute__((ext_vector_type(4)));
typedef unsigned u32x4 __attribute__((ext_vector_type(4)));
typedef unsigned u32x2 __attribute__((ext_vector_type(2)));

#ifndef MULTI_LAUNCH
#define MULTI_LAUNCH 0
#endif

constexpr int MT = 17408, MPR = 16384, DM = 1024, NPROJ = 7168, NIN = 7424, DFF = 2816;
constexpr float EPS = 1e-6f;
constexpr int NTHR = 512;
constexpr int LDS_BYTES = 143360;
constexpr int C_Z = 0, C_XBC = 1024, C_U = 2560, C_V = 3072, C_POOL = 3584, C_GA = 4096, C_GB = 5120, C_GC = 6144;
constexpr size_t al256(size_t x) { return (x + 255) & ~(size_t)255; }
constexpr size_t WS_WIN = 0;
constexpr size_t WS_WBR = WS_WIN + (size_t)4 * NIN * 1024 * 2;
constexpr size_t WS_WOUT = WS_WBR + (size_t)4 * 1024 * 2048 * 2;
constexpr size_t WS_WGU = WS_WOUT + (size_t)4 * 1024 * 1024 * 2;
constexpr size_t WS_WDN = WS_WGU + (size_t)4 * 5632 * 1024 * 2;
constexpr size_t WS_WPG = WS_WDN + (size_t)4 * 1024 * 2816 * 2;
constexpr size_t WS_WPU = WS_WPG + (size_t)4 * 1024 * 1024 * 2;
constexpr size_t WS_X = WS_WPU + (size_t)4 * 1024 * 256 * 2;
constexpr size_t WS_XN = WS_X + (size_t)MT * 1024 * 4;
constexpr size_t WS_RSS = WS_XN + (size_t)MT * 1024 * 2;
constexpr size_t WS_PROJ = al256(WS_RSS + (size_t)13 * MT * 16 * 4);
constexpr size_t WS_DT = WS_PROJ + (size_t)MT * NPROJ * 2;
constexpr size_t WS_Y = WS_DT + (size_t)MT * 16 * 4;
constexpr size_t WS_SSQ = WS_Y + (size_t)MT * 2048 * 2;
constexpr size_t WS_MRG = WS_SSQ + (size_t)MT * 16 * 4;
constexpr size_t WS_ACT = WS_MRG + (size_t)MT * 1024 * 2;
constexpr size_t WS_UP = WS_ACT + (size_t)MT * DFF * 2;
constexpr size_t WS_PBF = WS_UP + (size_t)4 * MT * 1024 * 2;
constexpr size_t WS_XN2 = WS_PBF + (size_t)4 * MT * 256 * 2;
constexpr size_t WS_BAR = WS_XN2 + (size_t)MT * 1024 * 2;
constexpr size_t WS_CBC = WS_BAR + 16384;
constexpr size_t WS_END = WS_CBC + (size_t)MPR * 512 * 2;
constexpr size_t O_Y = 0;
constexpr size_t O_CONVP = (size_t)MT * 1024;
constexpr size_t O_SSMP = O_CONVP + (size_t)4 * 8 * 3 * 1536;
constexpr size_t O_POOLP = O_SSMP + (size_t)4 * 8 * 16 * 64 * 128;
constexpr size_t O_VP = O_POOLP + (size_t)4 * 8 * 15 * 512;
constexpr size_t O_CONVS = O_VP + (size_t)4 * 8 * 128 * 512;
constexpr size_t O_SSMS = O_CONVS + (size_t)4 * 128 * 3 * 1536;
constexpr size_t O_POOLS = O_SSMS + (size_t)4 * 128 * 16 * 64 * 128;
constexpr size_t O_VS = O_POOLS + (size_t)4 * 128 * 15 * 512;
constexpr size_t O_END = O_VS + (size_t)4 * 128 * 8 * 512;

struct Params {
    const float* in[32];
    float* out;
    uchar* ws;
    int ph_lo, ph_hi;
};
enum { I_XP = 0, I_XS, I_SCONV, I_SSSM, I_SPOOL, I_PP, I_PS, I_NMIX, I_WIN, I_CONVW, I_CONVB, I_DTB, I_ALOG, I_DSKIP, I_SSDN, I_LNG, I_LNB, I_WSP, I_BSP,
       I_POOLW, I_POOLS, I_WBRA, I_WBRB, I_WBRC, I_WOUT, I_NFFN, I_WGU, I_WDN, I_NPLE, I_WPG, I_WPU, I_FN };


__device__ __forceinline__ int launder_s(int i) { asm volatile("" : "+s"(i)); return i; }
__device__ __forceinline__ int launder_v(int i) { asm volatile("" : "+v"(i)); return i; }
template <class T> __device__ __forceinline__ T* launder_p(T* p) { asm volatile("" : "+s"(p)); return p; }
__device__ __forceinline__ size_t launder_z() { size_t z = 0; asm volatile("" : "+s"(z)); return z; }
typedef const float __attribute__((address_space(1)))* gcf_t;
#define PIN(i) ((const float*)(gcf_t)(P.in[launder_s(i)]))
#define TIDX launder_v((int)threadIdx.x)
#define BIDX launder_s((int)blockIdx.x)
#define GDIM launder_s((int)gridDim.x)
__device__ __forceinline__ unsigned cvt_pk_bf16(float lo, float hi) { unsigned r; asm("v_cvt_pk_bf16_f32 %0, %1, %2" : "=v"(r) : "v"(lo), "v"(hi)); return r; }
__device__ __forceinline__ float bf_lo(unsigned w) { return __uint_as_float(w << 16); }
__device__ __forceinline__ float bf_hi(unsigned w) { return __uint_as_float(w & 0xffff0000u); }
__device__ __forceinline__ float bf1(bf16_t b) { return __uint_as_float(((unsigned)b) << 16); }
__device__ __forceinline__ float frcp(float x) { return __builtin_amdgcn_rcpf(x); }
__device__ __forceinline__ float sigmoidf_(float x) { return frcp(1.0f + __expf(-x)); }
__device__ __forceinline__ float siluf_(float x) { return x * sigmoidf_(x); }
__device__ __forceinline__ float gelu_tanh(float x) { const float u = 1.5957691216057308f * (x + 0.044715f * x * x * x); return x * sigmoidf_(u); }
__device__ __forceinline__ float softplusf_(float x) {
    const float e = __expf(-fabsf(x));
    const float l = e < 0.03f ? e * (1.0f - e * (0.5f - e * (0.33333334f - e * 0.25f))) : __logf(1.0f + e);
    return fmaxf(x, 0.f) + l;
}
__device__ __forceinline__ float shx(float v, int m) { return __shfl_xor(v, m, 64); }

__device__ __forceinline__ float rownorm(const float* rssp, int row) {
    const f32x4 a = *(const f32x4*)(rssp + (size_t)row * 16), b = *(const f32x4*)(rssp + (size_t)row * 16 + 4), c = *(const f32x4*)(rssp + (size_t)row * 16 + 8), d = *(const f32x4*)(rssp + (size_t)row * 16 + 12);
    const float s = ((a[0] + a[1]) + (a[2] + a[3])) + ((b[0] + b[1]) + (b[2] + b[3])) + ((c[0] + c[1]) + (c[2] + c[3])) + ((d[0] + d[1]) + (d[2] + d[3]));
    return rsqrtf(s * (1.0f / 1024.0f) + EPS);
}
constexpr int BM = 256, BK = 64, HALF = 128, HTB = HALF * BK * 2, NXCD = 8, WGM = 8;
__device__ __forceinline__ int lds_byte(int r, int c) { const int st = (r >> 4) * 2 + (c >> 5), rr = r & 15, cc = c & 31, ob = rr * 64 + cc * 2; return st * 1024 + (ob ^ (((ob >> 9) & 1) << 5)); }
__device__ __forceinline__ void stage_rc(int b, int& R, int& C) { const int st = b / 1024, sb = b % 1024, swz = sb ^ (((sb >> 9) & 1) << 5); R = (st >> 1) * 16 + swz / 64; C = (st & 1) * 32 + (swz % 64) / 2; }

struct Unit { int pm, pn, seg, lay; };
enum { EPI_UP = 0, EPI_P1, EPI_P3, EPI_P4, EPI_P5, EPI_P6, EPI_P7 };

struct GPh {
    const bf16_t* A; const bf16_t* Bt; int lda, ldb, K, nM, nN, nseg, nlay; size_t a_lay, b_lay;
    int G, c;
    const float* rss; float* rss_next; const bf16_t* XS; bf16_t* XD; bf16_t* O; float* DT; const bf16_t* PROJ; const float* SSQ; const bf16_t* UPB;
    __device__ __forceinline__ bool next(int i, Unit& u) const {
        const int tiles = nM * nN; const long L = (long)(i / nseg) * G + c; if (L >= (long)tiles * nlay) return false;
        u.seg = i % nseg; u.lay = (int)(L / tiles); int wgid = (int)(L % tiles);
        { const int q = tiles / NXCD, r = tiles % NXCD, xcd = wgid % NXCD, off = wgid / NXCD; wgid = (xcd < r ? xcd * (q + 1) : r * (q + 1) + (xcd - r) * q) + off; }
        const int nig = WGM * nN, gid = wgid / nig, fm = gid * WGM, gsz = (nM - fm) < WGM ? (nM - fm) : WGM;
        u.pm = fm + ((wgid % nig) % gsz); u.pn = (wgid % nig) / gsz; return true;
    }
    __device__ __forceinline__ const char* pa(const Unit& u) const { return (const char*)(A + u.lay * a_lay + (size_t)u.pm * BM * lda + (size_t)u.seg * K); }
    __device__ __forceinline__ const char* pb(const Unit& u) const { return (const char*)(Bt + u.lay * b_lay + (size_t)u.pn * BM * ldb + (size_t)u.seg * K); }
};

__device__ __forceinline__ void p3_rowscale(const GPh& P, const int row, const int seg, float& rs0, float& rs1) {
    rs0 = 1.f; rs1 = 1.f;
    if (seg < 2) { const f32x4 a0 = *(const f32x4*)(P.SSQ + (size_t)row * 16), a1 = *(const f32x4*)(P.SSQ + (size_t)row * 16 + 4), b0 = *(const f32x4*)(P.SSQ + (size_t)row * 16 + 8), b1 = *(const f32x4*)(P.SSQ + (size_t)row * 16 + 12);
        rs0 = rsqrtf((a0[0] + a0[1] + a0[2] + a0[3] + a1[0] + a1[1] + a1[2] + a1[3]) * (1.0f / 512.0f) + EPS);
        rs1 = rsqrtf((b0[0] + b0[1] + b0[2] + b0[3] + b1[0] + b1[1] + b1[2] + b1[3]) * (1.0f / 512.0f) + EPS); }
}
__device__ __forceinline__ void p3_elem(const GPh& P, f32x4& v, const int row, const int col, const int seg, const float rs0, const float rs1) {
    const bf16_t* prow = P.PROJ + (size_t)row * NPROJ;
    if (seg == 0) { v = v * (rs0 * frcp(rs1)); }
    else if (seg == 1) { const u32x2 ga = *(const u32x2*)(prow + C_GA + col), gb = *(const u32x2*)(prow + C_GB + col);
        v[0] *= rs1 * bf_lo(ga.x) * frcp(bf_lo(gb.x)); v[1] *= rs1 * bf_hi(ga.x) * frcp(bf_hi(gb.x)); v[2] *= rs1 * bf_lo(ga.y) * frcp(bf_lo(gb.y)); v[3] *= rs1 * bf_hi(ga.y) * frcp(bf_hi(gb.y)); }
    else if (seg == 2) { const u32x2 ga = *(const u32x2*)(prow + C_GB + col), gb = *(const u32x2*)(prow + C_GC + col);
        v[0] *= bf_lo(ga.x) * frcp(bf_lo(gb.x)); v[1] *= bf_hi(ga.x) * frcp(bf_hi(gb.x)); v[2] *= bf_lo(ga.y) * frcp(bf_lo(gb.y)); v[3] *= bf_hi(ga.y) * frcp(bf_hi(gb.y)); }
    else { const u32x2 gc = *(const u32x2*)(prow + C_GC + col);
        u32x2 o; o.x = cvt_pk_bf16(v[0] * bf_lo(gc.x), v[1] * bf_hi(gc.x)); o.y = cvt_pk_bf16(v[2] * bf_lo(gc.y), v[3] * bf_hi(gc.y)); *(u32x2*)(P.O + (size_t)row * 1024 + col) = o; }
}
template <int EPI>
__device__ __forceinline__ void epi_row(const GPh& P, f32x4 (&a)[2][2], const int row, const int col0, const int pn, const int wc, const int fq, const int seg, const int lay) {
    if constexpr (EPI == EPI_UP) {
        bf16_t* O = P.O + (size_t)lay * MT * 1024;
#pragma unroll
        for (int bj = 0; bj < 2; ++bj)
#pragma unroll
            for (int n = 0; n < 2; ++n) { const int col = col0 + bj * HALF + n * 16; const f32x4 v = a[bj][n];
                u32x2 o; o.x = cvt_pk_bf16(v[0], v[1]); o.y = cvt_pk_bf16(v[2], v[3]); *(u32x2*)(O + (size_t)row * 1024 + col) = o; }
    } else if constexpr (EPI == EPI_P1) {
        const float r = rownorm(P.rss, row);
#pragma unroll
        for (int bj = 0; bj < 2; ++bj)
#pragma unroll
            for (int n = 0; n < 2; ++n) { const int col = col0 + bj * HALF + n * 16; f32x4 v = a[bj][n] * r;
                if (pn == 28) { if (col - NPROJ < 16) *(f32x4*)(P.DT + (size_t)row * 16 + (col - NPROJ)) = v; }
                else {
                    if (pn >= 10 && pn < 14) { v[0] = gelu_tanh(v[0]); v[1] = gelu_tanh(v[1]); v[2] = gelu_tanh(v[2]); v[3] = gelu_tanh(v[3]); }
                    else if (pn >= 16) { v[0] = sigmoidf_(v[0]); v[1] = sigmoidf_(v[1]); v[2] = sigmoidf_(v[2]); v[3] = sigmoidf_(v[3]); }
                    u32x2 o; o.x = cvt_pk_bf16(v[0], v[1]); o.y = cvt_pk_bf16(v[2], v[3]); *(u32x2*)(P.O + (size_t)row * NPROJ + col) = o; } }
    } else if constexpr (EPI == EPI_P3) {
        float rs0, rs1; p3_rowscale(P, row, seg, rs0, rs1);
#pragma unroll
        for (int bj = 0; bj < 2; ++bj)
#pragma unroll
            for (int n = 0; n < 2; ++n) p3_elem(P, a[bj][n], row, col0 + bj * HALF + n * 16, seg, rs0, rs1);
    } else if constexpr (EPI == EPI_P5) {
        const float r = rownorm(P.rss, row);
#pragma unroll
        for (int bj = 0; bj < 2; ++bj) { const f32x4 g = a[bj][0] * r, uu = a[bj][1] * r;
            const int ocol = 16 * (8 * pn + 4 * bj + wc) + 4 * fq;
            u32x2 o; o.x = cvt_pk_bf16(siluf_(g[0]) * uu[0], siluf_(g[1]) * uu[1]); o.y = cvt_pk_bf16(siluf_(g[2]) * uu[2], siluf_(g[3]) * uu[3]);
            *(u32x2*)(P.O + (size_t)row * DFF + ocol) = o; }
    } else {
        float ss = 0.f; float r7 = 0.f;
        if constexpr (EPI == EPI_P7) r7 = rownorm(P.rss, row);
#pragma unroll
        for (int bj = 0; bj < 2; ++bj)
#pragma unroll
            for (int n = 0; n < 2; ++n) { const int col = col0 + bj * HALF + n * 16; const f32x4 v = a[bj][n];
                const u32x2 xo = *(const u32x2*)(P.XS + (size_t)row * 1024 + col);
                f32x4 xv = (f32x4){bf_lo(xo.x), bf_hi(xo.x), bf_lo(xo.y), bf_hi(xo.y)};
                if constexpr (EPI == EPI_P7) { const u32x2 up = *(const u32x2*)(P.UPB + (size_t)row * 1024 + col);
                    xv[0] += bf_lo(up.x) * sigmoidf_(v[0] * r7); xv[1] += bf_hi(up.x) * sigmoidf_(v[1] * r7); xv[2] += bf_lo(up.y) * sigmoidf_(v[2] * r7); xv[3] += bf_hi(up.y) * sigmoidf_(v[3] * r7); }
                else xv += v;
                u32x2 o; o.x = cvt_pk_bf16(xv[0], xv[1]); o.y = cvt_pk_bf16(xv[2], xv[3]); *(u32x2*)(P.XD + (size_t)row * 1024 + col) = o;
                const float q0 = bf_lo(o.x), q1 = bf_hi(o.x), q2 = bf_lo(o.y), q3 = bf_hi(o.y);
                ss += q0 * q0 + q1 * q1 + q2 * q2 + q3 * q3; }
        ss += shx(ss, 16); ss += shx(ss, 32);
        if (fq == 0) P.rss_next[(size_t)row * 16 + pn * 4 + wc] = ss;
    }
}
template <int EPI>
__device__ __forceinline__ void epilogue(const GPh& P, f32x4 (&acc)[2][2][4][2], const Unit& u, int, int, int, int) {
    const int tid_ = TIDX, wid_ = tid_ >> 6, wr = wid_ >> 2, wc = wid_ & 3, fr = tid_ & 15, fq = (tid_ >> 4) & 3;
    const int row0 = u.pm * BM + wr * 64 + fr, col0 = u.pn * BM + wc * 32 + 4 * fq;
#pragma unroll
    for (int ai = 0; ai < 2; ++ai)
#pragma unroll
        for (int m = 0; m < 4; ++m) {
            const int row = row0 + ai * HALF + m * 16;
            if constexpr (EPI == EPI_P3) {
                float rs0, rs1; p3_rowscale(P, row, u.seg, rs0, rs1);
#pragma unroll
                for (int bj = 0; bj < 2; ++bj)
#pragma unroll
                    for (int n = 0; n < 2; ++n) p3_elem(P, acc[ai][bj][m][n], row, col0 + bj * HALF + n * 16, u.seg, rs0, rs1);
            } else {
                f32x4 a[2][2] = {{acc[ai][0][m][0], acc[ai][0][m][1]}, {acc[ai][1][m][0], acc[ai][1][m][1]}};
                epi_row<EPI>(P, a, row, col0, u.pn, wc, fq, u.seg, u.lay);
            }
        }
}

template <int EPI>
__device__ __forceinline__ void mini_gemm(LAS uchar* lds, const GPh& P) {
    const int tid = TIDX, wid = tid >> 6, lane = tid & 63, kh = wid >> 2, wc = wid & 3, fr = lane & 15, fq = lane >> 4;
    const int nseg = P.nseg, K = P.K, Kh = K >> 1;
    for (int su = P.c; su < 256; su += P.G) {
        const int strip = su >> 2, pn = su & 3; const int row = MPR + strip * 16 + fr;
        const bf16_t* Ap = P.A + (size_t)row * P.lda + fq * 8;
        const bf16_t* Bp = P.Bt + (size_t)(pn * 256 + wc * 32 + fr) * P.ldb + fq * 8;
        f32x4 a[2][2];
#pragma unroll
        for (int bj = 0; bj < 2; ++bj)
#pragma unroll
            for (int n = 0; n < 2; ++n) a[bj][n] = (f32x4){0.f, 0.f, 0.f, 0.f};
        __syncthreads();
        for (int seg = 0; seg < nseg; ++seg) {
            const int kbeg = seg * K + kh * Kh;
#pragma unroll 1
            for (int k0 = kbeg; k0 < kbeg + Kh; k0 += 128) {
                bf16x8 af[4], bfr[4][2][2];
#pragma unroll
                for (int s = 0; s < 4; ++s) { af[s] = *(const bf16x8*)(Ap + k0 + s * 32);
#pragma unroll
                    for (int bj = 0; bj < 2; ++bj)
#pragma unroll
                        for (int n = 0; n < 2; ++n) bfr[s][bj][n] = *(const bf16x8*)(Bp + (size_t)(bj * HALF + n * 16) * P.ldb + k0 + s * 32); }
#pragma unroll
                for (int s = 0; s < 4; ++s)
#pragma unroll
                    for (int bj = 0; bj < 2; ++bj)
#pragma unroll
                        for (int n = 0; n < 2; ++n) a[bj][n] = __builtin_amdgcn_mfma_f32_16x16x32_bf16(bfr[s][bj][n], af[s], a[bj][n], 0, 0, 0);
            }
            if (EPI == EPI_P3 && seg < 3) epi_row<EPI>(P, a, row, pn * 256 + wc * 32 + 4 * fq, pn, wc, fq, seg, 0);
        }
        LAS f32x4* xch = (LAS f32x4*)lds;
        if (kh == 1) {
#pragma unroll
            for (int bj = 0; bj < 2; ++bj)
#pragma unroll
                for (int n = 0; n < 2; ++n) xch[((wc * 4 + bj * 2 + n) * 64) + lane] = a[bj][n];
        }
        __syncthreads();
        if (kh == 0) {
#pragma unroll
            for (int bj = 0; bj < 2; ++bj)
#pragma unroll
                for (int n = 0; n < 2; ++n) a[bj][n] += xch[((wc * 4 + bj * 2 + n) * 64) + lane];
            epi_row<EPI>(P, a, row, pn * 256 + wc * 32 + 4 * fq, pn, wc, fq, nseg - 1, 0);
        }
    }
}

template <int EPI>
__device__ __forceinline__ void gemm_phase(LAS uchar* lds, const GPh& P) {
    const int tid = TIDX, wid = __builtin_amdgcn_readfirstlane(tid >> 6), lane = tid & 63, wr = wid >> 2, wc = wid & 3, fr = lane & 15, fq = lane >> 4;
    const int K = P.K, nt = K / BK;
    unsigned voffA[2], voffB[2];
#pragma unroll
    for (int i = 0; i < 2; ++i) { int R, C; stage_rc(tid * 16 + i * 8192, R, C); voffA[i] = (unsigned)(R * P.lda + C) * 2u; voffB[i] = (unsigned)(R * P.ldb + C) * 2u; }
    const size_t kstep = (size_t)(BK * 2);
    const size_t hstepA = (size_t)HALF * P.lda * 2, hstepB = (size_t)HALF * P.ldb * 2;
    const unsigned ldsw = (unsigned)wid * 1024u;
    const int aoff = lds_byte(wr * 64 + fr, fq * 8), boff = lds_byte(wc * 32 + fr, fq * 8);
#define PG8_SA(b, h) (((b) * 2 + (h)) * HTB)
#define PG8_SB(b, h) ((4 + (b) * 2 + (h)) * HTB)
#define PG8_STAGE(bufoff, gbase, voff) do { _Pragma("unroll") for (int _i = 0; _i < 2; ++_i) \
        __builtin_amdgcn_global_load_lds((const unsigned*)((const char*)(gbase) + (voff)[_i]), (LAS unsigned*)(lds + (bufoff) + ldsw + _i * 8192), 16, 0, 0); } while (0)
#define PG8_LDA(dst, b, h) do { _Pragma("unroll") for (int m = 0; m < 4; ++m) _Pragma("unroll") for (int k = 0; k < 2; ++k) dst[m][k] = *(const LAS bf16x8*)(lds + PG8_SA(b, h) + aoff + m * 2048 + k * 1024); } while (0)
#define PG8_LDB(dst, b, h) do { _Pragma("unroll") for (int n = 0; n < 2; ++n) _Pragma("unroll") for (int k = 0; k < 2; ++k) dst[n][k] = *(const LAS bf16x8*)(lds + PG8_SB(b, h) + boff + n * 2048 + k * 1024); } while (0)
#define PG8_MMA(ai, bj, At, Bt) do { __builtin_amdgcn_s_setprio(1); _Pragma("unroll") for (int m = 0; m < 4; ++m) _Pragma("unroll") for (int n = 0; n < 2; ++n) _Pragma("unroll") for (int k = 0; k < 2; ++k) \
        acc[ai][bj][m][n] = __builtin_amdgcn_mfma_f32_16x16x32_bf16(Bt[n][k], At[m][k], acc[ai][bj][m][n], 0, 0, 0); __builtin_amdgcn_s_setprio(0); } while (0)
#define PG8_WAIT_V(n) asm volatile("s_waitcnt vmcnt(" #n ")" ::: "memory")
#define PG8_WAIT_L(n) asm volatile("s_waitcnt lgkmcnt(" #n ")" ::: "memory")
#define PG8_BAR __builtin_amdgcn_s_barrier()
#define PG8_SCHED __builtin_amdgcn_sched_barrier(0)
    Unit cur, nxt; int ui = 0;
    if (!P.next(0, cur)) return;
    f32x4 acc[2][2][4][2];
#pragma unroll
    for (int a = 0; a < 2; ++a)
#pragma unroll
        for (int b = 0; b < 2; ++b)
#pragma unroll
            for (int m = 0; m < 4; ++m)
#pragma unroll
                for (int n = 0; n < 2; ++n) acc[a][b][m][n] = (f32x4){0.f, 0.f, 0.f, 0.f};
    bf16x8 At[4][2], B0[2][2], B1[2][2];
    const char* cA = P.pa(cur); const char* cB = P.pb(cur);
    PG8_STAGE(PG8_SB(0, 0), cB, voffB); PG8_STAGE(PG8_SA(0, 0), cA, voffA); PG8_STAGE(PG8_SB(0, 1), cB + hstepB, voffB); PG8_STAGE(PG8_SA(0, 1), cA + hstepA, voffA);
    if (wr == 1) PG8_BAR;
    PG8_WAIT_V(4); PG8_BAR;
    PG8_STAGE(PG8_SB(1, 0), cB + kstep, voffB); PG8_STAGE(PG8_SA(1, 0), cA + kstep, voffA); PG8_STAGE(PG8_SB(1, 1), cB + hstepB + kstep, voffB);
    PG8_WAIT_V(6); PG8_BAR;
    for (;;) {
        const bool has_next = P.next(ui + 1, nxt);
        const char* nA = has_next ? P.pa(nxt) : cA; const char* nB = has_next ? P.pb(nxt) : cB;
        for (int t = 0; t < nt; t += 2) {
            const bool last = (t == nt - 2);
            const char* a1 = cA + (size_t)(t + 1) * kstep;
            const char* a2 = last ? nA : cA + (size_t)(t + 2) * kstep; const char* b2 = last ? nB : cB + (size_t)(t + 2) * kstep;
            const char* a3 = a2 + kstep; const char* b3 = b2 + kstep;
            PG8_LDB(B0, 0, 0); PG8_SCHED; PG8_LDA(At, 0, 0); PG8_STAGE(PG8_SA(1, 1), a1 + hstepA, voffA);
            PG8_WAIT_L(8); PG8_BAR; PG8_WAIT_L(0); PG8_MMA(0, 0, At, B0); PG8_BAR; PG8_SCHED;
            PG8_LDB(B1, 0, 1); PG8_STAGE(PG8_SB(0, 0), b2, voffB);
            PG8_BAR; PG8_WAIT_L(0); PG8_MMA(0, 1, At, B1); PG8_BAR;
            PG8_LDA(At, 0, 1); PG8_STAGE(PG8_SA(0, 0), a2, voffA);
            PG8_BAR; PG8_WAIT_L(0); PG8_MMA(1, 0, At, B0); PG8_BAR; PG8_SCHED;
            PG8_STAGE(PG8_SB(0, 1), b2 + hstepB, voffB);
            PG8_WAIT_V(6); PG8_BAR; PG8_MMA(1, 1, At, B1); PG8_BAR;
            PG8_LDB(B0, 1, 0); PG8_SCHED; PG8_LDA(At, 1, 0); PG8_STAGE(PG8_SA(0, 1), a2 + hstepA, voffA);
            PG8_WAIT_L(8); PG8_BAR; PG8_WAIT_L(0); PG8_MMA(0, 0, At, B0); PG8_BAR; PG8_SCHED;
            PG8_LDB(B1, 1, 1); PG8_STAGE(PG8_SB(1, 0), b3, voffB);
            PG8_BAR; PG8_WAIT_L(0); PG8_MMA(0, 1, At, B1); PG8_BAR;
            PG8_LDA(At, 1, 1); PG8_STAGE(PG8_SA(1, 0), a3, voffA);
            PG8_BAR; PG8_WAIT_L(0); PG8_MMA(1, 0, At, B0); PG8_BAR; PG8_SCHED;
            PG8_STAGE(PG8_SB(1, 1), b3 + hstepB, voffB);
            PG8_WAIT_V(6); PG8_BAR; PG8_MMA(1, 1, At, B1); PG8_BAR;
        }
        epilogue<EPI>(P, acc, cur, wr, wc, fr, fq);
        if (!has_next) break;
        if (EPI != EPI_P3 || cur.seg == 3) {
#pragma unroll
            for (int a = 0; a < 2; ++a)
#pragma unroll
                for (int b = 0; b < 2; ++b)
#pragma unroll
                    for (int m = 0; m < 4; ++m)
#pragma unroll
                        for (int n = 0; n < 2; ++n) acc[a][b][m][n] = (f32x4){0.f, 0.f, 0.f, 0.f};
        }
        cur = nxt; cA = nA; cB = nB; ++ui;
    }
    PG8_WAIT_V(0);
    if (wr == 0) PG8_BAR;
    PG8_BAR;
#undef PG8_SA
#undef PG8_SB
#undef PG8_STAGE
#undef PG8_LDA
#undef PG8_LDB
#undef PG8_MMA
#undef PG8_WAIT_V
#undef PG8_WAIT_L
#undef PG8_BAR
#undef PG8_SCHED
}

template <int NT, int KS>
__device__ __forceinline__ void wmma(const LAS uchar* A, const LAS uchar* B, int pitch, f32x4 (&acc)[NT], int fr, int fq) {
#pragma unroll 1
    for (int ks = 0; ks < KS; ++ks) {
        const bf16x8 a = *(const LAS bf16x8*)(A + fr * pitch + (ks * 32 + fq * 8) * 2);
#pragma unroll
        for (int ni = 0; ni < NT; ++ni) {
            const bf16x8 b = *(const LAS bf16x8*)(B + (ni * 16 + fr) * pitch + (ks * 32 + fq * 8) * 2);
            acc[ni] = __builtin_amdgcn_mfma_f32_16x16x32_bf16(b, a, acc[ni], 0, 0, 0);
        }
    }
}
constexpr int PB = 272;

__device__ __forceinline__ int map_row(int n, int map) {
    if (map == 1) return n < 2560 ? n : (n < 2576 ? 7168 + (n - 2560) : n - 16);
    if (map == 2) { const int up = n >= DFF, nn = up ? n - DFF : n; return 32 * (nn >> 4) + 16 * up + (nn & 15); }
    return n;
}
__device__ __forceinline__ void tr_tile(LAS float* T, const float* src, int N, bf16_t* dst, int ldd, int dcol0, int k0, int n0, int map, const float* gk = nullptr) {
    const int tid = TIDX;
    __syncthreads();
    f32x4 v[8];
    { const int c4 = (tid & 63) * 4, n = n0 + c4;
#pragma unroll
        for (int ps = 0; ps < 8; ++ps) { const int r = ps * 8 + (tid >> 6); v[ps] = (f32x4){0.f, 0.f, 0.f, 0.f}; if (n < N) v[ps] = *(const f32x4*)(src + (size_t)(k0 + r) * N + n); }
#pragma unroll
        for (int ps = 0; ps < 8; ++ps) { const int r = ps * 8 + (tid >> 6); f32x4 w = v[ps];
            if (gk) w = w * gk[k0 + r];
            T[r * 257 + c4 + 0] = w[0]; T[r * 257 + c4 + 1] = w[1]; T[r * 257 + c4 + 2] = w[2]; T[r * 257 + c4 + 3] = w[3]; } }
    __syncthreads();
    { const int n = tid >> 1, kh = (tid & 1) * 32;
        if (n0 + n < N) { bf16_t* drow = dst + (size_t)map_row(n0 + n, map) * ldd + dcol0 + k0 + kh;
#pragma unroll
            for (int q = 0; q < 4; ++q) { float f[8];
#pragma unroll
                for (int jj = 0; jj < 8; ++jj) f[jj] = T[(kh + q * 8 + jj) * 257 + n];
                u32x4 o; o.x = cvt_pk_bf16(f[0], f[1]); o.y = cvt_pk_bf16(f[2], f[3]); o.z = cvt_pk_bf16(f[4], f[5]); o.w = cvt_pk_bf16(f[6], f[7]);
                *(u32x4*)(drow + q * 8) = o; } } }
}

__device__ __forceinline__ void phase_pre(LAS uchar* lds, const Params& P) {
    const int tid = TIDX, G = GDIM, bid = BIDX;
    uchar* ws = (P.ws + launder_z());
    LAS float* T = (LAS float*)lds;
    constexpr int T_IN = 16 * 29, T_BRA = 16 * 4, T_BRB = 8 * 4, T_OUT = 16 * 4, T_GU = 16 * 22, T_DN = 44 * 4, T_PG = 16 * 4, T_PU = 4 * 4;
    constexpr int T_L = T_IN + T_BRA + T_BRB + T_OUT + T_GU + T_DN + T_PG + T_PU;
    for (int job = bid; job < 4 * T_L; job += G) {
        const int l = job / T_L; int j = job % T_L;
        if (j < T_IN) { tr_tile(T, PIN(I_WIN) + (size_t)l * 1024 * 7184, 7184, (bf16_t*)(ws + WS_WIN) + (size_t)l * NIN * 1024, 1024, 0, (j / 29) * 64, (j % 29) * 256, 1, PIN(I_NMIX) + (size_t)l * 1024); continue; } j -= T_IN;
        if (j < T_BRA) { tr_tile(T, PIN(I_WBRA) + (size_t)l * 1024 * 1024, 1024, (bf16_t*)(ws + WS_WBR) + (size_t)l * 1024 * 2048, 2048, 0, (j / 4) * 64, (j % 4) * 256, 0); continue; } j -= T_BRA;
        if (j < T_BRB) { tr_tile(T, PIN(I_WBRB) + (size_t)l * 512 * 1024, 1024, (bf16_t*)(ws + WS_WBR) + (size_t)l * 1024 * 2048, 2048, 1024, (j / 4) * 64, (j % 4) * 256, 0); continue; } j -= T_BRB;
        if (j < T_OUT) { tr_tile(T, PIN(I_WOUT) + (size_t)l * 1024 * 1024, 1024, (bf16_t*)(ws + WS_WOUT) + (size_t)l * 1024 * 1024, 1024, 0, (j / 4) * 64, (j % 4) * 256, 0); continue; } j -= T_OUT;
        if (j < T_GU) { tr_tile(T, PIN(I_WGU) + (size_t)l * 1024 * 5632, 5632, (bf16_t*)(ws + WS_WGU) + (size_t)l * 5632 * 1024, 1024, 0, (j / 22) * 64, (j % 22) * 256, 2, PIN(I_NFFN) + (size_t)l * 1024); continue; } j -= T_GU;
        if (j < T_DN) { tr_tile(T, PIN(I_WDN) + (size_t)l * DFF * 1024, 1024, (bf16_t*)(ws + WS_WDN) + (size_t)l * 1024 * DFF, DFF, 0, (j / 4) * 64, (j % 4) * 256, 0); continue; } j -= T_DN;
        if (j < T_PG) { tr_tile(T, PIN(I_WPG) + (size_t)l * 1024 * 1024, 1024, (bf16_t*)(ws + WS_WPG) + (size_t)l * 1024 * 1024, 1024, 0, (j / 4) * 64, (j % 4) * 256, 0, PIN(I_NPLE) + (size_t)l * 1024); continue; } j -= T_PG;
        tr_tile(T, PIN(I_WPU) + (size_t)l * 256 * 1024, 1024, (bf16_t*)(ws + WS_WPU) + (size_t)l * 1024 * 256, 256, 0, (j / 4) * 64, (j % 4) * 256, 0);
    }
    {
        LAS float* PW = (LAS float*)lds;
        LAS float* WC = (LAS float*)(lds + 128 * 129 * 4);
        for (int job = bid; job < 4 * 4 * 16; job += G) {
            const int l = job >> 6, g = (job >> 4) & 3, n0 = (job & 15) * 64;
            __syncthreads();
            for (int e = tid; e < 128 * 128; e += NTHR) { const int c = e >> 7, d = e & 127; PW[c * 129 + d] = PIN(I_POOLW)[((size_t)(l * 4 + g) * 128 + c) * 128 + d] * PIN(I_POOLS)[l * 512 + g * 128 + d]; }
            for (int e = tid; e < 128 * 64; e += NTHR) { const int d = e >> 6, n = e & 63; WC[d * 64 + n] = PIN(I_WBRC)[((size_t)l * 512 + g * 128 + d) * 1024 + n0 + n]; }
            __syncthreads();
            const int c = tid & 127, nq = (tid >> 7) * 16;
            float a[16];
#pragma unroll
            for (int i = 0; i < 16; ++i) a[i] = 0.f;
            for (int d = 0; d < 128; ++d) { const float pw = PW[c * 129 + d];
#pragma unroll
                for (int i = 0; i < 16; ++i) a[i] += pw * WC[d * 64 + nq + i]; }
            bf16_t* dst = (bf16_t*)(ws + WS_WBR) + (size_t)l * 1024 * 2048;
#pragma unroll
            for (int i = 0; i < 16; ++i) dst[(size_t)(n0 + nq + i) * 2048 + 1536 + g * 128 + c] = (bf16_t)(cvt_pk_bf16(a[i], 0.f) & 0xffffu);
        }
    }
    {
        const int lane = tid & 63, wv = tid >> 6;
        bf16_t* XB = (bf16_t*)(ws + WS_XN); float* RSS = (float*)(ws + WS_RSS);
        for (int row = bid * 8 + wv; row < MT; row += G * 8) {
            const float* src = row < MPR ? PIN(I_XP) + (size_t)row * 1024 : PIN(I_XS) + (size_t)(row - MPR) * 1024;
            float ss = 0.f;
#pragma unroll
            for (int i = 0; i < 4; ++i) { const int col = i * 256 + lane * 4; const f32x4 v = *(const f32x4*)(src + col);
                u32x2 o; o.x = cvt_pk_bf16(v[0], v[1]); o.y = cvt_pk_bf16(v[2], v[3]); *(u32x2*)(XB + (size_t)row * 1024 + col) = o;
                const float q0 = bf_lo(o.x), q1 = bf_hi(o.x), q2 = bf_lo(o.y), q3 = bf_hi(o.y); ss += q0 * q0 + q1 * q1 + q2 * q2 + q3 * q3; }
#pragma unroll
            for (int s = 1; s < 64; s <<= 1) ss += shx(ss, s);
            if (lane < 16) RSS[(size_t)row * 16 + lane] = lane == 0 ? ss : 0.f;
        }
    }
    {
        bf16_t* PBF = (bf16_t*)(ws + WS_PBF);
        const size_t n4 = (size_t)4 * MT * 256 / 4;
        for (size_t i = (size_t)bid * NTHR + tid; i < n4; i += (size_t)G * NTHR) {
            const size_t e = i * 4; const int l = (int)(e / ((size_t)MT * 256)); const size_t rem = e % ((size_t)MT * 256); const int row = (int)(rem >> 8), col = (int)(rem & 255);
            const float* src = row < MPR ? PIN(I_PP) + ((size_t)l * MPR + row) * 256 + col : PIN(I_PS) + ((size_t)l * 1024 + (row - MPR)) * 256 + col;
            const f32x4 v = *(const f32x4*)src; u32x2 o; o.x = cvt_pk_bf16(v[0], v[1]); o.y = cvt_pk_bf16(v[2], v[3]); *(u32x2*)(PBF + e) = o;
        }
    }
}

constexpr int L_CS = 0, L_BS = 34816, L_BDT = 69632, L_XT = 104448, L_SB = 121856, L_SC = 139264;
__device__ __forceinline__ int xbc_chan(int cc, int h, int g) { return cc < 64 ? h * 64 + cc : (cc < 192 ? 1024 + g * 128 + (cc - 64) : 1280 + g * 128 + (cc - 192)); }

__device__ __forceinline__ void ssd_prompt(LAS uchar* lds, const Params& P, int l, int b, int h) {
    const int tid = TIDX, lane = tid & 63, w = tid >> 6, fr = lane & 15, fq = lane >> 4, g = h >> 3;
    const bf16_t* PROJ = (const bf16_t*)((P.ws + launder_z()) + WS_PROJ); const float* DT = (const float*)((P.ws + launder_z()) + WS_DT);
    bf16_t* Y = (bf16_t*)((P.ws + launder_z()) + WS_Y); float* SSQ = (float*)((P.ws + launder_z()) + WS_SSQ);
    const float a_h = -__expf(PIN(I_ALOG)[l * 16 + h]), dtb = PIN(I_DTB)[l * 16 + h], Dh = PIN(I_DSKIP)[l * 16 + h];
    f32x4 S[4];
#pragma unroll
    for (int i = 0; i < 4; ++i) S[i] = (f32x4){0.f, 0.f, 0.f, 0.f};
    const int wu = __builtin_amdgcn_readfirstlane(w);
    const bf16_t* xsrc = PROJ + (size_t)(b * 2048) * NPROJ + C_XBC;
    const float* cwp = PIN(I_CONVW) + (size_t)l * 4 * 1536; const float* cbp = PIN(I_CONVB) + (size_t)l * 1536;
    const bf16_t* CBC = (const bf16_t*)((P.ws + launder_z()) + WS_CBC);
    float dN0 = 0.f, dN1 = 0.f;
#define SSD_LD1(cc, i, dst) do { if ((i) == 0) { const int ch_ = h * 64 + wu * 8; \
            _Pragma("unroll") for (int k = 0; k < 5; ++k) { const int pos = (cc) * 128 + 2 * lane - 3 + k; \
                dst[k] = (u32x4){0u, 0u, 0u, 0u}; if (pos >= 0) dst[k] = *(const u32x4*)(xsrc + (size_t)pos * NPROJ + ch_); } } \
        else { const int cgx_ = 8 * (i) + wu; const int col_ = cgx_ < 24 ? g * 128 + (cgx_ - 8) * 8 : 256 + g * 128 + (cgx_ - 24) * 8; \
            const bf16_t* cs_ = CBC + ((size_t)b * 2048 + (cc) * 128 + 2 * lane) * 512 + col_; dst[0] = *(const u32x4*)cs_; dst[1] = *(const u32x4*)(cs_ + 512); } } while (0)
#define SSD_DTLOAD(cc) do { if (w == 0) { dN0 = DT[(size_t)(b * 2048 + (cc) * 128 + 2 * lane) * 16 + h]; dN1 = DT[(size_t)(b * 2048 + (cc) * 128 + 2 * lane + 1) * 16 + h]; } } while (0)
#define SSD_SCAL(sb) do { if (w == 0) { LAS float* acs_ = (LAS float*)(lds + L_SC + (sb) * 2048); \
            const float d0 = softplusf_(dN0 + dtb), d1 = softplusf_(dN1 + dtb); const float a0 = d0 * a_h, a1 = d1 * a_h; float inc = a0 + a1; \
            _Pragma("unroll") for (int s = 1; s < 64; s <<= 1) { const float o = __shfl_up(inc, s, 64); if (lane >= s) inc += o; } \
            const float tot = __shfl(inc, 63, 64); const float c1 = inc, c0 = inc - a1; \
            acs_[2 * lane] = c0; acs_[2 * lane + 1] = c1; acs_[128 + 2 * lane] = d0; acs_[128 + 2 * lane + 1] = d1; \
            acs_[256 + 2 * lane] = __expf(c0); acs_[256 + 2 * lane + 1] = __expf(c1); acs_[384 + 2 * lane] = __expf(tot - c0) * d0; acs_[384 + 2 * lane + 1] = __expf(tot - c1) * d1; } } while (0)
#define SSD_CONV(sb, cc) do { const int lr = 2 * launder_v(lane); const LAS float* decdt_ = (const LAS float*)(lds + L_SC + (sb) * 2048) + 384; \
        u32x4 xr[2][5]; SSD_LD1(cc, 0, xr[0]); \
        _Pragma("unroll") for (int i = 0; i < 5; ++i) { const int cgx = 8 * i + wu; const int ch_ = xbc_chan(cgx * 8, h, g); \
            if (i < 4) SSD_LD1(cc, i + 1, xr[(i + 1) & 1]); \
            float xf[5][8]; \
            _Pragma("unroll") for (int k = 0; k < (i == 0 ? 5 : 2); ++k) { const u32x4 v = xr[i & 1][k]; \
                xf[k][0] = bf_lo(v.x); xf[k][1] = bf_hi(v.x); xf[k][2] = bf_lo(v.y); xf[k][3] = bf_hi(v.y); xf[k][4] = bf_lo(v.z); xf[k][5] = bf_hi(v.z); xf[k][6] = bf_lo(v.w); xf[k][7] = bf_hi(v.w); } \
            float o0[8], o1[8]; \
            if (i == 0) { _Pragma("unroll") for (int j = 0; j < 8; ++j) { \
                const float w0 = cwp[ch_ + j], w1 = cwp[1536 + ch_ + j], w2 = cwp[3072 + ch_ + j], w3 = cwp[4608 + ch_ + j]; \
                const float bb = cbp[ch_ + j]; \
                o0[j] = siluf_(bb + w0 * xf[0][j] + w1 * xf[1][j] + w2 * xf[2][j] + w3 * xf[3][j]); \
                o1[j] = siluf_(bb + w0 * xf[1][j] + w1 * xf[2][j] + w2 * xf[3][j] + w3 * xf[4][j]); } } \
            else { _Pragma("unroll") for (int j = 0; j < 8; ++j) { o0[j] = xf[0][j]; o1[j] = xf[1][j]; } } \
            if (cgx < 8) { _Pragma("unroll") for (int j = 0; j < 8; ++j) *(LAS unsigned*)(lds + L_XT + (cgx * 8 + j) * PB + lr * 2) = cvt_pk_bf16(o0[j], o1[j]); } \
            else if (cgx < 24) { const int n0 = (cgx - 8) * 8; const float s0 = decdt_[lr], s1 = decdt_[lr + 1]; \
                u32x4 q; q.x = cvt_pk_bf16(o0[0], o0[1]); q.y = cvt_pk_bf16(o0[2], o0[3]); q.z = cvt_pk_bf16(o0[4], o0[5]); q.w = cvt_pk_bf16(o0[6], o0[7]); *(LAS u32x4*)(lds + L_BS + lr * PB + n0 * 2) = q; \
                q.x = cvt_pk_bf16(o1[0], o1[1]); q.y = cvt_pk_bf16(o1[2], o1[3]); q.z = cvt_pk_bf16(o1[4], o1[5]); q.w = cvt_pk_bf16(o1[6], o1[7]); *(LAS u32x4*)(lds + L_BS + (lr + 1) * PB + n0 * 2) = q; \
                _Pragma("unroll") for (int j = 0; j < 8; ++j) *(LAS unsigned*)(lds + L_BDT + (n0 + j) * PB + lr * 2) = cvt_pk_bf16(o0[j] * s0, o1[j] * s1); } \
            else { const int n0 = (cgx - 24) * 8; \
                u32x4 q; q.x = cvt_pk_bf16(o0[0], o0[1]); q.y = cvt_pk_bf16(o0[2], o0[3]); q.z = cvt_pk_bf16(o0[4], o0[5]); q.w = cvt_pk_bf16(o0[6], o0[7]); *(LAS u32x4*)(lds + L_CS + lr * PB + n0 * 2) = q; \
                q.x = cvt_pk_bf16(o1[0], o1[1]); q.y = cvt_pk_bf16(o1[2], o1[3]); q.z = cvt_pk_bf16(o1[4], o1[5]); q.w = cvt_pk_bf16(o1[6], o1[7]); *(LAS u32x4*)(lds + L_CS + (lr + 1) * PB + n0 * 2) = q; } } } while (0)

    __syncthreads();
    SSD_DTLOAD(0);
    SSD_SCAL(0);
    __syncthreads();
    SSD_CONV(0, 0);
#pragma unroll 1
    for (int c = 0; c < 16; ++c) {
        const int grow0 = b * 2048 + c * 128, sb = c & 1;
        LAS float* acs = (LAS float*)(lds + L_SC + sb * 2048); LAS float* dtv = acs + 128; LAS float* eacs = acs + 256;
        __syncthreads();
        if (c < 15) SSD_DTLOAD(c + 1);
        const int lrow = 16 * w + fr, row = grow0 + lrow;
        u32x2 zz[4];
#pragma unroll
        for (int ni = 0; ni < 4; ++ni) zz[ni] = *(const u32x2*)(PROJ + (size_t)row * NPROJ + C_Z + h * 64 + ni * 16 + 4 * fq);
        if (c < 15) SSD_SCAL(sb ^ 1);
        {
            f32x4 cb[8];
#pragma unroll
            for (int i = 0; i < 8; ++i) cb[i] = (f32x4){0.f, 0.f, 0.f, 0.f};
            wmma<8, 4>(lds + L_CS + w * 16 * PB, lds + L_BS, PB, cb, fr, fq);
            __syncthreads();
            const float al = acs[lrow];
#pragma unroll
            for (int ni = 0; ni < 8; ++ni) { const int s0 = ni * 16 + 4 * fq; float mv[4];
#pragma unroll
                for (int e = 0; e < 4; ++e) { const int s = s0 + e; const float dd = fminf(al - acs[s], 0.f); mv[e] = (s <= lrow) ? cb[ni][e] * __expf(dd) * dtv[s] : 0.f; }
                u32x2 o; o.x = cvt_pk_bf16(mv[0], mv[1]); o.y = cvt_pk_bf16(mv[2], mv[3]); *(LAS u32x2*)(lds + L_BS + lrow * PB + s0 * 2) = o; }
        }
        __syncthreads();
        {
            f32x4 y[4];
#pragma unroll
            for (int i = 0; i < 4; ++i) y[i] = (f32x4){0.f, 0.f, 0.f, 0.f};
            if (c > 0) { wmma<4, 4>(lds + L_CS + w * 16 * PB, lds + L_SB, PB, y, fr, fq); const float ea = eacs[lrow];
#pragma unroll
                for (int i = 0; i < 4; ++i) y[i] = y[i] * ea; }
            wmma<4, 4>(lds + L_BS + w * 16 * PB, lds + L_XT, PB, y, fr, fq);
            float ssq = 0.f;
#pragma unroll
            for (int ni = 0; ni < 4; ++ni) { const int p0 = ni * 16 + 4 * fq;
                const f32x4 ng = *(const f32x4*)(PIN(I_SSDN) + (size_t)l * 1024 + h * 64 + p0);
                float zf[4] = {bf_lo(zz[ni].x), bf_hi(zz[ni].x), bf_lo(zz[ni].y), bf_hi(zz[ni].y)}; float ov[4];
#pragma unroll
                for (int e = 0; e < 4; ++e) { const float xs = bf1(*(const LAS bf16_t*)(lds + L_XT + (p0 + e) * PB + lrow * 2)); const float v = (y[ni][e] + Dh * xs) * siluf_(zf[e]); ssq += v * v; ov[e] = v * ng[e]; }
                u32x2 o; o.x = cvt_pk_bf16(ov[0], ov[1]); o.y = cvt_pk_bf16(ov[2], ov[3]); *(u32x2*)(Y + (size_t)row * 2048 + h * 64 + p0) = o; }
            ssq += shx(ssq, 16); ssq += shx(ssq, 32);
            if (fq == 0) SSQ[(size_t)row * 16 + h] = ssq;
        }
        __syncthreads();
        {
            const float et = eacs[127];
#pragma unroll
            for (int i = 0; i < 4; ++i) S[i] = S[i] * et;
            wmma<4, 4>(lds + L_XT + (w >> 1) * 16 * PB, lds + L_BDT + (w & 1) * 64 * PB, PB, S, fr, fq);
            const int p = (w >> 1) * 16 + fr;
#pragma unroll
            for (int ni = 0; ni < 4; ++ni) { const int n0 = (w & 1) * 64 + ni * 16 + 4 * fq; u32x2 o; o.x = cvt_pk_bf16(S[ni][0], S[ni][1]); o.y = cvt_pk_bf16(S[ni][2], S[ni][3]); *(LAS u32x2*)(lds + L_SB + p * PB + n0 * 2) = o; }
        }
        __syncthreads();
        if (c < 15) SSD_CONV(sb ^ 1, c + 1);
    }
#undef SSD_LD1
#undef SSD_DTLOAD
#undef SSD_SCAL
#undef SSD_CONV
    {
        float* dst = (P.out + launder_z()) + O_SSMP + ((size_t)((l * 8 + b) * 16 + h) * 64) * 128; const int p = (w >> 1) * 16 + fr;
#pragma unroll
        for (int ni = 0; ni < 4; ++ni) { const int n0 = (w & 1) * 64 + ni * 16 + 4 * fq; *(f32x4*)(dst + (size_t)p * 128 + n0) = S[ni]; }
    }
}

__device__ __forceinline__ void ssd_sample(LAS uchar* lds, const Params& P, int l, int b, int hp) {
    const int tid = TIDX, half = tid >> 8, t8 = tid & 255, h = hp * 2 + half, g = h >> 3;
    const bf16_t* PROJ = (const bf16_t*)((P.ws + launder_z()) + WS_PROJ); const float* DT = (const float*)((P.ws + launder_z()) + WS_DT);
    bf16_t* Y = (bf16_t*)((P.ws + launder_z()) + WS_Y); float* SSQ = (float*)((P.ws + launder_z()) + WS_SSQ);
    LAS float* xs = (LAS float*)(lds + half * 16384); LAS float* Bv = xs + 512; LAS float* Cv = xs + 1536; LAS float* sdt = xs + 2560; LAS float* sdec = xs + 2568; LAS float* yv = xs + 2576;
    const int row0 = MPR + b * 8;
    const int l16 = t8 & 15, pr = t8 >> 4;
    const float* hin = PIN(I_SSSM) + ((size_t)((l * 128 + b) * 16 + h) * 64) * 128;
    f32x4 hs[4][2];
#pragma unroll
    for (int pi = 0; pi < 4; ++pi)
#pragma unroll
        for (int it = 0; it < 2; ++it) hs[pi][it] = *(const f32x4*)(hin + (size_t)(pi * 16 + pr) * 128 + it * 64 + l16 * 4);
    __syncthreads();
    for (int cc = t8; cc < 320; cc += 256) {
        const int ch = xbc_chan(cc, h, g);
        float xv[11];
#pragma unroll
        for (int k = 0; k < 3; ++k) xv[k] = PIN(I_SCONV)[((size_t)(l * 128 + b) * 3 + k) * 1536 + ch];
#pragma unroll
        for (int t = 0; t < 8; ++t) xv[3 + t] = bf1(PROJ[(size_t)(row0 + t) * NPROJ + C_XBC + ch]);
        const float w0 = PIN(I_CONVW)[(size_t)(l * 4 + 0) * 1536 + ch], w1 = PIN(I_CONVW)[(size_t)(l * 4 + 1) * 1536 + ch], w2 = PIN(I_CONVW)[(size_t)(l * 4 + 2) * 1536 + ch], w3 = PIN(I_CONVW)[(size_t)(l * 4 + 3) * 1536 + ch];
        const float cb = PIN(I_CONVB)[(size_t)l * 1536 + ch];
#pragma unroll
        for (int t = 0; t < 8; ++t) { const float o = siluf_(cb + w0 * xv[t] + w1 * xv[t + 1] + w2 * xv[t + 2] + w3 * xv[t + 3]);
            if (cc < 64) xs[t * 64 + cc]= o; else if (cc < 192) Bv[t * 128 + cc - 64] = o; else Cv[t * 128 + cc - 192] = o; }
    }
    if (t8 < 8) { const float d = softplusf_(DT[(size_t)(row0 + t8) * 16 + h] + PIN(I_DTB)[l * 16 + h]); sdt[t8] = d; sdec[t8] = __expf(-d * __expf(PIN(I_ALOG)[l * 16 + h])); }
    __syncthreads();
    float* hout = (P.out + launder_z()) + O_SSMS + ((size_t)((l * 128 + b) * 16 + h) * 64) * 128;
#pragma unroll 1
    for (int t = 0; t < 8; ++t) {
        const float dec = sdec[t], dtt = sdt[t];
        const f32x4 B0 = *(const LAS f32x4*)(Bv + t * 128 + l16 * 4), B1 = *(const LAS f32x4*)(Bv + t * 128 + 64 + l16 * 4);
        const f32x4 C0 = *(const LAS f32x4*)(Cv + t * 128 + l16 * 4), C1 = *(const LAS f32x4*)(Cv + t * 128 + 64 + l16 * 4);
#pragma unroll
        for (int pi = 0; pi < 4; ++pi) { const float xd = xs[t * 64 + pi * 16 + pr] * dtt;
            hs[pi][0] = hs[pi][0] * dec + B0 * xd; hs[pi][1] = hs[pi][1] * dec + B1 * xd;
            const f32x4 q = hs[pi][0] * C0 + hs[pi][1] * C1; float yp = q[0] + q[1] + q[2] + q[3];
            yp += shx(yp, 1); yp += shx(yp, 2); yp += shx(yp, 4); yp += shx(yp, 8);
            if (l16 == 0) yv[t * 64 + pi * 16 + pr] = yp; }
    }
#pragma unroll
    for (int pi = 0; pi < 4; ++pi)
#pragma unroll
        for (int it = 0; it < 2; ++it) *(f32x4*)(hout + (size_t)(pi * 16 + pr) * 128 + it * 64 + l16 * 4) = hs[pi][it];
    __syncthreads();
    {
        const int t = t8 >> 5, p0 = (t8 & 31) * 2, row = row0 + t; const float Dh = PIN(I_DSKIP)[l * 16 + h];
        const unsigned zz = *(const unsigned*)(PROJ + (size_t)row * NPROJ + C_Z + h * 64 + p0);
        const float v0 = (yv[t * 64 + p0] + Dh * xs[t * 64 + p0]) * siluf_(bf_lo(zz)), v1 = (yv[t * 64 + p0 + 1] + Dh * xs[t * 64 + p0 + 1]) * siluf_(bf_hi(zz));
        float ssq = v0 * v0 + v1 * v1;
        ssq += shx(ssq, 1); ssq += shx(ssq, 2); ssq += shx(ssq, 4); ssq += shx(ssq, 8); ssq += shx(ssq, 16);
        *(unsigned*)(Y + (size_t)row * 2048 + h * 64 + p0) = cvt_pk_bf16(v0 * PIN(I_SSDN)[(size_t)l * 1024 + h * 64 + p0], v1 * PIN(I_SSDN)[(size_t)l * 1024 + h * 64 + p0 + 1]);
        if ((t8 & 31) == 0) SSQ[(size_t)row * 16 + h] = ssq;
    }
}

__device__ __forceinline__ void sgu_prompt(LAS uchar* lds, const Params& P, int l, int b, int c, int g) {
    const int tid = TIDX, lane = tid & 63, w = tid >> 6, fr = lane & 15, fq = lane >> 4;
    const bf16_t* PROJ = (const bf16_t*)((P.ws + launder_z()) + WS_PROJ); bf16_t* Y = (bf16_t*)((P.ws + launder_z()) + WS_Y);
    LAS float* smu = (LAS float*)(lds + 69632); LAS float* srs = smu + 128;
    const int grow0 = b * 2048 + c * 128;
    __syncthreads();
    {
        const int r = tid >> 2, q = tid & 3; const bf16_t* src = PROJ + (size_t)(grow0 + r) * NPROJ + C_V + q * 128;
        float s = 0.f, s2 = 0.f;
#pragma unroll
        for (int i = 0; i < 16; ++i) { const u32x4 v = *(const u32x4*)(src + i * 8);
            const float f[8] = {bf_lo(v.x), bf_hi(v.x), bf_lo(v.y), bf_hi(v.y), bf_lo(v.z), bf_hi(v.z), bf_lo(v.w), bf_hi(v.w)};
#pragma unroll
            for (int j = 0; j < 8; ++j) { s += f[j]; s2 += f[j] * f[j]; } }
        s += shx(s, 1); s += shx(s, 2); s2 += shx(s2, 1); s2 += shx(s2, 2);
        const float mu = s * (1.0f / 512.0f), var = fmaxf(s2 * (1.0f / 512.0f) - mu * mu, 0.f);
        if (q == 0) { smu[r] = mu; srs[r] = rsqrtf(var + EPS); }
        const float* wsrc = PIN(I_WSP) + ((size_t)(l * 4 + g) * 128 + r) * 128 + q * 32;
#pragma unroll
        for (int i = 0; i < 4; ++i) { const f32x4 a = *(const f32x4*)(wsrc + i * 8), bb = *(const f32x4*)(wsrc + i * 8 + 4); const int s0 = q * 32 + i * 8;
            u32x4 o; o.x = cvt_pk_bf16(s0 + 0 <= r ? a[0] : 0.f, s0 + 1 <= r ? a[1] : 0.f); o.y = cvt_pk_bf16(s0 + 2 <= r ? a[2] : 0.f, s0 + 3 <= r ? a[3] : 0.f);
            o.z = cvt_pk_bf16(s0 + 4 <= r ? bb[0] : 0.f, s0 + 5 <= r ? bb[1] : 0.f); o.w = cvt_pk_bf16(s0 + 6 <= r ? bb[2] : 0.f, s0 + 7 <= r ? bb[3] : 0.f);
            *(LAS u32x4*)(lds + r * PB + s0 * 2) = o; }
    }
    __syncthreads();
    {
        const int r = tid >> 2, q = tid & 3; const bf16_t* src = PROJ + (size_t)(grow0 + r) * NPROJ + C_V + g * 128 + q * 32;
        const float mu = smu[r], rs = srs[r];
        const float* lg = PIN(I_LNG) + (size_t)l * 512 + g * 128 + q * 32; const float* lb = PIN(I_LNB) + (size_t)l * 512 + g * 128 + q * 32;
        float* vout = (P.out + launder_z()) + O_VP + ((size_t)(l * 8 + b) * 128 + r) * 512 + g * 128 + q * 32;
#pragma unroll
        for (int i = 0; i < 4; ++i) { const u32x4 v = *(const u32x4*)(src + i * 8);
            const float f[8] = {bf_lo(v.x), bf_hi(v.x), bf_lo(v.y), bf_hi(v.y), bf_lo(v.z), bf_hi(v.z), bf_lo(v.w), bf_hi(v.w)}; float vn[8];
#pragma unroll
            for (int j = 0; j < 8; ++j) { vn[j] = (f[j] - mu) * rs * lg[i * 8 + j] + lb[i * 8 + j];
                *(LAS bf16_t*)(lds + 34816 + (q * 32 + i * 8 + j) * PB + r * 2) = (bf16_t)(cvt_pk_bf16(vn[j], 0.f) & 0xffffu); }
            if (c == 15) { *(f32x4*)(vout + i * 8) = (f32x4){vn[0], vn[1], vn[2], vn[3]}; *(f32x4*)(vout + i * 8 + 4) = (f32x4){vn[4], vn[5], vn[6], vn[7]}; } }
    }
    __syncthreads();
    {
        f32x4 acc[8];
#pragma unroll
        for (int i = 0; i < 8; ++i) acc[i] = (f32x4){0.f, 0.f, 0.f, 0.f};
        wmma<8, 4>(lds + w * 16 * PB, lds + 34816, PB, acc, fr, fq);
        const int t = 16 * w + fr, row = grow0 + t; const float bs = PIN(I_BSP)[(size_t)(l * 4 + g) * 128 + t];
#pragma unroll
        for (int ni = 0; ni < 8; ++ni) { const int d0 = ni * 16 + 4 * fq; const u32x2 uu = *(const u32x2*)(PROJ + (size_t)row * NPROJ + C_U + g * 128 + d0);
            u32x2 o; o.x = cvt_pk_bf16(bf_lo(uu.x) * (acc[ni][0] + bs), bf_hi(uu.x) * (acc[ni][1] + bs)); o.y = cvt_pk_bf16(bf_lo(uu.y) * (acc[ni][2] + bs), bf_hi(uu.y) * (acc[ni][3] + bs));
            *(u32x2*)(Y + (size_t)row * 2048 + 1024 + g * 128 + d0) = o; }
    }
}

__device__ __forceinline__ void sgu_sample(LAS uchar* lds, const Params& P, int l, int b) {
    const int tid = TIDX, lane = tid & 63, w = tid >> 6, ch = tid, g = ch >> 7;
    const bf16_t* PROJ = (const bf16_t*)((P.ws + launder_z()) + WS_PROJ); bf16_t* Y = (bf16_t*)((P.ws + launder_z()) + WS_Y);
    LAS float* red = (LAS float*)lds;
    const int row0 = MPR + b * 8;
    float v[8], u[8];
#pragma unroll
    for (int s = 0; s < 8; ++s) { v[s] = bf1(PROJ[(size_t)(row0 + s) * NPROJ + C_V + ch]); u[s] = bf1(PROJ[(size_t)(row0 + s) * NPROJ + C_U + ch]); }
    __syncthreads();
#pragma unroll
    for (int s = 0; s < 8; ++s) { float a = v[s], a2 = v[s] * v[s];
#pragma unroll
        for (int m = 1; m < 64; m <<= 1) { a += shx(a, m); a2 += shx(a2, m); }
        if (lane == 0) { red[w * 16 + s] = a; red[w * 16 + 8 + s] = a2; } }
    __syncthreads();
    const float lg = PIN(I_LNG)[(size_t)l * 512 + ch], lb = PIN(I_LNB)[(size_t)l * 512 + ch];
    float vn[8];
#pragma unroll
    for (int s = 0; s < 8; ++s) { float a = 0.f, a2 = 0.f;
#pragma unroll
        for (int ww = 0; ww < 8; ++ww) { a += red[ww * 16 + s]; a2 += red[ww * 16 + 8 + s]; }
        const float mu = a * (1.0f / 512.0f), var = fmaxf(a2 * (1.0f / 512.0f) - mu * mu, 0.f);
        vn[s] = (v[s] - mu) * rsqrtf(var + EPS) * lg + lb;
        (P.out + launder_z())[O_VS + ((size_t)(l * 128 + b) * 8 + s) * 512 + ch] = vn[s]; }
    const float* W = PIN(I_WSP) + (size_t)(l * 4 + g) * 128 * 128; const float* bsp = PIN(I_BSP) + (size_t)(l * 4 + g) * 128;
#pragma unroll
    for (int t = 0; t < 8; ++t) { float o = bsp[t];
#pragma unroll
        for (int s = 0; s <= t; ++s) o += W[t * 128 + s] * vn[s];
        Y[(size_t)(row0 + t) * 2048 + 1024 + ch] = (bf16_t)(cvt_pk_bf16(u[t] * o, 0.f) & 0xffffu); }
}

__device__ __forceinline__ void pool_prompt(const Params& P, int tile) {
    const int tid = TIDX, cgp = tid & 63, rsg = tid >> 6, ch0 = cgp * 8, wdw = 2 << (cgp >> 4);
    const bf16_t* PROJ = (const bf16_t*)((P.ws + launder_z()) + WS_PROJ); bf16_t* Y = (bf16_t*)((P.ws + launder_z()) + WS_Y);
    const int b = tile >> 4, pos0 = (tile & 15) * 128 + rsg * 16; const size_t rbase = (size_t)b * 2048;
    float S[8];
#pragma unroll
    for (int j = 0; j < 8; ++j) S[j] = 0.f;
    for (int k = 1; k < wdw; ++k) { const int pos = pos0 - k; if (pos >= 0) { const u32x4 v = *(const u32x4*)(PROJ + (rbase + pos) * NPROJ + C_POOL + ch0);
        S[0] += bf_lo(v.x); S[1] += bf_hi(v.x); S[2] += bf_lo(v.y); S[3] += bf_hi(v.y); S[4] += bf_lo(v.z); S[5] += bf_hi(v.z); S[6] += bf_lo(v.w); S[7] += bf_hi(v.w); } }
#pragma unroll 1
    for (int t = 0; t < 16; ++t) { const int pos = pos0 + t;
        const u32x4 v = *(const u32x4*)(PROJ + (rbase + pos) * NPROJ + C_POOL + ch0);
        const float x[8] = {bf_lo(v.x), bf_hi(v.x), bf_lo(v.y), bf_hi(v.y), bf_lo(v.z), bf_hi(v.z), bf_lo(v.w), bf_hi(v.w)};
        const float ic = 1.0f / (float)min(pos + 1, wdw); float d[8];
#pragma unroll
        for (int j = 0; j < 8; ++j) { S[j] += x[j]; d[j] = S[j] * ic - x[j]; }
        u32x4 o; o.x = cvt_pk_bf16(d[0], d[1]); o.y = cvt_pk_bf16(d[2], d[3]); o.z = cvt_pk_bf16(d[4], d[5]); o.w = cvt_pk_bf16(d[6], d[7]);
        *(u32x4*)(Y + (rbase + pos) * 2048 + 1536 + ch0) = o;
        const int po = pos - wdw + 1;
        if (po >= 0) { const u32x4 q = *(const u32x4*)(PROJ + (rbase + po) * NPROJ + C_POOL + ch0);
            S[0] -= bf_lo(q.x); S[1] -= bf_hi(q.x); S[2] -= bf_lo(q.y); S[3] -= bf_hi(q.y); S[4] -= bf_lo(q.z); S[5] -= bf_hi(q.z); S[6] -= bf_lo(q.w); S[7] -= bf_hi(q.w); } }
}
__device__ __forceinline__ void pool_sample(const Params& P, int l, int si) {
    const int tid = TIDX, cgp = tid & 63, ch0 = cgp * 8, wdw = 2 << (cgp >> 4), b = si * 8 + (tid >> 6);
    const bf16_t* PROJ = (const bf16_t*)((P.ws + launder_z()) + WS_PROJ); bf16_t* Y = (bf16_t*)((P.ws + launder_z()) + WS_Y);
    const float* buf = PIN(I_SPOOL) + (size_t)(l * 128 + b) * 15 * 512 + ch0;
    const size_t rbase = (size_t)MPR + b * 8;
    float S[8];
#pragma unroll
    for (int j = 0; j < 8; ++j) S[j] = 0.f;
    for (int k = 1; k < wdw; ++k) { const f32x4 a = *(const f32x4*)(buf + (size_t)(15 - k) * 512), c = *(const f32x4*)(buf + (size_t)(15 - k) * 512 + 4);
        S[0] += a[0]; S[1] += a[1]; S[2] += a[2]; S[3] += a[3]; S[4] += c[0]; S[5] += c[1]; S[6] += c[2]; S[7] += c[3]; }
    const float ic = 1.0f / (float)wdw;
#pragma unroll 1
    for (int t = 0; t < 8; ++t) {
        const u32x4 v = *(const u32x4*)(PROJ + (rbase + t) * NPROJ + C_POOL + ch0);
        const float x[8] = {bf_lo(v.x), bf_hi(v.x), bf_lo(v.y), bf_hi(v.y), bf_lo(v.z), bf_hi(v.z), bf_lo(v.w), bf_hi(v.w)}; float d[8];
#pragma unroll
        for (int j = 0; j < 8; ++j) { S[j] += x[j]; d[j] = S[j] * ic - x[j]; }
        u32x4 o; o.x = cvt_pk_bf16(d[0], d[1]); o.y = cvt_pk_bf16(d[2], d[3]); o.z = cvt_pk_bf16(d[4], d[5]); o.w = cvt_pk_bf16(d[6], d[7]);
        *(u32x4*)(Y + (rbase + t) * 2048 + 1536 + ch0) = o;
        const int po = t - wdw + 1;
        if (po >= 0) { const u32x4 q = *(const u32x4*)(PROJ + (rbase + po) * NPROJ + C_POOL + ch0);
            S[0] -= bf_lo(q.x); S[1] -= bf_hi(q.x); S[2] -= bf_lo(q.y); S[3] -= bf_hi(q.y); S[4] -= bf_lo(q.z); S[5] -= bf_hi(q.z); S[6] -= bf_lo(q.w); S[7] -= bf_hi(q.w); }
        else { const f32x4 a = *(const f32x4*)(buf + (size_t)(15 + po) * 512), c = *(const f32x4*)(buf + (size_t)(15 + po) * 512 + 4);
            S[0] -= a[0]; S[1] -= a[1]; S[2] -= a[2]; S[3] -= a[3]; S[4] -= c[0]; S[5] -= c[1]; S[6] -= c[2]; S[7] -= c[3]; } }
}
constexpr int NC_CP = 8 * 3 * 1536, NC_CS = 128 * 3 * 1536, NC_PP = 8 * 15 * 512, NC_PS = 128 * 15 * 512, NC_ALL = NC_CP + NC_CS + NC_PP + NC_PS;
__device__ __forceinline__ void state_copy(const Params& P, int l, int item) {
    const bf16_t* PROJ = (const bf16_t*)((P.ws + launder_z()) + WS_PROJ);
    for (int j = 0; j < 16; ++j) { int e = item * 8192 + j * NTHR + TIDX; if (e >= NC_ALL) return;
        if (e < NC_CP) { const int ch = e % 1536, k = (e / 1536) % 3, b = e / 4608; (P.out + launder_z())[O_CONVP + (size_t)l * NC_CP + e] = bf1(PROJ[(size_t)(b * 2048 + 2045 + k) * NPROJ + C_XBC + ch]); continue; } e -= NC_CP;
        if (e < NC_CS) { const int ch = e % 1536, k = (e / 1536) % 3, b = e / 4608; (P.out + launder_z())[O_CONVS + (size_t)l * NC_CS + e] = bf1(PROJ[(size_t)(MPR + b * 8 + 5 + k) * NPROJ + C_XBC + ch]); continue; } e -= NC_CS;
        if (e < NC_PP) { const int ch = e % 512, k = (e / 512) % 15, b = e / 7680; (P.out + launder_z())[O_POOLP + (size_t)l * NC_PP + e] = bf1(PROJ[(size_t)(b * 2048 + 2033 + k) * NPROJ + C_POOL + ch]); continue; } e -= NC_PP;
        { const int ch = e % 512, k = (e / 512) % 15, b = e / 7680;
          (P.out + launder_z())[O_POOLS + (size_t)l * NC_PS + e] = k < 7 ? PIN(I_SPOOL)[((size_t)(l * 128 + b) * 15 + 8 + k) * 512 + ch] : bf1(PROJ[(size_t)(MPR + b * 8 + (k - 7)) * NPROJ + C_POOL + ch]); }
    }
}

__device__ __forceinline__ void phase_convbc(const Params& P, int l) {
    const int tid = TIDX, lane = tid & 63, w = __builtin_amdgcn_readfirstlane(tid >> 6);
    const bf16_t* PROJ = (const bf16_t*)((P.ws + launder_z()) + WS_PROJ); bf16_t* CBC = (bf16_t*)((P.ws + launder_z()) + WS_CBC);
    const float* cwp = PIN(I_CONVW) + (size_t)l * 4 * 1536; const float* cbp = PIN(I_CONVB) + (size_t)l * 1536;
    for (int it = BIDX; it < 256; it += GDIM) {
        const int tile = it >> 1, half = it & 1, b = tile >> 4, c = tile & 15;
        const bf16_t* xsrc = PROJ + (size_t)(b * 2048) * NPROJ + C_XBC + 1024 + half * 256;
#pragma unroll 1
        for (int i = 0; i < 4; ++i) {
            const int cg = i * 8 + w, ch = 1024 + half * 256 + cg * 8;
            float xf[5][8];
#pragma unroll
            for (int k = 0; k < 5; ++k) { const int pos = c * 128 + 2 * lane - 3 + k; u32x4 v = (u32x4){0u, 0u, 0u, 0u}; if (pos >= 0) v = *(const u32x4*)(xsrc + (size_t)pos * NPROJ + cg * 8);
                xf[k][0] = bf_lo(v.x); xf[k][1] = bf_hi(v.x); xf[k][2] = bf_lo(v.y); xf[k][3] = bf_hi(v.y); xf[k][4] = bf_lo(v.z); xf[k][5] = bf_hi(v.z); xf[k][6] = bf_lo(v.w); xf[k][7] = bf_hi(v.w); }
            float o0[8], o1[8];
#pragma unroll
            for (int j = 0; j < 8; ++j) { const float w0 = cwp[ch + j], w1 = cwp[1536 + ch + j], w2 = cwp[3072 + ch + j], w3 = cwp[4608 + ch + j], bb = cbp[ch + j];
                o0[j] = siluf_(bb + w0 * xf[0][j] + w1 * xf[1][j] + w2 * xf[2][j] + w3 * xf[3][j]);
                o1[j] = siluf_(bb + w0 * xf[1][j] + w1 * xf[2][j] + w2 * xf[3][j] + w3 * xf[4][j]); }
            const size_t row = (size_t)b * 2048 + c * 128 + 2 * lane;
            u32x4 q; q.x = cvt_pk_bf16(o0[0], o0[1]); q.y = cvt_pk_bf16(o0[2], o0[3]); q.z = cvt_pk_bf16(o0[4], o0[5]); q.w = cvt_pk_bf16(o0[6], o0[7]); *(u32x4*)(CBC + row * 512 + half * 256 + cg * 8) = q;
            q.x = cvt_pk_bf16(o1[0], o1[1]); q.y = cvt_pk_bf16(o1[2], o1[3]); q.z = cvt_pk_bf16(o1[4], o1[5]); q.w = cvt_pk_bf16(o1[6], o1[7]); *(u32x4*)(CBC + (row + 1) * 512 + half * 256 + cg * 8) = q;
        }
    }
}

__device__ __forceinline__ void phase_mixer(LAS uchar* lds, const Params& P, int l) {
    const int G = GDIM, bid = BIDX;
    constexpr int N_B = 1024, N_C = 512, N_D = 128, N_E = 128, N_E2 = 16, N_F = (NC_ALL + 8191) / 8192;
    constexpr int N_REST = N_B + N_C + N_D + N_E + N_E2 + N_F;
    if (G > 128) { if (bid < 128) ssd_prompt(lds, P, l, bid >> 4, bid & 15); }
    else { for (int i = bid; i < 128; i += G) ssd_prompt(lds, P, l, i >> 4, i & 15); }
    unsigned* ctr = (unsigned*)((P.ws + launder_z()) + WS_BAR) + 3584 + 64 * l;
    volatile LAS unsigned* bc = (volatile LAS unsigned*)(lds + LDS_BYTES) + 2;
    for (;;) {
        __syncthreads();
        if (TIDX == 0) bc[0] = __hip_atomic_fetch_add(ctr, 1u, __ATOMIC_RELAXED, __HIP_MEMORY_SCOPE_AGENT);
        __syncthreads();
        int j = (int)bc[0];
        if (j >= N_REST) break;
        if (j < N_C) { sgu_prompt(lds, P, l, j >> 6, (j >> 2) & 15, j & 3); continue; } j -= N_C;
        if (j < N_B) { ssd_sample(lds, P, l, j >> 3, j & 7); continue; } j -= N_B;
        if (j < N_D) { sgu_sample(lds, P, l, j); continue; } j -= N_D;
        if (j < N_E) { pool_prompt(P, j); continue; } j -= N_E;
        if (j < N_E2) { pool_sample(P, l, j); continue; } j -= N_E2;
        state_copy(P, l, j);
    }
}


#define XB_TMO      128
#define XB_XCNT(j)  (256  + 64 * (j))
#define XB_XSUB(j)  (1280 + 64 * (j))
#define XB_XGEN(j)  (2304 + 64 * (j))
#define XB_TOP      3328
#define XB_TOPGEN   3392
#define XCD_BAR_WORDS 3456
#define XB_SPIN_CAP (1u << 20)
__device__ __forceinline__ unsigned xb_ld(unsigned* p)              { return __hip_atomic_load(p, __ATOMIC_RELAXED, __HIP_MEMORY_SCOPE_AGENT); }
__device__ __forceinline__ unsigned xb_add(unsigned* p, unsigned v) { return __hip_atomic_fetch_add(p, v, __ATOMIC_RELAXED, __HIP_MEMORY_SCOPE_AGENT); }
__device__ __forceinline__ unsigned xb_xcc_id() { return (unsigned)__builtin_amdgcn_s_getreg((3 << 11) | 20) & 0xFu; }
#define XB_SPIN(cond, bar) do { unsigned _sp = 0; while (cond) { __builtin_amdgcn_s_sleep(1); \
    if ((++_sp & 255u) == 0u) { if (xb_ld(&(bar)[XB_TMO])) break; if (_sp > XB_SPIN_CAP) { atomicAdd(&(bar)[XB_TMO], 1u); break; } } } } while (0)
struct XcdBarrier { unsigned* bar; unsigned x; volatile LAS unsigned* st; };
__device__ __forceinline__ XcdBarrier xcd_barrier_post(unsigned* bar, volatile LAS unsigned* st) {
    XcdBarrier b; b.bar = bar; b.x = xb_xcc_id(); b.st = st;
    if (threadIdx.x == 0) (void)xb_add(&bar[XB_XCNT(b.x)], 1u);
    return b;
}
__device__ __forceinline__ void xcd_barrier_complete(unsigned* bar, unsigned x, unsigned& nloc, unsigned& nx) {
    const unsigned G = gridDim.x * gridDim.y * gridDim.z;
    unsigned sum, cnt, mine, sp = 0u;
    for (;;) {
        sum = 0u; cnt = 0u; mine = 0u;
#pragma unroll
        for (unsigned j = 0; j < 16; ++j) { const unsigned c = xb_ld(&bar[XB_XCNT(j)]); sum += c; cnt += (c > 0u) ? 1u : 0u; mine = (j == x) ? c : mine; }
        if (sum == G) break;
        __builtin_amdgcn_s_sleep(1);
        if ((++sp & 255u) == 0u) { if (xb_ld(&bar[XB_TMO])) break; if (sp > XB_SPIN_CAP) { atomicAdd(&bar[XB_TMO], 1u); break; } }
    }
    nloc = mine > 0u ? mine : 1u; nx = cnt > 0u ? cnt : 1u;
}
__device__ __forceinline__ void xcd_barrier(const XcdBarrier& b) {
    asm volatile("s_waitcnt vmcnt(0)" ::: "memory");
    __syncthreads();
    if (threadIdx.x == 0) {
        unsigned* bar = b.bar + launder_z(); const unsigned bx = (unsigned)launder_s((int)b.x);
        __builtin_amdgcn_s_waitcnt(0);
        unsigned nloc = b.st[0], nx = b.st[1];
        if (nloc == 0u) { xcd_barrier_complete(bar, bx, nloc, nx); b.st[0] = nloc; b.st[1] = nx; }
        const unsigned old = xb_add(&bar[XB_XSUB(bx)], 1u);
        const unsigned gen = old / nloc;
        if (old + 1u == (gen + 1u) * nloc) {
            __builtin_amdgcn_fence(__ATOMIC_RELEASE, "agent");
            asm volatile("s_waitcnt vmcnt(0)" ::: "memory");
            const unsigned og = xb_add(&bar[XB_TOP], 1u);
            const unsigned tg = og / nx;
            if (og + 1u == (tg + 1u) * nx) xb_add(&bar[XB_TOPGEN], 1u);
            else XB_SPIN(xb_ld(&bar[XB_TOPGEN]) == tg, bar);
            __builtin_amdgcn_fence(__ATOMIC_ACQUIRE, "agent");
            xb_add(&bar[XB_XGEN(bx)], 1u);
            asm volatile("s_waitcnt vmcnt(0)" ::: "memory");
        } else {
            XB_SPIN(xb_ld(&bar[XB_XGEN(bx)]) == gen, bar);
            __builtin_amdgcn_fence(__ATOMIC_ACQUIRE, "agent");
            asm volatile("s_waitcnt vmcnt(0)" ::: "memory");
        }
    }
    __syncthreads();
}

__device__ __forceinline__ void run_phase(LAS uchar* lds, const Params& P, int ph) {
    uchar* ws = (P.ws + launder_z());
    float* RSS = (float*)(ws + WS_RSS);
    if (ph == 0) { phase_pre(lds, P); return; }
    if (ph == 30) {
        const int tid = TIDX, lane = tid & 63, wv = tid >> 6; const bf16_t* XB = (const bf16_t*)(ws + WS_XN); const float* fg = PIN(I_FN);
        for (int row = BIDX * 8 + wv; row < MT; row += GDIM * 8) { const float r = rownorm(RSS + (size_t)12 * MT * 16, row);
#pragma unroll
            for (int i = 0; i < 4; ++i) { const int col = i * 256 + lane * 4; const u32x2 xo = *(const u32x2*)(XB + (size_t)row * 1024 + col); const f32x4 gg = *(const f32x4*)(fg + col);
                *(f32x4*)((P.out + launder_z()) + O_Y + (size_t)row * 1024 + col) = (f32x4){bf_lo(xo.x) * r * gg[0], bf_hi(xo.x) * r * gg[1], bf_lo(xo.y) * r * gg[2], bf_hi(xo.y) * r * gg[3]}; } }
        return; }
    const int l = ph >= 2 ? (ph - 2) / 7 : 0, s = ph >= 2 ? (ph - 2) % 7 : -1;
    if (s == 1) { phase_convbc(P, l); { XcdBarrier xb; xb.bar = (unsigned*)(ws + WS_BAR); xb.x = xb_xcc_id(); xb.st = (volatile LAS unsigned*)(lds + LDS_BYTES); xcd_barrier(xb); } phase_mixer(lds, P, l); return; }
    bf16_t* xn_cur = (bf16_t*)(ws + ((l & 1) ? WS_XN2 : WS_XN)); bf16_t* xn_alt = (bf16_t*)(ws + ((l & 1) ? WS_XN : WS_XN2));
#define GINIT GPh g; g.G = GDIM; g.c = BIDX; g.nseg = 1; g.nlay = 1; g.a_lay = 0; g.b_lay = 0; g.nM = MT / 256; \
    g.rss = nullptr; g.rss_next = nullptr; g.XS = xn_cur; g.XD = xn_cur; g.O = nullptr; g.DT = (float*)(ws + WS_DT); \
    g.PROJ = (const bf16_t*)(ws + WS_PROJ); g.SSQ = (const float*)(ws + WS_SSQ); g.UPB = nullptr; \
    g.A = xn_cur; g.lda = 1024; g.ldb = 1024; g.K = 1024; g.nN = 4;
    switch (s) {
    case -1: { GINIT g.A = (const bf16_t*)(ws + WS_PBF); g.Bt = (const bf16_t*)(ws + WS_WPU); g.lda = 256; g.ldb = 256; g.K = 256; g.nlay = 4; g.a_lay = (size_t)MT * 256; g.b_lay = (size_t)1024 * 256;
        g.O = (bf16_t*)(ws + WS_UP); gemm_phase<EPI_UP>(lds, g); } break;
    case 0: { GINIT g.Bt = (const bf16_t*)(ws + WS_WIN) + (size_t)l * NIN * 1024; g.nN = NIN / 256;
        g.rss = RSS + (size_t)(3 * l) * MT * 16; g.O = (bf16_t*)(ws + WS_PROJ); gemm_phase<EPI_P1>(lds, g); } break;
    case 2: { GINIT g.A = (const bf16_t*)(ws + WS_Y); g.Bt = (const bf16_t*)(ws + WS_WBR) + (size_t)l * 1024 * 2048; g.lda = 2048; g.ldb = 2048; g.K = 512; g.nseg = 4;
        g.O = (bf16_t*)(ws + WS_MRG); g.nM = 64; gemm_phase<EPI_P3>(lds, g); mini_gemm<EPI_P3>(lds, g); } break;
    case 3: { GINIT g.A = (const bf16_t*)(ws + WS_MRG); g.Bt = (const bf16_t*)(ws + WS_WOUT) + (size_t)l * 1024 * 1024;
        g.rss_next = RSS + (size_t)(3 * l + 1) * MT * 16; g.nM = 64; gemm_phase<EPI_P4>(lds, g); mini_gemm<EPI_P4>(lds, g); } break;
    case 4: { GINIT g.Bt = (const bf16_t*)(ws + WS_WGU) + (size_t)l * 5632 * 1024; g.nN = 22;
        g.rss = RSS + (size_t)(3 * l + 1) * MT * 16; g.O = (bf16_t*)(ws + WS_ACT); gemm_phase<EPI_P5>(lds, g); } break;
    case 5: { GINIT g.A = (const bf16_t*)(ws + WS_ACT); g.Bt = (const bf16_t*)(ws + WS_WDN) + (size_t)l * 1024 * DFF; g.lda = DFF; g.ldb = DFF; g.K = DFF;
        g.rss_next = RSS + (size_t)(3 * l + 2) * MT * 16; g.nM = 64; gemm_phase<EPI_P6>(lds, g); mini_gemm<EPI_P6>(lds, g); } break;
    default: { GINIT g.Bt = (const bf16_t*)(ws + WS_WPG) + (size_t)l * 1024 * 1024;
        g.rss = RSS + (size_t)(3 * l + 2) * MT * 16; g.rss_next = RSS + (size_t)(3 * l + 3) * MT * 16; g.XD = xn_alt;
        g.UPB = (const bf16_t*)(ws + WS_UP) + (size_t)l * MT * 1024; g.nM = 64; gemm_phase<EPI_P7>(lds, g); mini_gemm<EPI_P7>(lds, g); } break;
    }
#undef GINIT
}

__global__ void __launch_bounds__(NTHR, 2) hybrid_fwd(Params P) {
    extern __shared__ __attribute__((aligned(16))) uchar smem[];
    LAS uchar* lds = (LAS uchar*)smem;
    cg::grid_group grid = cg::this_grid();
    volatile LAS unsigned* st = (volatile LAS unsigned*)(lds + LDS_BYTES);
    if (threadIdx.x < 4) st[threadIdx.x] = 0u;
    __syncthreads();
    const XcdBarrier xbar = xcd_barrier_post((unsigned*)(P.ws + WS_BAR), st);
    for (int ph = P.ph_lo; ph < P.ph_hi; ++ph) {
        int nrep_ = 1;
#ifdef PROBE_REP
        { const int s_ = ph >= 2 && ph < 30 ? (ph - 2) % 7 : (ph == 0 ? 7 : (ph == 1 ? 8 : 9)); if ((PROBE_REP >> s_) & 1) nrep_ = 2; }
#endif
#pragma unroll 1
        for (int r_ = 0; r_ < nrep_; ++r_) { run_phase(lds, P, ph); __syncthreads(); }
        if (ph + 1 < P.ph_hi) {
            if (P.ph_lo < 0) grid.sync();
            xcd_barrier(xbar);
        }
    }
}

extern "C" void kernel_launch(void* const* d_in, const int* in_sizes, int n_in, void* d_out, int out_size, void* d_ws, size_t ws_size, hipStream_t stream) {
    static int grid = 0;
    if (grid == 0) {
        if (n_in != 32 || (size_t)out_size != O_END || ws_size < WS_END) { fprintf(stderr, "kernel_launch: shape mismatch n_in %d out %d (want %zu) ws %zu (want %zu)\n", n_in, out_size, (size_t)O_END, ws_size, (size_t)WS_END); grid = -1; return; }
        int dev = 0, cus = 0, per_cu = 0;
        hipGetDevice(&dev); hipDeviceGetAttribute(&cus, hipDeviceAttributeMultiprocessorCount, dev);
        if (hipFuncSetAttribute((const void*)hybrid_fwd, hipFuncAttributeMaxDynamicSharedMemorySize, LDS_BYTES + 16) != hipSuccess) { fprintf(stderr, "kernel_launch: hipFuncSetAttribute failed\n"); grid = -1; return; }
        hipOccupancyMaxActiveBlocksPerMultiprocessor(&per_cu, (const void*)hybrid_fwd, NTHR, LDS_BYTES + 16);
        if (per_cu < 1) { fprintf(stderr, "kernel_launch: occupancy query says %d blocks per CU\n", per_cu); per_cu = 1; }
        grid = cus * 1;
        fprintf(stderr, "kernel_launch: cus %d per_cu %d grid %d\n", cus, per_cu, grid);
    }
    if (grid < 0) return;
    hipMemsetAsync((char*)d_ws + WS_BAR, 0, 16384, stream);
    Params p{};
    for (int i = 0; i < 32; ++i) p.in[i] = (const float*)d_in[i];
    p.out = (float*)d_out; p.ws = (uchar*)d_ws;
#if MULTI_LAUNCH
    for (int ph = 0; ph < 31; ++ph) { p.ph_lo = ph; p.ph_hi = ph + 1; hipLaunchKernelGGL(hybrid_fwd, dim3(grid), dim3(NTHR), LDS_BYTES + 16, stream, p); }
#else
    p.ph_lo = 0; p.ph_hi = 31;
    void* args[] = {&p};
    hipError_t e = hipLaunchCooperativeKernel((const void*)hybrid_fwd, dim3(grid), dim3(NTHR), args, LDS_BYTES + 16, stream);
    if (e != hipSuccess) fprintf(stderr, "cooperative launch failed: %s (grid %d)\n", hipGetErrorString(e), grid);
#endif
}
```

```cpp
#include <hip/hip_runtime.h>
#include <hip/hip_cooperative_groups.h>
#include <cstdio>
namespace cg = cooperative_groups;

#define LAS __attribute__((address_space(3)))
typedef unsigned short bf16_t;
typedef unsigned char uchar;
typedef short bf16x8 __attribute__((ext_vector_type(8)));
typedef float f32x4 __attribute__((ext_vector_type(4)));
typedef unsigned u32x4 __attribute__((ext_vector_type(4)));
typedef unsigned u32x2 __attribute__((ext_vector_type(2)));

#ifndef MULTI_LAUNCH
#define MULTI_LAUNCH 0
#endif

constexpr int MT = 17408, MPR = 16384, DM = 1024, NPROJ = 7168, NIN = 7424, DFF = 2816;
constexpr float EPS = 1e-6f;
constexpr int NTHR = 512;
constexpr int LDS_BYTES = 143360;
constexpr int C_Z = 0, C_XBC = 1024, C_U = 2560, C_V = 3072, C_POOL = 3584, C_GA = 4096, C_GB = 5120, C_GC = 6144;
constexpr size_t al256(size_t x) { return (x + 255) & ~(size_t)255; }
constexpr size_t WS_WIN = 0;
constexpr size_t WS_WBR = WS_WIN + (size_t)4 * NIN * 1024 * 2;
constexpr size_t WS_WOUT = WS_WBR + (size_t)4 * 1024 * 2048 * 2;
constexpr size_t WS_WGU = WS_WOUT + (size_t)4 * 1024 * 1024 * 2;
constexpr size_t WS_WDN = WS_WGU + (size_t)4 * 5632 * 1024 * 2;
constexpr size_t WS_WPG = WS_WDN + (size_t)4 * 1024 * 2816 * 2;
constexpr size_t WS_WPU = WS_WPG + (size_t)4 * 1024 * 1024 * 2;
constexpr size_t WS_X = WS_WPU + (size_t)4 * 1024 * 256 * 2;
constexpr size_t WS_XN = WS_X + (size_t)MT * 1024 * 4;
constexpr size_t WS_RSS = WS_XN + (size_t)MT * 1024 * 2;
constexpr size_t WS_PROJ = al256(WS_RSS + (size_t)13 * MT * 16 * 4);
constexpr size_t WS_DT = WS_PROJ + (size_t)MT * NPROJ * 2;
constexpr size_t WS_Y = WS_DT + (size_t)MT * 16 * 4;
constexpr size_t WS_SSQ = WS_Y + (size_t)MT * 2048 * 2;
constexpr size_t WS_MRG = WS_SSQ + (size_t)MT * 16 * 4;
constexpr size_t WS_ACT = WS_MRG + (size_t)MT * 1024 * 2;
constexpr size_t WS_UP = WS_ACT + (size_t)MT * DFF * 2;
constexpr size_t WS_PBF = WS_UP + (size_t)4 * MT * 1024 * 2;
constexpr size_t WS_XN2 = WS_PBF + (size_t)4 * MT * 256 * 2;
constexpr size_t WS_BAR = WS_XN2 + (size_t)MT * 1024 * 2;
constexpr size_t WS_CBC = WS_BAR + 16384;
constexpr size_t WS_GT2 = WS_CBC + (size_t)MPR * 512 * 2;
constexpr size_t WS_END = WS_GT2 + (size_t)MT * 1024 * 2;
constexpr size_t O_Y = 0;
constexpr size_t O_CONVP = (size_t)MT * 1024;
constexpr size_t O_SSMP = O_CONVP + (size_t)4 * 8 * 3 * 1536;
constexpr size_t O_POOLP = O_SSMP + (size_t)4 * 8 * 16 * 64 * 128;
constexpr size_t O_VP = O_POOLP + (size_t)4 * 8 * 15 * 512;
constexpr size_t O_CONVS = O_VP + (size_t)4 * 8 * 128 * 512;
constexpr size_t O_SSMS = O_CONVS + (size_t)4 * 128 * 3 * 1536;
constexpr size_t O_POOLS = O_SSMS + (size_t)4 * 128 * 16 * 64 * 128;
constexpr size_t O_VS = O_POOLS + (size_t)4 * 128 * 15 * 512;
constexpr size_t O_END = O_VS + (size_t)4 * 128 * 8 * 512;

struct Params {
    const float* in[32];
    float* out;
    uchar* ws;
    int ph_lo, ph_hi;
};
enum { I_XP = 0, I_XS, I_SCONV, I_SSSM, I_SPOOL, I_PP, I_PS, I_NMIX, I_WIN, I_CONVW, I_CONVB, I_DTB, I_ALOG, I_DSKIP, I_SSDN, I_LNG, I_LNB, I_WSP, I_BSP,
       I_POOLW, I_POOLS, I_WBRA, I_WBRB, I_WBRC, I_WOUT, I_NFFN, I_WGU, I_WDN, I_NPLE, I_WPG, I_WPU, I_FN };


__device__ __forceinline__ int launder_s(int i) { asm volatile("" : "+s"(i)); return i; }
__device__ __forceinline__ int launder_v(int i) { asm volatile("" : "+v"(i)); return i; }
template <class T> __device__ __forceinline__ T* launder_p(T* p) { asm volatile("" : "+s"(p)); return p; }
__device__ __forceinline__ size_t launder_z() { size_t z = 0; asm volatile("" : "+s"(z)); return z; }
typedef const float __attribute__((address_space(1)))* gcf_t;
#define PIN(i) ((const float*)(gcf_t)(P.in[launder_s(i)]))
#define TIDX launder_v((int)threadIdx.x)
#define BIDX launder_s((int)blockIdx.x)
#define GDIM launder_s((int)gridDim.x)
__device__ __forceinline__ unsigned cvt_pk_bf16(float lo, float hi) { unsigned r; asm("v_cvt_pk_bf16_f32 %0, %1, %2" : "=v"(r) : "v"(lo), "v"(hi)); return r; }
__device__ __forceinline__ float bf_lo(unsigned w) { return __uint_as_float(w << 16); }
__device__ __forceinline__ float bf_hi(unsigned w) { return __uint_as_float(w & 0xffff0000u); }
__device__ __forceinline__ float bf1(bf16_t b) { return __uint_as_float(((unsigned)b) << 16); }
__device__ __forceinline__ float frcp(float x) { return __builtin_amdgcn_rcpf(x); }
__device__ __forceinline__ float sigmoidf_(float x) { return frcp(1.0f + __expf(-x)); }
__device__ __forceinline__ float siluf_(float x) { return x * sigmoidf_(x); }
__device__ __forceinline__ float gelu_tanh(float x) { const float u = 1.5957691216057308f * (x + 0.044715f * x * x * x); return x * sigmoidf_(u); }
__device__ __forceinline__ float softplusf_(float x) {
    const float e = __expf(-fabsf(x));
    const float l = e < 0.03f ? e * (1.0f - e * (0.5f - e * (0.33333334f - e * 0.25f))) : __logf(1.0f + e);
    return fmaxf(x, 0.f) + l;
}
__device__ __forceinline__ float shx(float v, int m) { return __shfl_xor(v, m, 64); }

__device__ __forceinline__ float rownorm(const float* rssp, int row) {
    const f32x4 a = *(const f32x4*)(rssp + (size_t)row * 16), b = *(const f32x4*)(rssp + (size_t)row * 16 + 4), c = *(const f32x4*)(rssp + (size_t)row * 16 + 8), d = *(const f32x4*)(rssp + (size_t)row * 16 + 12);
    const float s = ((a[0] + a[1]) + (a[2] + a[3])) + ((b[0] + b[1]) + (b[2] + b[3])) + ((c[0] + c[1]) + (c[2] + c[3])) + ((d[0] + d[1]) + (d[2] + d[3]));
    return rsqrtf(s * (1.0f / 1024.0f) + EPS);
}
constexpr int BM = 256, BK = 64, HALF = 128, HTB = HALF * BK * 2, NXCD = 8, WGM = 8;
__device__ __forceinline__ int lds_byte(int r, int c) { const int st = (r >> 4) * 2 + (c >> 5), rr = r & 15, cc = c & 31, ob = rr * 64 + cc * 2; return st * 1024 + (ob ^ (((ob >> 9) & 1) << 5)); }
__device__ __forceinline__ void stage_rc(int b, int& R, int& C) { const int st = b / 1024, sb = b % 1024, swz = sb ^ (((sb >> 9) & 1) << 5); R = (st >> 1) * 16 + swz / 64; C = (st & 1) * 32 + (swz % 64) / 2; }

struct Unit { int pm, pn, seg, lay; };
enum { EPI_UP = 0, EPI_P1, EPI_P3, EPI_P4, EPI_P5, EPI_P6, EPI_P7 };

struct GPh {
    const bf16_t* A; const bf16_t* Bt; int lda, ldb, K, nM, nN, nseg, nlay; size_t a_lay, b_lay;
    int G, c;
    const float* rss; float* rss_next; const bf16_t* XS; bf16_t* XD; bf16_t* O; float* DT; const bf16_t* PROJ; const float* SSQ; const bf16_t* UPB;
    __device__ __forceinline__ bool next(int i, Unit& u) const {
        const int tiles = nM * nN; const long L = (long)(i / nseg) * G + c; if (L >= (long)tiles * nlay) return false;
        u.seg = i % nseg; u.lay = (int)(L / tiles); int wgid = (int)(L % tiles);
        { const int q = tiles / NXCD, r = tiles % NXCD, xcd = wgid % NXCD, off = wgid / NXCD; wgid = (xcd < r ? xcd * (q + 1) : r * (q + 1) + (xcd - r) * q) + off; }
        const int nig = WGM * nN, gid = wgid / nig, fm = gid * WGM, gsz = (nM - fm) < WGM ? (nM - fm) : WGM;
        u.pm = fm + ((wgid % nig) % gsz); u.pn = (wgid % nig) / gsz; return true;
    }
    __device__ __forceinline__ const char* pa(const Unit& u) const { return (const char*)(A + u.lay * a_lay + (size_t)u.pm * BM * lda + (size_t)u.seg * K); }
    __device__ __forceinline__ const char* pb(const Unit& u) const { return (const char*)(Bt + u.lay * b_lay + (size_t)u.pn * BM * ldb + (size_t)u.seg * K); }
};

__device__ __forceinline__ int gate_off(const int row, const int col) { return ((((row >> 8) << 2) + (col >> 8)) << 16) + ((row & 255) << 8) + (col & 255); }
__device__ __forceinline__ bf16_t* gate_addr(const GPh& P, const int g, const int goff) {
    uchar* pb = (uchar*)P.PROJ;
    bf16_t* base = (bf16_t*)(g < 2 ? pb + ((long)WS_X - (long)WS_PROJ) + (long)g * MT * 1024 * 2 : pb + ((long)WS_GT2 - (long)WS_PROJ));
    return base + goff;
}
__device__ __forceinline__ void p3_rowscale(const GPh& P, const int row, const int seg, float& rs0, float& rs1) {
    rs0 = 1.f; rs1 = 1.f;
    if (seg < 2) { const f32x4 a0 = *(const f32x4*)(P.SSQ + (size_t)row * 16), a1 = *(const f32x4*)(P.SSQ + (size_t)row * 16 + 4), b0 = *(const f32x4*)(P.SSQ + (size_t)row * 16 + 8), b1 = *(const f32x4*)(P.SSQ + (size_t)row * 16 + 12);
        rs0 = rsqrtf((a0[0] + a0[1] + a0[2] + a0[3] + a1[0] + a1[1] + a1[2] + a1[3]) * (1.0f / 512.0f) + EPS);
        rs1 = rsqrtf((b0[0] + b0[1] + b0[2] + b0[3] + b1[0] + b1[1] + b1[2] + b1[3]) * (1.0f / 512.0f) + EPS); }
}
__device__ __forceinline__ void p3_elem(const GPh& P, f32x4& v, const int row, const int col, const int goff, const int seg, const float rs0, const float rs1) {
    if (seg == 0) { v = v * (rs0 * frcp(rs1)); }
    else if (seg == 1) { const u32x2 ga = *(const u32x2*)gate_addr(P, 0, goff), gb = *(const u32x2*)gate_addr(P, 1, goff);
        v[0] *= rs1 * bf_lo(ga.x) * frcp(bf_lo(gb.x)); v[1] *= rs1 * bf_hi(ga.x) * frcp(bf_hi(gb.x)); v[2] *= rs1 * bf_lo(ga.y) * frcp(bf_lo(gb.y)); v[3] *= rs1 * bf_hi(ga.y) * frcp(bf_hi(gb.y)); }
    else if (seg == 2) { const u32x2 ga = *(const u32x2*)gate_addr(P, 1, goff), gb = *(const u32x2*)gate_addr(P, 2, goff);
        v[0] *= bf_lo(ga.x) * frcp(bf_lo(gb.x)); v[1] *= bf_hi(ga.x) * frcp(bf_hi(gb.x)); v[2] *= bf_lo(ga.y) * frcp(bf_lo(gb.y)); v[3] *= bf_hi(ga.y) * frcp(bf_hi(gb.y)); }
    else { const u32x2 gc = *(const u32x2*)gate_addr(P, 2, goff);
        u32x2 o; o.x = cvt_pk_bf16(v[0] * bf_lo(gc.x), v[1] * bf_hi(gc.x)); o.y = cvt_pk_bf16(v[2] * bf_lo(gc.y), v[3] * bf_hi(gc.y)); *(u32x2*)(P.O + (size_t)row * 1024 + col) = o; }
}
template <int EPI>
__device__ __forceinline__ void epi_row(const GPh& P, f32x4 (&a)[2][2], const int row, const int col0, const int pn, const int wc, const int fq, const int seg, const int lay, const int bjs = HALF, const int pidx = -1) {
    if constexpr (EPI == EPI_UP) {
        bf16_t* O = P.O + (size_t)lay * MT * 1024;
#pragma unroll
        for (int bj = 0; bj < 2; ++bj)
#pragma unroll
            for (int n = 0; n < 2; ++n) { const int col = col0 + bj * bjs + n * 16; const f32x4 v = a[bj][n];
                u32x2 o; o.x = cvt_pk_bf16(v[0], v[1]); o.y = cvt_pk_bf16(v[2], v[3]); *(u32x2*)(O + gate_off(row, col)) = o; }
    } else if constexpr (EPI == EPI_P1) {
        const float r = rownorm(P.rss, row);
#pragma unroll
        for (int bj = 0; bj < 2; ++bj)
#pragma unroll
            for (int n = 0; n < 2; ++n) { const int col = col0 + bj * bjs + n * 16; f32x4 v = a[bj][n] * r;
                if (pn == 28) { if (col - NPROJ < 16) *(f32x4*)(P.DT + (size_t)row * 16 + (col - NPROJ)) = v; }
                else {
                    if (pn >= 10 && pn < 14) { v[0] = gelu_tanh(v[0]); v[1] = gelu_tanh(v[1]); v[2] = gelu_tanh(v[2]); v[3] = gelu_tanh(v[3]); }
                    u32x2 o;
                    if (pn >= 16) { v[0] = sigmoidf_(v[0]); v[1] = sigmoidf_(v[1]); v[2] = sigmoidf_(v[2]); v[3] = sigmoidf_(v[3]);
                        o.x = cvt_pk_bf16(v[0], v[1]); o.y = cvt_pk_bf16(v[2], v[3]); const int gcol = col - C_GA; *(u32x2*)gate_addr(P, gcol >> 10, gate_off(row, gcol & 1023)) = o; }
                    else { o.x = cvt_pk_bf16(v[0], v[1]); o.y = cvt_pk_bf16(v[2], v[3]); *(u32x2*)(P.O + (size_t)row * NPROJ + col) = o; } } }
    } else if constexpr (EPI == EPI_P3) {
        float rs0, rs1; p3_rowscale(P, row, seg, rs0, rs1);
#pragma unroll
        for (int bj = 0; bj < 2; ++bj)
#pragma unroll
            for (int n = 0; n < 2; ++n) p3_elem(P, a[bj][n], row, col0 + bj * bjs + n * 16, gate_off(row, col0 + bj * bjs + n * 16), seg, rs0, rs1);
    } else if constexpr (EPI == EPI_P5) {
        const float r = rownorm(P.rss, row);
#pragma unroll
        for (int bj = 0; bj < 2; ++bj) { const f32x4 g = a[bj][0] * r, uu = a[bj][1] * r;
            const int ocol = 16 * (8 * pn + 4 * bj + wc) + 4 * fq;
            u32x2 o; o.x = cvt_pk_bf16(siluf_(g[0]) * uu[0], siluf_(g[1]) * uu[1]); o.y = cvt_pk_bf16(siluf_(g[2]) * uu[2], siluf_(g[3]) * uu[3]);
            *(u32x2*)(P.O + (size_t)row * DFF + ocol) = o; }
    } else {
        float ss = 0.f; float r7 = 0.f;
        if constexpr (EPI == EPI_P7) r7 = rownorm(P.rss, row);
#pragma unroll
        for (int bj = 0; bj < 2; ++bj)
#pragma unroll
            for (int n = 0; n < 2; ++n) { const int col = col0 + bj * bjs + n * 16; const f32x4 v = a[bj][n];
                const u32x2 xo = *(const u32x2*)(P.XS + (size_t)row * 1024 + col);
                f32x4 xv = (f32x4){bf_lo(xo.x), bf_hi(xo.x), bf_lo(xo.y), bf_hi(xo.y)};
                if constexpr (EPI == EPI_P7) { const u32x2 up = *(const u32x2*)(P.UPB + gate_off(row, col));
                    xv[0] += bf_lo(up.x) * sigmoidf_(v[0] * r7); xv[1] += bf_hi(up.x) * sigmoidf_(v[1] * r7); xv[2] += bf_lo(up.y) * sigmoidf_(v[2] * r7); xv[3] += bf_hi(up.y) * sigmoidf_(v[3] * r7); }
                else xv += v;
                u32x2 o; o.x = cvt_pk_bf16(xv[0], xv[1]); o.y = cvt_pk_bf16(xv[2], xv[3]); *(u32x2*)(P.XD + (size_t)row * 1024 + col) = o;
                const float q0 = bf_lo(o.x), q1 = bf_hi(o.x), q2 = bf_lo(o.y), q3 = bf_hi(o.y);
                ss += q0 * q0 + q1 * q1 + q2 * q2 + q3 * q3; }
        ss += shx(ss, 16); ss += shx(ss, 32);
        if (fq == 0) P.rss_next[(size_t)row * 16 + (pidx >= 0 ? pidx : pn * 4 + wc)] = ss;
    }
}
template <int EPI>
__device__ __forceinline__ void epilogue(const GPh& P, f32x4 (&acc)[2][2][4][2], const Unit& u, int, int, int, int) {
    const int tid_ = TIDX, wid_ = tid_ >> 6, wr = wid_ >> 2, wc = wid_ & 3, fr = tid_ & 15, fq = (tid_ >> 4) & 3;
    const int row0 = u.pm * BM + wr * 64 + fr, col0 = u.pn * BM + wc * 32 + 4 * fq;
#pragma unroll
    for (int ai = 0; ai < 2; ++ai)
#pragma unroll
        for (int m = 0; m < 4; ++m) {
            const int row = row0 + ai * HALF + m * 16;
            if constexpr (EPI == EPI_P3) {
                float rs0, rs1; p3_rowscale(P, row, u.seg, rs0, rs1);
                const int grow = (((u.pm << 2) + u.pn) << 16) + ((row & 255) << 8) + (col0 & 255);
#pragma unroll
                for (int bj = 0; bj < 2; ++bj)
#pragma unroll
                    for (int n = 0; n < 2; ++n) p3_elem(P, acc[ai][bj][m][n], row, col0 + bj * HALF + n * 16, grow + bj * HALF + n * 16, u.seg, rs0, rs1);
            } else {
                f32x4 a[2][2] = {{acc[ai][0][m][0], acc[ai][0][m][1]}, {acc[ai][1][m][0], acc[ai][1][m][1]}};
                epi_row<EPI>(P, a, row, col0, u.pn, wc, fq, u.seg, u.lay);
            }
        }
}

template <int EPI>
__device__ __forceinline__ void mini_gemm(LAS uchar* lds, const GPh& P) {
    const int tid = TIDX, wid = tid >> 6, lane = tid & 63, kh = wid >> 2, wc = wid & 3, fr = lane & 15, fq = lane >> 4;
    const int nseg = P.nseg, K = P.K, Kh = K >> 1;
    for (int su = P.c; su < 256; su += P.G) {
        const int rg = su >> 4, cgp = su & 15; const int row = MPR + rg * 64 + wc * 16 + fr;
        const bf16_t* Ap = P.A + (size_t)row * P.lda + fq * 8;
        const bf16_t* Bp = P.Bt + (size_t)(cgp * 64 + fr) * P.ldb + fq * 8;
        f32x4 a[2][2];
#pragma unroll
        for (int bj = 0; bj < 2; ++bj)
#pragma unroll
            for (int n = 0; n < 2; ++n) a[bj][n] = (f32x4){0.f, 0.f, 0.f, 0.f};
        __syncthreads();
        for (int seg = 0; seg < nseg; ++seg) {
            const int kbeg = seg * K + kh * Kh, kend = kbeg + Kh;
            bf16x8 af[4], bfr[4][2][2];
#define MG_LOAD(s, kk) do { af[s] = *(const bf16x8*)(Ap + (kk)); \
                _Pragma("unroll") for (int bj = 0; bj < 2; ++bj) _Pragma("unroll") for (int n = 0; n < 2; ++n) bfr[s][bj][n] = *(const bf16x8*)(Bp + (size_t)(bj * 32 + n * 16) * P.ldb + (kk)); } while (0)
#define MG_MMA(s) do { _Pragma("unroll") for (int bj = 0; bj < 2; ++bj) _Pragma("unroll") for (int n = 0; n < 2; ++n) \
                a[bj][n] = __builtin_amdgcn_mfma_f32_16x16x32_bf16(bfr[s][bj][n], af[s], a[bj][n], 0, 0, 0); } while (0)
#pragma unroll
            for (int s = 0; s < 4; ++s) MG_LOAD(s, kbeg + 32 * s);
#pragma unroll 1
            for (int k0 = kbeg; k0 < kend; k0 += 128) {
#pragma unroll
                for (int s = 0; s < 4; ++s) { MG_MMA(s); if (k0 + 128 + 32 * s < kend) MG_LOAD(s, k0 + 128 + 32 * s); }
            }
#undef MG_LOAD
#undef MG_MMA
            if (EPI == EPI_P3 && seg < 3) epi_row<EPI>(P, a, row, cgp * 64 + 4 * fq, 0, wc, fq, seg, 0, 32, cgp);
        }
        LAS f32x4* xch = (LAS f32x4*)lds;
        if (kh == 1) {
#pragma unroll
            for (int bj = 0; bj < 2; ++bj)
#pragma unroll
                for (int n = 0; n < 2; ++n) xch[((wc * 4 + bj * 2 + n) * 64) + lane] = a[bj][n];
        }
        __syncthreads();
        if (kh == 0) {
#pragma unroll
            for (int bj = 0; bj < 2; ++bj)
#pragma unroll
                for (int n = 0; n < 2; ++n) a[bj][n] += xch[((wc * 4 + bj * 2 + n) * 64) + lane];
            epi_row<EPI>(P, a, row, cgp * 64 + 4 * fq, 0, wc, fq, nseg - 1, 0, 32, cgp);
        }
    }
}

template <int EPI>
__device__ __forceinline__ void gemm_phase(LAS uchar* lds, const GPh& P) {
    const int tid = TIDX, wid = __builtin_amdgcn_readfirstlane(tid >> 6), lane = tid & 63, wr = wid >> 2, wc = wid & 3, fr = lane & 15, fq = lane >> 4;
    const int K = P.K, nt = K / BK;
    unsigned voffA[2], voffB[2];
#pragma unroll
    for (int i = 0; i < 2; ++i) { int R, C; stage_rc(tid * 16 + i * 8192, R, C); voffA[i] = (unsigned)(R * P.lda + C) * 2u; voffB[i] = (unsigned)(R * P.ldb + C) * 2u; }
    const size_t kstep = (size_t)(BK * 2);
    const size_t hstepA = (size_t)HALF * P.lda * 2, hstepB = (size_t)HALF * P.ldb * 2;
    const unsigned ldsw = (unsigned)wid * 1024u;
    const int aoff = lds_byte(wr * 64 + fr, fq * 8), boff = lds_byte(wc * 32 + fr, fq * 8);
#define PG8_SA(b, h) (((b) * 2 + (h)) * HTB)
#define PG8_SB(b, h) ((4 + (b) * 2 + (h)) * HTB)
#define PG8_STAGE(bufoff, gbase, voff) do { _Pragma("unroll") for (int _i = 0; _i < 2; ++_i) \
        __builtin_amdgcn_global_load_lds((const unsigned*)((const char*)(gbase) + (voff)[_i]), (LAS unsigned*)(lds + (bufoff) + ldsw + _i * 8192), 16, 0, 0); } while (0)
#define PG8_LDA(dst, b, h) do { _Pragma("unroll") for (int m = 0; m < 4; ++m) _Pragma("unroll") for (int k = 0; k < 2; ++k) dst[m][k] = *(const LAS bf16x8*)(lds + PG8_SA(b, h) + aoff + m * 2048 + k * 1024); } while (0)
#define PG8_LDB(dst, b, h) do { _Pragma("unroll") for (int n = 0; n < 2; ++n) _Pragma("unroll") for (int k = 0; k < 2; ++k) dst[n][k] = *(const LAS bf16x8*)(lds + PG8_SB(b, h) + boff + n * 2048 + k * 1024); } while (0)
#define PG8_MMA(ai, bj, At, Bt) do { __builtin_amdgcn_s_setprio(1); _Pragma("unroll") for (int m = 0; m < 4; ++m) _Pragma("unroll") for (int n = 0; n < 2; ++n) _Pragma("unroll") for (int k = 0; k < 2; ++k) \
        acc[ai][bj][m][n] = __builtin_amdgcn_mfma_f32_16x16x32_bf16(Bt[n][k], At[m][k], acc[ai][bj][m][n], 0, 0, 0); __builtin_amdgcn_s_setprio(0); } while (0)
#define PG8_WAIT_V(n) asm volatile("s_waitcnt vmcnt(" #n ")" ::: "memory")
#define PG8_WAIT_L(n) asm volatile("s_waitcnt lgkmcnt(" #n ")" ::: "memory")
#define PG8_BAR __builtin_amdgcn_s_barrier()
#define PG8_SCHED __builtin_amdgcn_sched_barrier(0)
    Unit cur, nxt; int ui = 0;
    if (!P.next(0, cur)) return;
    f32x4 acc[2][2][4][2];
#pragma unroll
    for (int a = 0; a < 2; ++a)
#pragma unroll
        for (int b = 0; b < 2; ++b)
#pragma unroll
            for (int m = 0; m < 4; ++m)
#pragma unroll
                for (int n = 0; n < 2; ++n) acc[a][b][m][n] = (f32x4){0.f, 0.f, 0.f, 0.f};
    bf16x8 At[4][2], B0[2][2], B1[2][2];
    const char* cA = P.pa(cur); const char* cB = P.pb(cur);
    PG8_STAGE(PG8_SB(0, 0), cB, voffB); PG8_STAGE(PG8_SA(0, 0), cA, voffA); PG8_STAGE(PG8_SB(0, 1), cB + hstepB, voffB); PG8_STAGE(PG8_SA(0, 1), cA + hstepA, voffA);
    if (wr == 1) PG8_BAR;
    PG8_WAIT_V(4); PG8_BAR;
    PG8_STAGE(PG8_SB(1, 0), cB + kstep, voffB); PG8_STAGE(PG8_SA(1, 0), cA + kstep, voffA); PG8_STAGE(PG8_SB(1, 1), cB + hstepB + kstep, voffB);
    PG8_WAIT_V(6); PG8_BAR;
    for (;;) {
        const bool has_next = P.next(ui + 1, nxt);
        const char* nA = has_next ? P.pa(nxt) : cA; const char* nB = has_next ? P.pb(nxt) : cB;
        for (int t = 0; t < nt; t += 2) {
            const bool last = (t == nt - 2);
            const char* a1 = cA + (size_t)(t + 1) * kstep;
            const char* a2 = last ? nA : cA + (size_t)(t + 2) * kstep; const char* b2 = last ? nB : cB + (size_t)(t + 2) * kstep;
            const char* a3 = a2 + kstep; const char* b3 = b2 + kstep;
            PG8_LDB(B0, 0, 0); PG8_SCHED; PG8_LDA(At, 0, 0); PG8_STAGE(PG8_SA(1, 1), a1 + hstepA, voffA);
            PG8_WAIT_L(8); PG8_BAR; PG8_WAIT_L(0); PG8_MMA(0, 0, At, B0); PG8_BAR; PG8_SCHED;
            PG8_LDB(B1, 0, 1); PG8_STAGE(PG8_SB(0, 0), b2, voffB);
            PG8_BAR; PG8_WAIT_L(0); PG8_MMA(0, 1, At, B1); PG8_BAR;
            PG8_LDA(At, 0, 1); PG8_STAGE(PG8_SA(0, 0), a2, voffA);
            PG8_BAR; PG8_WAIT_L(0); PG8_MMA(1, 0, At, B0); PG8_BAR; PG8_SCHED;
            PG8_STAGE(PG8_SB(0, 1), b2 + hstepB, voffB);
            PG8_WAIT_V(6); PG8_BAR; PG8_MMA(1, 1, At, B1); PG8_BAR;
            PG8_LDB(B0, 1, 0); PG8_SCHED; PG8_LDA(At, 1, 0); PG8_STAGE(PG8_SA(0, 1), a2 + hstepA, voffA);
            PG8_WAIT_L(8); PG8_BAR; PG8_WAIT_L(0); PG8_MMA(0, 0, At, B0); PG8_BAR; PG8_SCHED;
            PG8_LDB(B1, 1, 1); PG8_STAGE(PG8_SB(1, 0), b3, voffB);
            PG8_BAR; PG8_WAIT_L(0); PG8_MMA(0, 1, At, B1); PG8_BAR;
            PG8_LDA(At, 1, 1); PG8_STAGE(PG8_SA(1, 0), a3, voffA);
            PG8_BAR; PG8_WAIT_L(0); PG8_MMA(1, 0, At, B0); PG8_BAR; PG8_SCHED;
            PG8_STAGE(PG8_SB(1, 1), b3 + hstepB, voffB);
            PG8_WAIT_V(6); PG8_BAR; PG8_MMA(1, 1, At, B1); PG8_BAR;
        }
        epilogue<EPI>(P, acc, cur, wr, wc, fr, fq);
        if (!has_next) break;
        if (EPI != EPI_P3 || cur.seg == 3) {
#pragma unroll
            for (int a = 0; a < 2; ++a)
#pragma unroll
                for (int b = 0; b < 2; ++b)
#pragma unroll
                    for (int m = 0; m < 4; ++m)
#pragma unroll
                        for (int n = 0; n < 2; ++n) acc[a][b][m][n] = (f32x4){0.f, 0.f, 0.f, 0.f};
        }
        cur = nxt; cA = nA; cB = nB; ++ui;
    }
    PG8_WAIT_V(0);
    if (wr == 0) PG8_BAR;
    PG8_BAR;
#undef PG8_SA
#undef PG8_SB
#undef PG8_STAGE
#undef PG8_LDA
#undef PG8_LDB
#undef PG8_MMA
#undef PG8_WAIT_V
#undef PG8_WAIT_L
#undef PG8_BAR
#undef PG8_SCHED
}

template <int NT, int KS>
__device__ __forceinline__ void wmma(const LAS uchar* A, const LAS uchar* B, int pitch, f32x4 (&acc)[NT], int fr, int fq) {
#pragma unroll 1
    for (int ks = 0; ks < KS; ++ks) {
        const bf16x8 a = *(const LAS bf16x8*)(A + fr * pitch + (ks * 32 + fq * 8) * 2);
#pragma unroll
        for (int ni = 0; ni < NT; ++ni) {
            const bf16x8 b = *(const LAS bf16x8*)(B + (ni * 16 + fr) * pitch + (ks * 32 + fq * 8) * 2);
            acc[ni] = __builtin_amdgcn_mfma_f32_16x16x32_bf16(b, a, acc[ni], 0, 0, 0);
        }
    }
}
constexpr int PB = 272;

__device__ __forceinline__ int map_row(int n, int map) {
    if (map == 1) return n < 2560 ? n : (n < 2576 ? 7168 + (n - 2560) : n - 16);
    if (map == 2) { const int up = n >= DFF, nn = up ? n - DFF : n; return 32 * (nn >> 4) + 16 * up + (nn & 15); }
    return n;
}
__device__ __forceinline__ void tr_tile(LAS float* T, const float* src, int N, bf16_t* dst, int ldd, int dcol0, int k0, int n0, int map, const float* gk = nullptr) {
    const int tid = TIDX;
    __syncthreads();
    f32x4 v[8];
    { const int c4 = (tid & 63) * 4, n = n0 + c4;
#pragma unroll
        for (int ps = 0; ps < 8; ++ps) { const int r = ps * 8 + (tid >> 6); v[ps] = (f32x4){0.f, 0.f, 0.f, 0.f}; if (n < N) v[ps] = *(const f32x4*)(src + (size_t)(k0 + r) * N + n); }
#pragma unroll
        for (int ps = 0; ps < 8; ++ps) { const int r = ps * 8 + (tid >> 6); f32x4 w = v[ps];
            if (gk) w = w * gk[k0 + r];
            T[r * 257 + c4 + 0] = w[0]; T[r * 257 + c4 + 1] = w[1]; T[r * 257 + c4 + 2] = w[2]; T[r * 257 + c4 + 3] = w[3]; } }
    __syncthreads();
    { const int n = tid >> 1, kh = (tid & 1) * 32;
        if (n0 + n < N) { bf16_t* drow = dst + (size_t)map_row(n0 + n, map) * ldd + dcol0 + k0 + kh;
#pragma unroll
            for (int q = 0; q < 4; ++q) { float f[8];
#pragma unroll
                for (int jj = 0; jj < 8; ++jj) f[jj] = T[(kh + q * 8 + jj) * 257 + n];
                u32x4 o; o.x = cvt_pk_bf16(f[0], f[1]); o.y = cvt_pk_bf16(f[2], f[3]); o.z = cvt_pk_bf16(f[4], f[5]); o.w = cvt_pk_bf16(f[6], f[7]);
                *(u32x4*)(drow + q * 8) = o; } } }
}

__device__ __forceinline__ void phase_pre(LAS uchar* lds, const Params& P) {
    const int tid = TIDX, G = GDIM, bid = BIDX;
    uchar* ws = (P.ws + launder_z());
    LAS float* T = (LAS float*)lds;
    constexpr int T_IN = 16 * 29, T_BRA = 16 * 4, T_BRB = 8 * 4, T_OUT = 16 * 4, T_GU = 16 * 22, T_DN = 44 * 4, T_PG = 16 * 4, T_PU = 4 * 4;
    constexpr int T_L = T_IN + T_BRA + T_BRB + T_OUT + T_GU + T_DN + T_PG + T_PU;
    for (int job = bid; job < 4 * T_L; job += G) {
        const int l = job / T_L; int j = job % T_L;
        if (j < T_IN) { tr_tile(T, PIN(I_WIN) + (size_t)l * 1024 * 7184, 7184, (bf16_t*)(ws + WS_WIN) + (size_t)l * NIN * 1024, 1024, 0, (j / 29) * 64, (j % 29) * 256, 1, PIN(I_NMIX) + (size_t)l * 1024); continue; } j -= T_IN;
        if (j < T_BRA) { tr_tile(T, PIN(I_WBRA) + (size_t)l * 1024 * 1024, 1024, (bf16_t*)(ws + WS_WBR) + (size_t)l * 1024 * 2048, 2048, 0, (j / 4) * 64, (j % 4) * 256, 0); continue; } j -= T_BRA;
        if (j < T_BRB) { tr_tile(T, PIN(I_WBRB) + (size_t)l * 512 * 1024, 1024, (bf16_t*)(ws + WS_WBR) + (size_t)l * 1024 * 2048, 2048, 1024, (j / 4) * 64, (j % 4) * 256, 0); continue; } j -= T_BRB;
        if (j < T_OUT) { tr_tile(T, PIN(I_WOUT) + (size_t)l * 1024 * 1024, 1024, (bf16_t*)(ws + WS_WOUT) + (size_t)l * 1024 * 1024, 1024, 0, (j / 4) * 64, (j % 4) * 256, 0); continue; } j -= T_OUT;
        if (j < T_GU) { tr_tile(T, PIN(I_WGU) + (size_t)l * 1024 * 5632, 5632, (bf16_t*)(ws + WS_WGU) + (size_t)l * 5632 * 1024, 1024, 0, (j / 22) * 64, (j % 22) * 256, 2, PIN(I_NFFN) + (size_t)l * 1024); continue; } j -= T_GU;
        if (j < T_DN) { tr_tile(T, PIN(I_WDN) + (size_t)l * DFF * 1024, 1024, (bf16_t*)(ws + WS_WDN) + (size_t)l * 1024 * DFF, DFF, 0, (j / 4) * 64, (j % 4) * 256, 0); continue; } j -= T_DN;
        if (j < T_PG) { tr_tile(T, PIN(I_WPG) + (size_t)l * 1024 * 1024, 1024, (bf16_t*)(ws + WS_WPG) + (size_t)l * 1024 * 1024, 1024, 0, (j / 4) * 64, (j % 4) * 256, 0, PIN(I_NPLE) + (size_t)l * 1024); continue; } j -= T_PG;
        tr_tile(T, PIN(I_WPU) + (size_t)l * 256 * 1024, 1024, (bf16_t*)(ws + WS_WPU) + (size_t)l * 1024 * 256, 256, 0, (j / 4) * 64, (j % 4) * 256, 0);
    }
    {
        LAS float* PW = (LAS float*)lds;
        LAS float* WC = (LAS float*)(lds + 128 * 129 * 4);
        for (int job = bid; job < 4 * 4 * 16; job += G) {
            const int l = job >> 6, g = (job >> 4) & 3, n0 = (job & 15) * 64;
            __syncthreads();
            for (int e = tid; e < 128 * 128; e += NTHR) { const int c = e >> 7, d = e & 127; PW[c * 129 + d] = PIN(I_POOLW)[((size_t)(l * 4 + g) * 128 + c) * 128 + d] * PIN(I_POOLS)[l * 512 + g * 128 + d]; }
            for (int e = tid; e < 128 * 64; e += NTHR) { const int d = e >> 6, n = e & 63; WC[d * 64 + n] = PIN(I_WBRC)[((size_t)l * 512 + g * 128 + d) * 1024 + n0 + n]; }
            __syncthreads();
            const int c = tid & 127, nq = (tid >> 7) * 16;
            float a[16];
#pragma unroll
            for (int i = 0; i < 16; ++i) a[i] = 0.f;
            for (int d = 0; d < 128; ++d) { const float pw = PW[c * 129 + d];
#pragma unroll
                for (int i = 0; i < 16; ++i) a[i] += pw * WC[d * 64 + nq + i]; }
            bf16_t* dst = (bf16_t*)(ws + WS_WBR) + (size_t)l * 1024 * 2048;
#pragma unroll
            for (int i = 0; i < 16; ++i) dst[(size_t)(n0 + nq + i) * 2048 + 1536 + g * 128 + c] = (bf16_t)(cvt_pk_bf16(a[i], 0.f) & 0xffffu);
        }
    }
    {
        const int lane = tid & 63, wv = tid >> 6;
        bf16_t* XB = (bf16_t*)(ws + WS_XN); float* RSS = (float*)(ws + WS_RSS);
        for (int row = bid * 8 + wv; row < MT; row += G * 8) {
            const float* src = row < MPR ? PIN(I_XP) + (size_t)row * 1024 : PIN(I_XS) + (size_t)(row - MPR) * 1024;
            float ss = 0.f;
#pragma unroll
            for (int i = 0; i < 4; ++i) { const int col = i * 256 + lane * 4; const f32x4 v = *(const f32x4*)(src + col);
                u32x2 o; o.x = cvt_pk_bf16(v[0], v[1]); o.y = cvt_pk_bf16(v[2], v[3]); *(u32x2*)(XB + (size_t)row * 1024 + col) = o;
                const float q0 = bf_lo(o.x), q1 = bf_hi(o.x), q2 = bf_lo(o.y), q3 = bf_hi(o.y); ss += q0 * q0 + q1 * q1 + q2 * q2 + q3 * q3; }
#pragma unroll
            for (int s = 1; s < 64; s <<= 1) ss += shx(ss, s);
            if (lane < 16) RSS[(size_t)row * 16 + lane] = lane == 0 ? ss : 0.f;
        }
    }
    {
        bf16_t* PBF = (bf16_t*)(ws + WS_PBF);
        const size_t n4 = (size_t)4 * MT * 256 / 4;
        for (size_t i = (size_t)bid * NTHR + tid; i < n4; i += (size_t)G * NTHR) {
            const size_t e = i * 4; const int l = (int)(e / ((size_t)MT * 256)); const size_t rem = e % ((size_t)MT * 256); const int row = (int)(rem >> 8), col = (int)(rem & 255);
            const float* src = row < MPR ? PIN(I_PP) + ((size_t)l * MPR + row) * 256 + col : PIN(I_PS) + ((size_t)l * 1024 + (row - MPR)) * 256 + col;
            const f32x4 v = *(const f32x4*)src; u32x2 o; o.x = cvt_pk_bf16(v[0], v[1]); o.y = cvt_pk_bf16(v[2], v[3]); *(u32x2*)(PBF + e) = o;
        }
    }
}

constexpr int L_CS = 0, L_BS = 34816, L_BDT = 69632, L_XT = 104448, L_SB = 121856, L_SC = 139264;
__device__ __forceinline__ int xbc_chan(int cc, int h, int g) { return cc < 64 ? h * 64 + cc : (cc < 192 ? 1024 + g * 128 + (cc - 64) : 1280 + g * 128 + (cc - 192)); }

__device__ __forceinline__ void ssd_prompt(LAS uchar* lds, const Params& P, int l, int b, int h) {
    const int tid = TIDX, lane = tid & 63, w = tid >> 6, fr = lane & 15, fq = lane >> 4, g = h >> 3;
    const bf16_t* PROJ = (const bf16_t*)((P.ws + launder_z()) + WS_PROJ); const float* DT = (const float*)((P.ws + launder_z()) + WS_DT);
    bf16_t* Y = (bf16_t*)((P.ws + launder_z()) + WS_Y); float* SSQ = (float*)((P.ws + launder_z()) + WS_SSQ);
    const float a_h = -__expf(PIN(I_ALOG)[l * 16 + h]), dtb = PIN(I_DTB)[l * 16 + h], Dh = PIN(I_DSKIP)[l * 16 + h];
    f32x4 S[4];
#pragma unroll
    for (int i = 0; i < 4; ++i) S[i] = (f32x4){0.f, 0.f, 0.f, 0.f};
    const int wu = __builtin_amdgcn_readfirstlane(w);
    const bf16_t* xsrc = PROJ + (size_t)(b * 2048) * NPROJ + C_XBC;
    const float* cwp = PIN(I_CONVW) + (size_t)l * 4 * 1536; const float* cbp = PIN(I_CONVB) + (size_t)l * 1536;
    const bf16_t* CBC = (const bf16_t*)((P.ws + launder_z()) + WS_CBC);
    float dN0 = 0.f, dN1 = 0.f;
#define SSD_LD1(cc, i, dst) do { if ((i) == 0) { const int ch_ = h * 64 + wu * 8; \
            _Pragma("unroll") for (int k = 0; k < 5; ++k) { const int pos = (cc) * 128 + 2 * lane - 3 + k; \
                dst[k] = (u32x4){0u, 0u, 0u, 0u}; if (pos >= 0) dst[k] = *(const u32x4*)(xsrc + (size_t)pos * NPROJ + ch_); } } \
        else { const int cgx_ = 8 * (i) + wu; const int col_ = cgx_ < 24 ? g * 128 + (cgx_ - 8) * 8 : 256 + g * 128 + (cgx_ - 24) * 8; \
            const bf16_t* cs_ = CBC + ((size_t)b * 2048 + (cc) * 128 + 2 * lane) * 512 + col_; dst[0] = *(const u32x4*)cs_; dst[1] = *(const u32x4*)(cs_ + 512); } } while (0)
#define SSD_DTLOAD(cc) do { if (w == 0) { dN0 = DT[(size_t)(b * 2048 + (cc) * 128 + 2 * lane) * 16 + h]; dN1 = DT[(size_t)(b * 2048 + (cc) * 128 + 2 * lane + 1) * 16 + h]; } } while (0)
#define SSD_SCAL(sb) do { if (w == 0) { LAS float* acs_ = (LAS float*)(lds + L_SC + (sb) * 2048); \
            const float d0 = softplusf_(dN0 + dtb), d1 = softplusf_(dN1 + dtb); const float a0 = d0 * a_h, a1 = d1 * a_h; float inc = a0 + a1; \
            _Pragma("unroll") for (int s = 1; s < 64; s <<= 1) { const float o = __shfl_up(inc, s, 64); if (lane >= s) inc += o; } \
            const float tot = __shfl(inc, 63, 64); const float c1 = inc, c0 = inc - a1; \
            acs_[2 * lane] = c0; acs_[2 * lane + 1] = c1; acs_[128 + 2 * lane] = d0; acs_[128 + 2 * lane + 1] = d1; \
            acs_[256 + 2 * lane] = __expf(c0); acs_[256 + 2 * lane + 1] = __expf(c1); acs_[384 + 2 * lane] = __expf(tot - c0) * d0; acs_[384 + 2 * lane + 1] = __expf(tot - c1) * d1; } } while (0)
#define SSD_CONV(sb, cc) do { const int lr = 2 * launder_v(lane); const LAS float* decdt_ = (const LAS float*)(lds + L_SC + (sb) * 2048) + 384; \
        u32x4 xr[2][5]; SSD_LD1(cc, 0, xr[0]); \
        _Pragma("unroll") for (int i = 0; i < 5; ++i) { const int cgx = 8 * i + wu; const int ch_ = xbc_chan(cgx * 8, h, g); \
            if (i < 4) SSD_LD1(cc, i + 1, xr[(i + 1) & 1]); \
            float xf[5][8]; \
            _Pragma("unroll") for (int k = 0; k < (i == 0 ? 5 : 2); ++k) { const u32x4 v = xr[i & 1][k]; \
                xf[k][0] = bf_lo(v.x); xf[k][1] = bf_hi(v.x); xf[k][2] = bf_lo(v.y); xf[k][3] = bf_hi(v.y); xf[k][4] = bf_lo(v.z); xf[k][5] = bf_hi(v.z); xf[k][6] = bf_lo(v.w); xf[k][7] = bf_hi(v.w); } \
            float o0[8], o1[8]; \
            if (i == 0) { _Pragma("unroll") for (int j = 0; j < 8; ++j) { \
                const float w0 = cwp[ch_ + j], w1 = cwp[1536 + ch_ + j], w2 = cwp[3072 + ch_ + j], w3 = cwp[4608 + ch_ + j]; \
                const float bb = cbp[ch_ + j]; \
                o0[j] = siluf_(bb + w0 * xf[0][j] + w1 * xf[1][j] + w2 * xf[2][j] + w3 * xf[3][j]); \
                o1[j] = siluf_(bb + w0 * xf[1][j] + w1 * xf[2][j] + w2 * xf[3][j] + w3 * xf[4][j]); } } \
            else { _Pragma("unroll") for (int j = 0; j < 8; ++j) { o0[j] = xf[0][j]; o1[j] = xf[1][j]; } } \
            if (cgx < 8) { _Pragma("unroll") for (int j = 0; j < 8; ++j) *(LAS unsigned*)(lds + L_XT + (cgx * 8 + j) * PB + lr * 2) = cvt_pk_bf16(o0[j], o1[j]); } \
            else if (cgx < 24) { const int n0 = (cgx - 8) * 8; const float s0 = decdt_[lr], s1 = decdt_[lr + 1]; \
                u32x4 q; q.x = cvt_pk_bf16(o0[0], o0[1]); q.y = cvt_pk_bf16(o0[2], o0[3]); q.z = cvt_pk_bf16(o0[4], o0[5]); q.w = cvt_pk_bf16(o0[6], o0[7]); *(LAS u32x4*)(lds + L_BS + lr * PB + n0 * 2) = q; \
                q.x = cvt_pk_bf16(o1[0], o1[1]); q.y = cvt_pk_bf16(o1[2], o1[3]); q.z = cvt_pk_bf16(o1[4], o1[5]); q.w = cvt_pk_bf16(o1[6], o1[7]); *(LAS u32x4*)(lds + L_BS + (lr + 1) * PB + n0 * 2) = q; \
                _Pragma("unroll") for (int j = 0; j < 8; ++j) *(LAS unsigned*)(lds + L_BDT + (n0 + j) * PB + lr * 2) = cvt_pk_bf16(o0[j] * s0, o1[j] * s1); } \
            else { const int n0 = (cgx - 24) * 8; \
                u32x4 q; q.x = cvt_pk_bf16(o0[0], o0[1]); q.y = cvt_pk_bf16(o0[2], o0[3]); q.z = cvt_pk_bf16(o0[4], o0[5]); q.w = cvt_pk_bf16(o0[6], o0[7]); *(LAS u32x4*)(lds + L_CS + lr * PB + n0 * 2) = q; \
                q.x = cvt_pk_bf16(o1[0], o1[1]); q.y = cvt_pk_bf16(o1[2], o1[3]); q.z = cvt_pk_bf16(o1[4], o1[5]); q.w = cvt_pk_bf16(o1[6], o1[7]); *(LAS u32x4*)(lds + L_CS + (lr + 1) * PB + n0 * 2) = q; } } } while (0)

    __syncthreads();
    SSD_DTLOAD(0);
    SSD_SCAL(0);
    __syncthreads();
    SSD_CONV(0, 0);
#pragma unroll 1
    for (int c = 0; c < 16; ++c) {
        const int grow0 = b * 2048 + c * 128, sb = c & 1;
        LAS float* acs = (LAS float*)(lds + L_SC + sb * 2048); LAS float* dtv = acs + 128; LAS float* eacs = acs + 256;
        __syncthreads();
        if (c < 15) SSD_DTLOAD(c + 1);
        const int lrow = 16 * w + fr, row = grow0 + lrow;
        if (c < 15) SSD_SCAL(sb ^ 1);
        {
            f32x4 cb[8];
#pragma unroll
            for (int i = 0; i < 8; ++i) cb[i] = (f32x4){0.f, 0.f, 0.f, 0.f};
            wmma<8, 4>(lds + L_CS + w * 16 * PB, lds + L_BS, PB, cb, fr, fq);
            __syncthreads();
            const float al = acs[lrow];
#pragma unroll
            for (int ni = 0; ni < 8; ++ni) { const int s0 = ni * 16 + 4 * fq; float mv[4];
#pragma unroll
                for (int e = 0; e < 4; ++e) { const int s = s0 + e; const float dd = fminf(al - acs[s], 0.f); mv[e] = (s <= lrow) ? cb[ni][e] * __expf(dd) * dtv[s] : 0.f; }
                u32x2 o; o.x = cvt_pk_bf16(mv[0], mv[1]); o.y = cvt_pk_bf16(mv[2], mv[3]); *(LAS u32x2*)(lds + L_BS + lrow * PB + s0 * 2) = o;
                if (ni & 1) __builtin_amdgcn_sched_barrier(0); }
        }
        u32x2 zz[4];
#pragma unroll
        for (int ni = 0; ni < 4; ++ni) zz[ni] = *(const u32x2*)(PROJ + (size_t)row * NPROJ + C_Z + h * 64 + ni * 16 + 4 * fq);
        __syncthreads();
        {
            f32x4 y[4];
#pragma unroll
            for (int i = 0; i < 4; ++i) y[i] = (f32x4){0.f, 0.f, 0.f, 0.f};
            if (c > 0) { wmma<4, 4>(lds + L_CS + w * 16 * PB, lds + L_SB, PB, y, fr, fq); const float ea = eacs[lrow];
#pragma unroll
                for (int i = 0; i < 4; ++i) y[i] = y[i] * ea; }
            wmma<4, 4>(lds + L_BS + w * 16 * PB, lds + L_XT, PB, y, fr, fq);
            float ssq = 0.f;
#pragma unroll
            for (int ni = 0; ni < 4; ++ni) { const int p0 = ni * 16 + 4 * fq;
                const f32x4 ng = *(const f32x4*)(PIN(I_SSDN) + (size_t)l * 1024 + h * 64 + p0);
                float zf[4] = {bf_lo(zz[ni].x), bf_hi(zz[ni].x), bf_lo(zz[ni].y), bf_hi(zz[ni].y)}; float ov[4];
#pragma unroll
                for (int e = 0; e < 4; ++e) { const float xs = bf1(*(const LAS bf16_t*)(lds + L_XT + (p0 + e) * PB + lrow * 2)); const float v = (y[ni][e] + Dh * xs) * siluf_(zf[e]); ssq += v * v; ov[e] = v * ng[e]; }
                u32x2 o; o.x = cvt_pk_bf16(ov[0], ov[1]); o.y = cvt_pk_bf16(ov[2], ov[3]); *(u32x2*)(Y + (size_t)row * 2048 + h * 64 + p0) = o; }
            ssq += shx(ssq, 16); ssq += shx(ssq, 32);
            if (fq == 0) SSQ[(size_t)row * 16 + h] = ssq;
        }
        __syncthreads();
        {
            const float et = eacs[127];
#pragma unroll
            for (int i = 0; i < 4; ++i) S[i] = S[i] * et;
            wmma<4, 4>(lds + L_XT + (w >> 1) * 16 * PB, lds + L_BDT + (w & 1) * 64 * PB, PB, S, fr, fq);
            const int p = (w >> 1) * 16 + fr;
#pragma unroll
            for (int ni = 0; ni < 4; ++ni) { const int n0 = (w & 1) * 64 + ni * 16 + 4 * fq; u32x2 o; o.x = cvt_pk_bf16(S[ni][0], S[ni][1]); o.y = cvt_pk_bf16(S[ni][2], S[ni][3]); *(LAS u32x2*)(lds + L_SB + p * PB + n0 * 2) = o; }
        }
        __syncthreads();
        if (c < 15) SSD_CONV(sb ^ 1, c + 1);
    }
#undef SSD_LD1
#undef SSD_DTLOAD
#undef SSD_SCAL
#undef SSD_CONV
    {
        float* dst = (P.out + launder_z()) + O_SSMP + ((size_t)((l * 8 + b) * 16 + h) * 64) * 128; const int p = (w >> 1) * 16 + fr;
#pragma unroll
        for (int ni = 0; ni < 4; ++ni) { const int n0 = (w & 1) * 64 + ni * 16 + 4 * fq; *(f32x4*)(dst + (size_t)p * 128 + n0) = S[ni]; }
    }
}

__device__ __forceinline__ void ssd_sample(LAS uchar* lds, const Params& P, int l, int b, int hp) {
    const int tid = TIDX, half = tid >> 8, t8 = tid & 255, h = hp * 2 + half, g = h >> 3;
    const bf16_t* PROJ = (const bf16_t*)((P.ws + launder_z()) + WS_PROJ); const float* DT = (const float*)((P.ws + launder_z()) + WS_DT);
    bf16_t* Y = (bf16_t*)((P.ws + launder_z()) + WS_Y); float* SSQ = (float*)((P.ws + launder_z()) + WS_SSQ);
    LAS float* xs = (LAS float*)(lds + half * 16384); LAS float* Bv = xs + 512; LAS float* Cv = xs + 1536; LAS float* sdt = xs + 2560; LAS float* sdec = xs + 2568; LAS float* yv = xs + 2576;
    const int row0 = MPR + b * 8;
    const int l16 = t8 & 15, pr = t8 >> 4;
    const float* hin = PIN(I_SSSM) + ((size_t)((l * 128 + b) * 16 + h) * 64) * 128;
    f32x4 hs[4][2];
#pragma unroll
    for (int pi = 0; pi < 4; ++pi)
#pragma unroll
        for (int it = 0; it < 2; ++it) hs[pi][it] = *(const f32x4*)(hin + (size_t)(pi * 16 + pr) * 128 + it * 64 + l16 * 4);
    __syncthreads();
    for (int cc = t8; cc < 320; cc += 256) {
        const int ch = xbc_chan(cc, h, g);
        float xv[11];
#pragma unroll
        for (int k = 0; k < 3; ++k) xv[k] = PIN(I_SCONV)[((size_t)(l * 128 + b) * 3 + k) * 1536 + ch];
#pragma unroll
        for (int t = 0; t < 8; ++t) xv[3 + t] = bf1(PROJ[(size_t)(row0 + t) * NPROJ + C_XBC + ch]);
        const float w0 = PIN(I_CONVW)[(size_t)(l * 4 + 0) * 1536 + ch], w1 = PIN(I_CONVW)[(size_t)(l * 4 + 1) * 1536 + ch], w2 = PIN(I_CONVW)[(size_t)(l * 4 + 2) * 1536 + ch], w3 = PIN(I_CONVW)[(size_t)(l * 4 + 3) * 1536 + ch];
        const float cb = PIN(I_CONVB)[(size_t)l * 1536 + ch];
#pragma unroll
        for (int t = 0; t < 8; ++t) { const float o = siluf_(cb + w0 * xv[t] + w1 * xv[t + 1] + w2 * xv[t + 2] + w3 * xv[t + 3]);
            if (cc < 64) xs[t * 64 + cc]= o; else if (cc < 192) Bv[t * 128 + cc - 64] = o; else Cv[t * 128 + cc - 192] = o; }
    }
    if (t8 < 8) { const float d = softplusf_(DT[(size_t)(row0 + t8) * 16 + h] + PIN(I_DTB)[l * 16 + h]); sdt[t8] = d; sdec[t8] = __expf(-d * __expf(PIN(I_ALOG)[l * 16 + h])); }
    __syncthreads();
    float* hout = (P.out + launder_z()) + O_SSMS + ((size_t)((l * 128 + b) * 16 + h) * 64) * 128;
#pragma unroll 1
    for (int t = 0; t < 8; ++t) {
        const float dec = sdec[t], dtt = sdt[t];
        const f32x4 B0 = *(const LAS f32x4*)(Bv + t * 128 + l16 * 4), B1 = *(const LAS f32x4*)(Bv + t * 128 + 64 + l16 * 4);
        const f32x4 C0 = *(const LAS f32x4*)(Cv + t * 128 + l16 * 4), C1 = *(const LAS f32x4*)(Cv + t * 128 + 64 + l16 * 4);
#pragma unroll
        for (int pi = 0; pi < 4; ++pi) { const float xd = xs[t * 64 + pi * 16 + pr] * dtt;
            hs[pi][0] = hs[pi][0] * dec + B0 * xd; hs[pi][1] = hs[pi][1] * dec + B1 * xd;
            const f32x4 q = hs[pi][0] * C0 + hs[pi][1] * C1; float yp = q[0] + q[1] + q[2] + q[3];
            yp += shx(yp, 1); yp += shx(yp, 2); yp += shx(yp, 4); yp += shx(yp, 8);
            if (l16 == 0) yv[t * 64 + pi * 16 + pr] = yp; }
    }
#pragma unroll
    for (int pi = 0; pi < 4; ++pi)
#pragma unroll
        for (int it = 0; it < 2; ++it) *(f32x4*)(hout + (size_t)(pi * 16 + pr) * 128 + it * 64 + l16 * 4) = hs[pi][it];
    __syncthreads();
    {
        const int t = t8 >> 5, p0 = (t8 & 31) * 2, row = row0 + t; const float Dh = PIN(I_DSKIP)[l * 16 + h];
        const unsigned zz = *(const unsigned*)(PROJ + (size_t)row * NPROJ + C_Z + h * 64 + p0);
        const float v0 = (yv[t * 64 + p0] + Dh * xs[t * 64 + p0]) * siluf_(bf_lo(zz)), v1 = (yv[t * 64 + p0 + 1] + Dh * xs[t * 64 + p0 + 1]) * siluf_(bf_hi(zz));
        float ssq = v0 * v0 + v1 * v1;
        ssq += shx(ssq, 1); ssq += shx(ssq, 2); ssq += shx(ssq, 4); ssq += shx(ssq, 8); ssq += shx(ssq, 16);
        *(unsigned*)(Y + (size_t)row * 2048 + h * 64 + p0) = cvt_pk_bf16(v0 * PIN(I_SSDN)[(size_t)l * 1024 + h * 64 + p0], v1 * PIN(I_SSDN)[(size_t)l * 1024 + h * 64 + p0 + 1]);
        if ((t8 & 31) == 0) SSQ[(size_t)row * 16 + h] = ssq;
    }
}

__device__ __forceinline__ void sgu_prompt(LAS uchar* lds, const Params& P, int l, int b, int c, int g) {
    const int tid = TIDX, lane = tid & 63, w = tid >> 6, fr = lane & 15, fq = lane >> 4;
    const bf16_t* PROJ = (const bf16_t*)((P.ws + launder_z()) + WS_PROJ); bf16_t* Y = (bf16_t*)((P.ws + launder_z()) + WS_Y);
    LAS float* smu = (LAS float*)(lds + 69632); LAS float* srs = smu + 128;
    const int grow0 = b * 2048 + c * 128;
    __syncthreads();
    {
        const int r = tid >> 2, q = tid & 3; const bf16_t* src = PROJ + (size_t)(grow0 + r) * NPROJ + C_V + q * 128;
        float s = 0.f, s2 = 0.f;
#pragma unroll
        for (int i = 0; i < 16; ++i) { const u32x4 v = *(const u32x4*)(src + i * 8);
            const float f[8] = {bf_lo(v.x), bf_hi(v.x), bf_lo(v.y), bf_hi(v.y), bf_lo(v.z), bf_hi(v.z), bf_lo(v.w), bf_hi(v.w)};
#pragma unroll
            for (int j = 0; j < 8; ++j) { s += f[j]; s2 += f[j] * f[j]; } }
        s += shx(s, 1); s += shx(s, 2); s2 += shx(s2, 1); s2 += shx(s2, 2);
        const float mu = s * (1.0f / 512.0f), var = fmaxf(s2 * (1.0f / 512.0f) - mu * mu, 0.f);
        if (q == 0) { smu[r] = mu; srs[r] = rsqrtf(var + EPS); }
        const float* wsrc = PIN(I_WSP) + ((size_t)(l * 4 + g) * 128 + r) * 128 + q * 32;
#pragma unroll
        for (int i = 0; i < 4; ++i) { const f32x4 a = *(const f32x4*)(wsrc + i * 8), bb = *(const f32x4*)(wsrc + i * 8 + 4); const int s0 = q * 32 + i * 8;
            u32x4 o; o.x = cvt_pk_bf16(s0 + 0 <= r ? a[0] : 0.f, s0 + 1 <= r ? a[1] : 0.f); o.y = cvt_pk_bf16(s0 + 2 <= r ? a[2] : 0.f, s0 + 3 <= r ? a[3] : 0.f);
            o.z = cvt_pk_bf16(s0 + 4 <= r ? bb[0] : 0.f, s0 + 5 <= r ? bb[1] : 0.f); o.w = cvt_pk_bf16(s0 + 6 <= r ? bb[2] : 0.f, s0 + 7 <= r ? bb[3] : 0.f);
            *(LAS u32x4*)(lds + r * PB + s0 * 2) = o; }
    }
    __syncthreads();
    {
        const int r = tid >> 2, q = tid & 3; const bf16_t* src = PROJ + (size_t)(grow0 + r) * NPROJ + C_V + g * 128 + q * 32;
        const float mu = smu[r], rs = srs[r];
        const float* lg = PIN(I_LNG) + (size_t)l * 512 + g * 128 + q * 32; const float* lb = PIN(I_LNB) + (size_t)l * 512 + g * 128 + q * 32;
        float* vout = (P.out + launder_z()) + O_VP + ((size_t)(l * 8 + b) * 128 + r) * 512 + g * 128 + q * 32;
#pragma unroll
        for (int i = 0; i < 4; ++i) { const u32x4 v = *(const u32x4*)(src + i * 8);
            const float f[8] = {bf_lo(v.x), bf_hi(v.x), bf_lo(v.y), bf_hi(v.y), bf_lo(v.z), bf_hi(v.z), bf_lo(v.w), bf_hi(v.w)}; float vn[8];
#pragma unroll
            for (int j = 0; j < 8; ++j) { vn[j] = (f[j] - mu) * rs * lg[i * 8 + j] + lb[i * 8 + j];
                *(LAS bf16_t*)(lds + 34816 + (q * 32 + i * 8 + j) * PB + r * 2) = (bf16_t)(cvt_pk_bf16(vn[j], 0.f) & 0xffffu); }
            if (c == 15) { *(f32x4*)(vout + i * 8) = (f32x4){vn[0], vn[1], vn[2], vn[3]}; *(f32x4*)(vout + i * 8 + 4) = (f32x4){vn[4], vn[5], vn[6], vn[7]}; } }
    }
    __syncthreads();
    {
        f32x4 acc[8];
#pragma unroll
        for (int i = 0; i < 8; ++i) acc[i] = (f32x4){0.f, 0.f, 0.f, 0.f};
        wmma<8, 4>(lds + w * 16 * PB, lds + 34816, PB, acc, fr, fq);
        const int t = 16 * w + fr, row = grow0 + t; const float bs = PIN(I_BSP)[(size_t)(l * 4 + g) * 128 + t];
#pragma unroll
        for (int ni = 0; ni < 8; ++ni) { const int d0 = ni * 16 + 4 * fq; const u32x2 uu = *(const u32x2*)(PROJ + (size_t)row * NPROJ + C_U + g * 128 + d0);
            u32x2 o; o.x = cvt_pk_bf16(bf_lo(uu.x) * (acc[ni][0] + bs), bf_hi(uu.x) * (acc[ni][1] + bs)); o.y = cvt_pk_bf16(bf_lo(uu.y) * (acc[ni][2] + bs), bf_hi(uu.y) * (acc[ni][3] + bs));
            *(u32x2*)(Y + (size_t)row * 2048 + 1024 + g * 128 + d0) = o; }
    }
}

__device__ __forceinline__ void sgu_sample(LAS uchar* lds, const Params& P, int l, int b) {
    const int tid = TIDX, lane = tid & 63, w = tid >> 6, ch = tid, g = ch >> 7;
    const bf16_t* PROJ = (const bf16_t*)((P.ws + launder_z()) + WS_PROJ); bf16_t* Y = (bf16_t*)((P.ws + launder_z()) + WS_Y);
    LAS float* red = (LAS float*)lds;
    const int row0 = MPR + b * 8;
    float v[8], u[8];
#pragma unroll
    for (int s = 0; s < 8; ++s) { v[s] = bf1(PROJ[(size_t)(row0 + s) * NPROJ + C_V + ch]); u[s] = bf1(PROJ[(size_t)(row0 + s) * NPROJ + C_U + ch]); }
    __syncthreads();
#pragma unroll
    for (int s = 0; s < 8; ++s) { float a = v[s], a2 = v[s] * v[s];
#pragma unroll
        for (int m = 1; m < 64; m <<= 1) { a += shx(a, m); a2 += shx(a2, m); }
        if (lane == 0) { red[w * 16 + s] = a; red[w * 16 + 8 + s] = a2; } }
    __syncthreads();
    const float lg = PIN(I_LNG)[(size_t)l * 512 + ch], lb = PIN(I_LNB)[(size_t)l * 512 + ch];
    float vn[8];
#pragma unroll
    for (int s = 0; s < 8; ++s) { float a = 0.f, a2 = 0.f;
#pragma unroll
        for (int ww = 0; ww < 8; ++ww) { a += red[ww * 16 + s]; a2 += red[ww * 16 + 8 + s]; }
        const float mu = a * (1.0f / 512.0f), var = fmaxf(a2 * (1.0f / 512.0f) - mu * mu, 0.f);
        vn[s] = (v[s] - mu) * rsqrtf(var + EPS) * lg + lb;
        (P.out + launder_z())[O_VS + ((size_t)(l * 128 + b) * 8 + s) * 512 + ch] = vn[s]; }
    const float* W = PIN(I_WSP) + (size_t)(l * 4 + g) * 128 * 128; const float* bsp = PIN(I_BSP) + (size_t)(l * 4 + g) * 128;
#pragma unroll
    for (int t = 0; t < 8; ++t) { float o = bsp[t];
#pragma unroll
        for (int s = 0; s <= t; ++s) o += W[t * 128 + s] * vn[s];
        Y[(size_t)(row0 + t) * 2048 + 1024 + ch] = (bf16_t)(cvt_pk_bf16(u[t] * o, 0.f) & 0xffffu); }
}

__device__ __forceinline__ void pool_prompt(const Params& P, int tile) {
    const int tid = TIDX, cgp = tid & 63, rsg = tid >> 6, ch0 = cgp * 8, wdw = 2 << (cgp >> 4);
    const bf16_t* PROJ = (const bf16_t*)((P.ws + launder_z()) + WS_PROJ); bf16_t* Y = (bf16_t*)((P.ws + launder_z()) + WS_Y);
    const int b = tile >> 4, pos0 = (tile & 15) * 128 + rsg * 16; const size_t rbase = (size_t)b * 2048;
    float S[8];
#pragma unroll
    for (int j = 0; j < 8; ++j) S[j] = 0.f;
    for (int k = 1; k < wdw; ++k) { const int pos = pos0 - k; if (pos >= 0) { const u32x4 v = *(const u32x4*)(PROJ + (rbase + pos) * NPROJ + C_POOL + ch0);
        S[0] += bf_lo(v.x); S[1] += bf_hi(v.x); S[2] += bf_lo(v.y); S[3] += bf_hi(v.y); S[4] += bf_lo(v.z); S[5] += bf_hi(v.z); S[6] += bf_lo(v.w); S[7] += bf_hi(v.w); } }
#pragma unroll 1
    for (int t = 0; t < 16; ++t) { const int pos = pos0 + t;
        const u32x4 v = *(const u32x4*)(PROJ + (rbase + pos) * NPROJ + C_POOL + ch0);
        const float x[8] = {bf_lo(v.x), bf_hi(v.x), bf_lo(v.y), bf_hi(v.y), bf_lo(v.z), bf_hi(v.z), bf_lo(v.w), bf_hi(v.w)};
        const float ic = 1.0f / (float)min(pos + 1, wdw); float d[8];
#pragma unroll
        for (int j = 0; j < 8; ++j) { S[j] += x[j]; d[j] = S[j] * ic - x[j]; }
        u32x4 o; o.x = cvt_pk_bf16(d[0], d[1]); o.y = cvt_pk_bf16(d[2], d[3]); o.z = cvt_pk_bf16(d[4], d[5]); o.w = cvt_pk_bf16(d[6], d[7]);
        *(u32x4*)(Y + (rbase + pos) * 2048 + 1536 + ch0) = o;
        const int po = pos - wdw + 1;
        if (po >= 0) { const u32x4 q = *(const u32x4*)(PROJ + (rbase + po) * NPROJ + C_POOL + ch0);
            S[0] -= bf_lo(q.x); S[1] -= bf_hi(q.x); S[2] -= bf_lo(q.y); S[3] -= bf_hi(q.y); S[4] -= bf_lo(q.z); S[5] -= bf_hi(q.z); S[6] -= bf_lo(q.w); S[7] -= bf_hi(q.w); } }
}
__device__ __forceinline__ void pool_sample(const Params& P, int l, int si) {
    const int tid = TIDX, cgp = tid & 63, ch0 = cgp * 8, wdw = 2 << (cgp >> 4), b = si * 8 + (tid >> 6);
    const bf16_t* PROJ = (const bf16_t*)((P.ws + launder_z()) + WS_PROJ); bf16_t* Y = (bf16_t*)((P.ws + launder_z()) + WS_Y);
    const float* buf = PIN(I_SPOOL) + (size_t)(l * 128 + b) * 15 * 512 + ch0;
    const size_t rbase = (size_t)MPR + b * 8;
    float S[8];
#pragma unroll
    for (int j = 0; j < 8; ++j) S[j] = 0.f;
    for (int k = 1; k < wdw; ++k) { const f32x4 a = *(const f32x4*)(buf + (size_t)(15 - k) * 512), c = *(const f32x4*)(buf + (size_t)(15 - k) * 512 + 4);
        S[0] += a[0]; S[1] += a[1]; S[2] += a[2]; S[3] += a[3]; S[4] += c[0]; S[5] += c[1]; S[6] += c[2]; S[7] += c[3]; }
    const float ic = 1.0f / (float)wdw;
#pragma unroll 1
    for (int t = 0; t < 8; ++t) {
        const u32x4 v = *(const u32x4*)(PROJ + (rbase + t) * NPROJ + C_POOL + ch0);
        const float x[8] = {bf_lo(v.x), bf_hi(v.x), bf_lo(v.y), bf_hi(v.y), bf_lo(v.z), bf_hi(v.z), bf_lo(v.w), bf_hi(v.w)}; float d[8];
#pragma unroll
        for (int j = 0; j < 8; ++j) { S[j] += x[j]; d[j] = S[j] * ic - x[j]; }
        u32x4 o; o.x = cvt_pk_bf16(d[0], d[1]); o.y = cvt_pk_bf16(d[2], d[3]); o.z = cvt_pk_bf16(d[4], d[5]); o.w = cvt_pk_bf16(d[6], d[7]);
        *(u32x4*)(Y + (rbase + t) * 2048 + 1536 + ch0) = o;
        const int po = t - wdw + 1;
        if (po >= 0) { const u32x4 q = *(const u32x4*)(PROJ + (rbase + po) * NPROJ + C_POOL + ch0);
            S[0] -= bf_lo(q.x); S[1] -= bf_hi(q.x); S[2] -= bf_lo(q.y); S[3] -= bf_hi(q.y); S[4] -= bf_lo(q.z); S[5] -= bf_hi(q.z); S[6] -= bf_lo(q.w); S[7] -= bf_hi(q.w); }
        else { const f32x4 a = *(const f32x4*)(buf + (size_t)(15 + po) * 512), c = *(const f32x4*)(buf + (size_t)(15 + po) * 512 + 4);
            S[0] -= a[0]; S[1] -= a[1]; S[2] -= a[2]; S[3] -= a[3]; S[4] -= c[0]; S[5] -= c[1]; S[6] -= c[2]; S[7] -= c[3]; } }
}
constexpr int NC_CP = 8 * 3 * 1536, NC_CS = 128 * 3 * 1536, NC_PP = 8 * 15 * 512, NC_PS = 128 * 15 * 512, NC_ALL = NC_CP + NC_CS + NC_PP + NC_PS;
__device__ __forceinline__ void state_copy(const Params& P, int l, int item) {
    const bf16_t* PROJ = (const bf16_t*)((P.ws + launder_z()) + WS_PROJ);
    for (int j = 0; j < 16; ++j) { int e = item * 8192 + j * NTHR + TIDX; if (e >= NC_ALL) return;
        if (e < NC_CP) { const int ch = e % 1536, k = (e / 1536) % 3, b = e / 4608; (P.out + launder_z())[O_CONVP + (size_t)l * NC_CP + e] = bf1(PROJ[(size_t)(b * 2048 + 2045 + k) * NPROJ + C_XBC + ch]); continue; } e -= NC_CP;
        if (e < NC_CS) { const int ch = e % 1536, k = (e / 1536) % 3, b = e / 4608; (P.out + launder_z())[O_CONVS + (size_t)l * NC_CS + e] = bf1(PROJ[(size_t)(MPR + b * 8 + 5 + k) * NPROJ + C_XBC + ch]); continue; } e -= NC_CS;
        if (e < NC_PP) { const int ch = e % 512, k = (e / 512) % 15, b = e / 7680; (P.out + launder_z())[O_POOLP + (size_t)l * NC_PP + e] = bf1(PROJ[(size_t)(b * 2048 + 2033 + k) * NPROJ + C_POOL + ch]); continue; } e -= NC_PP;
        { const int ch = e % 512, k = (e / 512) % 15, b = e / 7680;
          (P.out + launder_z())[O_POOLS + (size_t)l * NC_PS + e] = k < 7 ? PIN(I_SPOOL)[((size_t)(l * 128 + b) * 15 + 8 + k) * 512 + ch] : bf1(PROJ[(size_t)(MPR + b * 8 + (k - 7)) * NPROJ + C_POOL + ch]); }
    }
}

__device__ __forceinline__ void phase_convbc(const Params& P, int l) {
    const int tid = TIDX, lane = tid & 63, w = __builtin_amdgcn_readfirstlane(tid >> 6);
    const bf16_t* PROJ = (const bf16_t*)((P.ws + launder_z()) + WS_PROJ); bf16_t* CBC = (bf16_t*)((P.ws + launder_z()) + WS_CBC);
    const float* cwp = PIN(I_CONVW) + (size_t)l * 4 * 1536; const float* cbp = PIN(I_CONVB) + (size_t)l * 1536;
    for (int it = BIDX; it < 256; it += GDIM) {
        const int tile = it >> 1, half = it & 1, b = tile >> 4, c = tile & 15;
        const bf16_t* xsrc = PROJ + (size_t)(b * 2048) * NPROJ + C_XBC + 1024 + half * 256;
#pragma unroll 1
        for (int i = 0; i < 4; ++i) {
            const int cg = i * 8 + w, ch = 1024 + half * 256 + cg * 8;
            float xf[5][8];
#pragma unroll
            for (int k = 0; k < 5; ++k) { const int pos = c * 128 + 2 * lane - 3 + k; u32x4 v = (u32x4){0u, 0u, 0u, 0u}; if (pos >= 0) v = *(const u32x4*)(xsrc + (size_t)pos * NPROJ + cg * 8);
                xf[k][0] = bf_lo(v.x); xf[k][1] = bf_hi(v.x); xf[k][2] = bf_lo(v.y); xf[k][3] = bf_hi(v.y); xf[k][4] = bf_lo(v.z); xf[k][5] = bf_hi(v.z); xf[k][6] = bf_lo(v.w); xf[k][7] = bf_hi(v.w); }
            float o0[8], o1[8];
#pragma unroll
            for (int j = 0; j < 8; ++j) { const float w0 = cwp[ch + j], w1 = cwp[1536 + ch + j], w2 = cwp[3072 + ch + j], w3 = cwp[4608 + ch + j], bb = cbp[ch + j];
                o0[j] = siluf_(bb + w0 * xf[0][j] + w1 * xf[1][j] + w2 * xf[2][j] + w3 * xf[3][j]);
                o1[j] = siluf_(bb + w0 * xf[1][j] + w1 * xf[2][j] + w2 * xf[3][j] + w3 * xf[4][j]); }
            const size_t row = (size_t)b * 2048 + c * 128 + 2 * lane;
            u32x4 q; q.x = cvt_pk_bf16(o0[0], o0[1]); q.y = cvt_pk_bf16(o0[2], o0[3]); q.z = cvt_pk_bf16(o0[4], o0[5]); q.w = cvt_pk_bf16(o0[6], o0[7]); *(u32x4*)(CBC + row * 512 + half * 256 + cg * 8) = q;
            q.x = cvt_pk_bf16(o1[0], o1[1]); q.y = cvt_pk_bf16(o1[2], o1[3]); q.z = cvt_pk_bf16(o1[4], o1[5]); q.w = cvt_pk_bf16(o1[6], o1[7]); *(u32x4*)(CBC + (row + 1) * 512 + half * 256 + cg * 8) = q;
        }
    }
}

__device__ __forceinline__ void phase_mixer(LAS uchar* lds, const Params& P, int l) {
    const int G = GDIM, bid = BIDX;
    constexpr int N_B = 1024, N_C = 512, N_D = 128, N_E = 128, N_E2 = 16, N_F = (NC_ALL + 8191) / 8192;
    constexpr int N_REST = N_B + N_C + N_D + N_E + N_E2 + N_F;
    if (G > 128) { if (bid < 128) ssd_prompt(lds, P, l, bid >> 4, bid & 15); }
    else { for (int i = bid; i < 128; i += G) ssd_prompt(lds, P, l, i >> 4, i & 15); }
    unsigned* ctr = (unsigned*)((P.ws + launder_z()) + WS_BAR) + 3584 + 64 * l;
    volatile LAS unsigned* bc = (volatile LAS unsigned*)(lds + LDS_BYTES) + 2;
    for (;;) {
        __syncthreads();
        if (TIDX == 0) bc[0] = __hip_atomic_fetch_add(ctr, 1u, __ATOMIC_RELAXED, __HIP_MEMORY_SCOPE_AGENT);
        __syncthreads();
        int j = (int)bc[0];
        if (j >= N_REST) break;
        if (j < N_C) { sgu_prompt(lds, P, l, j >> 6, (j >> 2) & 15, j & 3); continue; } j -= N_C;
        if (j < N_B) { ssd_sample(lds, P, l, j >> 3, j & 7); continue; } j -= N_B;
        if (j < N_D) { sgu_sample(lds, P, l, j); continue; } j -= N_D;
        if (j < N_E) { pool_prompt(P, j); continue; } j -= N_E;
        if (j < N_E2) { pool_sample(P, l, j); continue; } j -= N_E2;
        state_copy(P, l, j);
    }
}


#define XB_TMO      128
#define XB_XCNT(j)  (256  + 64 * (j))
#define XB_XSUB(j)  (1280 + 64 * (j))
#define XB_XGEN(j)  (2304 + 64 * (j))
#define XB_TOP      3328
#define XB_TOPGEN   3392
#define XCD_BAR_WORDS 3456
#define XB_SPIN_CAP (1u << 20)
__device__ __forceinline__ unsigned xb_ld(unsigned* p)              { return __hip_atomic_load(p, __ATOMIC_RELAXED, __HIP_MEMORY_SCOPE_AGENT); }
__device__ __forceinline__ unsigned xb_add(unsigned* p, unsigned v) { return __hip_atomic_fetch_add(p, v, __ATOMIC_RELAXED, __HIP_MEMORY_SCOPE_AGENT); }
__device__ __forceinline__ unsigned xb_xcc_id() { return (unsigned)__builtin_amdgcn_s_getreg((3 << 11) | 20) & 0xFu; }
#define XB_SPIN(cond, bar) do { unsigned _sp = 0; while (cond) { __builtin_amdgcn_s_sleep(1); \
    if ((++_sp & 255u) == 0u) { if (xb_ld(&(bar)[XB_TMO])) break; if (_sp > XB_SPIN_CAP) { atomicAdd(&(bar)[XB_TMO], 1u); break; } } } } while (0)
struct XcdBarrier { unsigned* bar; unsigned x; volatile LAS unsigned* st; };
__device__ __forceinline__ XcdBarrier xcd_barrier_post(unsigned* bar, volatile LAS unsigned* st) {
    XcdBarrier b; b.bar = bar; b.x = xb_xcc_id(); b.st = st;
    if (threadIdx.x == 0) (void)xb_add(&bar[XB_XCNT(b.x)], 1u);
    return b;
}
__device__ __forceinline__ void xcd_barrier_complete(unsigned* bar, unsigned x, unsigned& nloc, unsigned& nx) {
    const unsigned G = gridDim.x * gridDim.y * gridDim.z;
    unsigned sum, cnt, mine, sp = 0u;
    for (;;) {
        sum = 0u; cnt = 0u; mine = 0u;
#pragma unroll
        for (unsigned j = 0; j < 16; ++j) { const unsigned c = xb_ld(&bar[XB_XCNT(j)]); sum += c; cnt += (c > 0u) ? 1u : 0u; mine = (j == x) ? c : mine; }
        if (sum == G) break;
        __builtin_amdgcn_s_sleep(1);
        if ((++sp & 255u) == 0u) { if (xb_ld(&bar[XB_TMO])) break; if (sp > XB_SPIN_CAP) { atomicAdd(&bar[XB_TMO], 1u); break; } }
    }
    nloc = mine > 0u ? mine : 1u; nx = cnt > 0u ? cnt : 1u;
}
__device__ __forceinline__ void xcd_barrier(const XcdBarrier& b) {
    asm volatile("s_waitcnt vmcnt(0)" ::: "memory");
    __syncthreads();
    if (threadIdx.x == 0) {
        unsigned* bar = b.bar + launder_z(); const unsigned bx = (unsigned)launder_s((int)b.x);
        __builtin_amdgcn_s_waitcnt(0);
        unsigned nloc = b.st[0], nx = b.st[1];
        if (nloc == 0u) { xcd_barrier_complete(bar, bx, nloc, nx); b.st[0] = nloc; b.st[1] = nx; }
        const unsigned old = xb_add(&bar[XB_XSUB(bx)], 1u);
        const unsigned gen = old / nloc;
        if (old + 1u == (gen + 1u) * nloc) {
            __builtin_amdgcn_fence(__ATOMIC_RELEASE, "agent");
            asm volatile("s_waitcnt vmcnt(0)" ::: "memory");
            const unsigned og = xb_add(&bar[XB_TOP], 1u);
            const unsigned tg = og / nx;
            if (og + 1u == (tg + 1u) * nx) xb_add(&bar[XB_TOPGEN], 1u);
            else XB_SPIN(xb_ld(&bar[XB_TOPGEN]) == tg, bar);
            __builtin_amdgcn_fence(__ATOMIC_ACQUIRE, "agent");
            xb_add(&bar[XB_XGEN(bx)], 1u);
            asm volatile("s_waitcnt vmcnt(0)" ::: "memory");
        } else {
            XB_SPIN(xb_ld(&bar[XB_XGEN(bx)]) == gen, bar);
            __builtin_amdgcn_fence(__ATOMIC_ACQUIRE, "agent");
            asm volatile("s_waitcnt vmcnt(0)" ::: "memory");
        }
    }
    __syncthreads();
}

__device__ __forceinline__ void run_phase(LAS uchar* lds, const Params& P, int ph) {
    uchar* ws = (P.ws + launder_z());
    float* RSS = (float*)(ws + WS_RSS);
    if (ph == 0) { phase_pre(lds, P); return; }
    if (ph == 30) {
        const int tid = TIDX, lane = tid & 63, wv = tid >> 6; const bf16_t* XB = (const bf16_t*)(ws + WS_XN); const float* fg = PIN(I_FN);
        for (int row = BIDX * 8 + wv; row < MT; row += GDIM * 8) { const float r = rownorm(RSS + (size_t)12 * MT * 16, row);
#pragma unroll
            for (int i = 0; i < 4; ++i) { const int col = i * 256 + lane * 4; const u32x2 xo = *(const u32x2*)(XB + (size_t)row * 1024 + col); const f32x4 gg = *(const f32x4*)(fg + col);
                *(f32x4*)((P.out + launder_z()) + O_Y + (size_t)row * 1024 + col) = (f32x4){bf_lo(xo.x) * r * gg[0], bf_hi(xo.x) * r * gg[1], bf_lo(xo.y) * r * gg[2], bf_hi(xo.y) * r * gg[3]}; } }
        return; }
    const int l = ph >= 2 ? (ph - 2) / 7 : 0, s = ph >= 2 ? (ph - 2) % 7 : -1;
    if (s == 1) { phase_convbc(P, l); { XcdBarrier xb; xb.bar = (unsigned*)(ws + WS_BAR); xb.x = xb_xcc_id(); xb.st = (volatile LAS unsigned*)(lds + LDS_BYTES); xcd_barrier(xb); } phase_mixer(lds, P, l); return; }
    bf16_t* xn_cur = (bf16_t*)(ws + ((l & 1) ? WS_XN2 : WS_XN)); bf16_t* xn_alt = (bf16_t*)(ws + ((l & 1) ? WS_XN : WS_XN2));
#define GINIT GPh g; g.G = GDIM; g.c = BIDX; g.nseg = 1; g.nlay = 1; g.a_lay = 0; g.b_lay = 0; g.nM = MT / 256; \
    g.rss = nullptr; g.rss_next = nullptr; g.XS = xn_cur; g.XD = xn_cur; g.O = nullptr; g.DT = (float*)(ws + WS_DT); \
    g.PROJ = (const bf16_t*)(ws + WS_PROJ); g.SSQ = (const float*)(ws + WS_SSQ); g.UPB = nullptr; \
    g.A = xn_cur; g.lda = 1024; g.ldb = 1024; g.K = 1024; g.nN = 4;
    switch (s) {
    case -1: { GINIT g.A = (const bf16_t*)(ws + WS_PBF); g.Bt = (const bf16_t*)(ws + WS_WPU); g.lda = 256; g.ldb = 256; g.K = 256; g.nlay = 4; g.a_lay = (size_t)MT * 256; g.b_lay = (size_t)1024 * 256;
        g.O = (bf16_t*)(ws + WS_UP); gemm_phase<EPI_UP>(lds, g); } break;
    case 0: { GINIT g.Bt = (const bf16_t*)(ws + WS_WIN) + (size_t)l * NIN * 1024; g.nN = NIN / 256;
        g.rss = RSS + (size_t)(3 * l) * MT * 16; g.O = (bf16_t*)(ws + WS_PROJ); gemm_phase<EPI_P1>(lds, g); } break;
    case 2: { GINIT g.A = (const bf16_t*)(ws + WS_Y); g.Bt = (const bf16_t*)(ws + WS_WBR) + (size_t)l * 1024 * 2048; g.lda = 2048; g.ldb = 2048; g.K = 512; g.nseg = 4;
        g.O = (bf16_t*)(ws + WS_MRG); g.nM = 64; gemm_phase<EPI_P3>(lds, g); mini_gemm<EPI_P3>(lds, g); } break;
    case 3: { GINIT g.A = (const bf16_t*)(ws + WS_MRG); g.Bt = (const bf16_t*)(ws + WS_WOUT) + (size_t)l * 1024 * 1024;
        g.rss_next = RSS + (size_t)(3 * l + 1) * MT * 16; g.nM = 64; gemm_phase<EPI_P4>(lds, g); mini_gemm<EPI_P4>(lds, g); } break;
    case 4: { GINIT g.Bt = (const bf16_t*)(ws + WS_WGU) + (size_t)l * 5632 * 1024; g.nN = 22;
        g.rss = RSS + (size_t)(3 * l + 1) * MT * 16; g.O = (bf16_t*)(ws + WS_ACT); gemm_phase<EPI_P5>(lds, g); } break;
    case 5: { GINIT g.A = (const bf16_t*)(ws + WS_ACT); g.Bt = (const bf16_t*)(ws + WS_WDN) + (size_t)l * 1024 * DFF; g.lda = DFF; g.ldb = DFF; g.K = DFF;
        g.rss_next = RSS + (size_t)(3 * l + 2) * MT * 16; g.nM = 64; gemm_phase<EPI_P6>(lds, g); mini_gemm<EPI_P6>(lds, g); } break;
    default: { GINIT g.Bt = (const bf16_t*)(ws + WS_WPG) + (size_t)l * 1024 * 1024;
        g.rss = RSS + (size_t)(3 * l + 2) * MT * 16; g.rss_next = RSS + (size_t)(3 * l + 3) * MT * 16; g.XD = xn_alt;
        g.UPB = (const bf16_t*)(ws + WS_UP) + (size_t)l * MT * 1024; g.nM = 64; gemm_phase<EPI_P7>(lds, g); mini_gemm<EPI_P7>(lds, g); } break;
    }
#undef GINIT
}

__global__ void __launch_bounds__(NTHR, 2) hybrid_fwd(Params P) {
    extern __shared__ __attribute__((aligned(16))) uchar smem[];
    LAS uchar* lds = (LAS uchar*)smem;
    cg::grid_group grid = cg::this_grid();
    volatile LAS unsigned* st = (volatile LAS unsigned*)(lds + LDS_BYTES);
    if (threadIdx.x < 4) st[threadIdx.x] = 0u;
    __syncthreads();
    const XcdBarrier xbar = xcd_barrier_post((unsigned*)(P.ws + WS_BAR), st);
    for (int ph = P.ph_lo; ph < P.ph_hi; ++ph) {
        int nrep_ = 1;
#ifdef PROBE_REP
        { const int s_ = ph >= 2 && ph < 30 ? (ph - 2) % 7 : (ph == 0 ? 7 : (ph == 1 ? 8 : 9)); if ((PROBE_REP >> s_) & 1) nrep_ = 2; }
#endif
#pragma unroll 1
        for (int r_ = 0; r_ < nrep_; ++r_) { run_phase(lds, P, ph); __syncthreads(); }
        if (ph + 1 < P.ph_hi) {
            if (P.ph_lo < 0) grid.sync();
            xcd_barrier(xbar);
        }
    }
}

extern "C" void kernel_launch(void* const* d_in, const int* in_sizes, int n_in, void* d_out, int out_size, void* d_ws, size_t ws_size, hipStream_t stream) {
    static int grid = 0;
    if (grid == 0) {
        if (n_in != 32 || (size_t)out_size != O_END || ws_size < WS_END) { fprintf(stderr, "kernel_launch: shape mismatch n_in %d out %d (want %zu) ws %zu (want %zu)\n", n_in, out_size, (size_t)O_END, ws_size, (size_t)WS_END); grid = -1; return; }
        int dev = 0, cus = 0, per_cu = 0;
        hipGetDevice(&dev); hipDeviceGetAttribute(&cus, hipDeviceAttributeMultiprocessorCount, dev);
        if (hipFuncSetAttribute((const void*)hybrid_fwd, hipFuncAttributeMaxDynamicSharedMemorySize, LDS_BYTES + 16) != hipSuccess) { fprintf(stderr, "kernel_launch: hipFuncSetAttribute failed\n"); grid = -1; return; }
        hipOccupancyMaxActiveBlocksPerMultiprocessor(&per_cu, (const void*)hybrid_fwd, NTHR, LDS_BYTES + 16);
        if (per_cu < 1) { fprintf(stderr, "kernel_launch: occupancy query says %d blocks per CU\n", per_cu); per_cu = 1; }
        grid = cus * 1;
        fprintf(stderr, "kernel_launch: cus %d per_cu %d grid %d\n", cus, per_cu, grid);
    }
    if (grid < 0) return;
    hipMemsetAsync((char*)d_ws + WS_BAR, 0, 16384, stream);
    Params p{};
    for (int i = 0; i < 32; ++i) p.in[i] = (const float*)d_in[i];
    p.out = (float*)d_out; p.ws = (uchar*)d_ws;
#if MULTI_LAUNCH
    for (int ph = 0; ph < 31; ++ph) { p.ph_lo = ph; p.ph_hi = ph + 1; hipLaunchKernelGGL(hybrid_fwd, dim3(grid), dim3(NTHR), LDS_BYTES + 16, stream, p); }
#else
    p.ph_lo = 0; p.ph_hi = 31;
    void* args[] = {&p};
    hipError_t e = hipLaunchCooperativeKernel((const void*)hybrid_fwd, dim3(grid), dim3(NTHR), args, LDS_BYTES + 16, stream);
    if (e != hipSuccess) fprintf(stderr, "cooperative launch failed: %s (grid %d)\n", hipGetErrorString(e), grid);
#endif
}
```
